# Optimizing an MI355X kernel written in HIP

```python
import jax, jax.numpy as jnp
from jax import lax
import numpy as np

D_MODEL = 1024
BATCH = 4
SEQ = 8192
DEPTH = 2

CHUNK = 64
N_MIXERS = 2
POOL_WINDOWS = (2, 4, 8, 16)
N_POOL_GROUPS = len(POOL_WINDOWS)
POOL_GROUP_DIM = D_MODEL // N_POOL_GROUPS
HEAD_DIM = 64
N_HEADS = D_MODEL // HEAD_DIM
Q_BLOCK = 128
D_FF_DENSE = ((8 * D_MODEL // 3 + 127) // 128) * 128
N_EXPERTS = 8
TOP_K = 2
D_FF_EXPERT = 7 * D_MODEL // 2
RMS_EPS = 1e-6
N_POOL_LAYERS = (DEPTH + 1) // 2
N_ATTN_LAYERS = DEPTH // 2
N_DENSE_LAYERS = (DEPTH + 1) // 2
N_MOE_LAYERS = DEPTH // 2
NEG_INF = -1e30

kernel_name = "hybrid_pool_fox_moe_trunk"


def rms_norm(x, g):
    xf = x.astype(jnp.float32)
    y = xf * lax.rsqrt(jnp.mean(xf * xf, axis=-1, keepdims=True) + RMS_EPS)
    return (y * g.astype(jnp.float32)).astype(x.dtype)


def pool_mixer(h, w_group, scale):
    B, S, D = h.shape
    hf = h.astype(jnp.float32)
    cum = jnp.cumsum(hf, axis=1)
    t = jnp.arange(S)
    outs = []
    for g, w in enumerate(POOL_WINDOWS):
        sl = slice(g * POOL_GROUP_DIM, (g + 1) * POOL_GROUP_DIM)
        c = cum[:, :, sl]
        c_lag = jnp.pad(c, ((0, 0), (w, 0), (0, 0)))[:, :S]
        count = jnp.minimum(t + 1, w).astype(jnp.float32)
        mean = (c - c_lag) / count[None, :, None]
        outs.append(mean - hf[:, :, sl])
    pooled = jnp.stack(outs, axis=2).astype(h.dtype)
    mixed = jnp.einsum('bsgc,gcd->bsgd', pooled, w_group).reshape(B, S, D)
    return mixed * scale


def forgetting_attention(h, w_in, b_f, w_out):
    B, S, D = h.shape
    proj = h @ w_in
    q, k, v, f_logit = jnp.split(proj, [D, 2 * D, 3 * D], axis=-1)
    q = q.reshape(B, S, N_HEADS, HEAD_DIM)
    k = k.reshape(B, S, N_HEADS, HEAD_DIM)
    v = v.reshape(B, S, N_HEADS, HEAD_DIM)
    log_f = jax.nn.log_sigmoid((f_logit + b_f).astype(jnp.float32))
    c = jnp.cumsum(log_f, axis=1).transpose(0, 2, 1)
    n_blk = S // Q_BLOCK
    q_blocks = q.reshape(B, n_blk, Q_BLOCK, N_HEADS, HEAD_DIM).transpose(1, 0, 3, 2, 4)
    c_blocks = c.reshape(B, N_HEADS, n_blk, Q_BLOCK).transpose(2, 0, 1, 3)
    pos_k = jnp.arange(S)
    scale = HEAD_DIM ** -0.5

    def one_block(args):
        q_i, c_i, i = args
        pos_q = i * Q_BLOCK + jnp.arange(Q_BLOCK)
        logits = jnp.einsum('bhqd,bshd->bhqs', q_i, k).astype(jnp.float32) * scale
        logits = logits + c_i[..., :, None] - c[:, :, None, :]
        mask = pos_q[:, None] >= pos_k[None, :]
        logits = jnp.where(mask[None, None], logits, NEG_INF)
        p = jax.nn.softmax(logits, axis=-1).astype(v.dtype)
        return jnp.einsum('bhqs,bshd->bqhd', p, v)

    o = lax.map(one_block, (q_blocks, c_blocks, jnp.arange(n_blk)))
    o = o.transpose(1, 0, 2, 3, 4).reshape(B, S, D)
    return o @ w_out


def swiglu(h, w_gate, w_up, w_down):
    return (jax.nn.silu(h @ w_gate) * (h @ w_up)) @ w_down


def moe_swiglu(h, w_router, w_gate, w_up, w_down):
    logits = (h @ w_router).astype(jnp.float32)
    top_val, top_idx = lax.top_k(logits, TOP_K)
    top_w = jax.nn.softmax(top_val, axis=-1)
    gates = jnp.sum(jax.nn.one_hot(top_idx, N_EXPERTS, dtype=jnp.float32) * top_w[..., None], axis=-2)
    gates = gates.astype(h.dtype)
    out = jnp.zeros_like(h)
    for e in range(N_EXPERTS):
        out = out + gates[..., e:e + 1] * swiglu(h, w_gate[e], w_up[e], w_down[e])
    return out


def setup_inputs(seed: int = 0) -> dict:
    key = jax.random.key(seed)
    ks = jax.random.split(key, 16)
    D, H = D_MODEL, N_HEADS

    def nrm(k, shape, fan_in):
        return jax.random.normal(k, shape, jnp.float32) * (fan_in ** -0.5)

    x = jax.random.normal(ks[0], (BATCH, SEQ, D), jnp.float32)
    norm_g = 1.0 + 0.05 * jax.random.normal(ks[1], (DEPTH, 4, D), jnp.float32)
    pool_w = nrm(ks[2], (N_POOL_LAYERS, N_POOL_GROUPS, POOL_GROUP_DIM, POOL_GROUP_DIM), POOL_GROUP_DIM)
    pool_scale = 1.0 + 0.1 * jax.random.normal(ks[3], (N_POOL_LAYERS, D), jnp.float32)
    attn_w_in = nrm(ks[4], (N_ATTN_LAYERS, D, 3 * D + H), D)
    attn_b_f = 3.0 + 0.5 * jax.random.normal(ks[5], (N_ATTN_LAYERS, H), jnp.float32)
    attn_w_out = nrm(ks[6], (N_ATTN_LAYERS, D, D), D)
    ffn_w_gate = nrm(ks[7], (N_DENSE_LAYERS, D, D_FF_DENSE), D)
    ffn_w_up = nrm(ks[8], (N_DENSE_LAYERS, D, D_FF_DENSE), D)
    ffn_w_down = nrm(ks[9], (N_DENSE_LAYERS, D_FF_DENSE, D), D_FF_DENSE)
    moe_w_router = nrm(ks[10], (N_MOE_LAYERS, D, N_EXPERTS), D)
    moe_w_gate = nrm(ks[11], (N_MOE_LAYERS, N_EXPERTS, D, D_FF_EXPERT), D)
    moe_w_up = nrm(ks[12], (N_MOE_LAYERS, N_EXPERTS, D, D_FF_EXPERT), D)
    moe_w_down = nrm(ks[13], (N_MOE_LAYERS, N_EXPERTS, D_FF_EXPERT, D), D_FF_EXPERT)
    return {"x": x, "norm_g": norm_g, "pool_w": pool_w, "pool_scale": pool_scale,
            "attn_w_in": attn_w_in, "attn_b_f": attn_b_f, "attn_w_out": attn_w_out,
            "ffn_w_gate": ffn_w_gate, "ffn_w_up": ffn_w_up, "ffn_w_down": ffn_w_down,
            "moe_w_router": moe_w_router, "moe_w_gate": moe_w_gate,
            "moe_w_up": moe_w_up, "moe_w_down": moe_w_down}


def reference(x, norm_g, pool_w, pool_scale, attn_w_in, attn_b_f, attn_w_out,
              ffn_w_gate, ffn_w_up, ffn_w_down,
              moe_w_router, moe_w_gate, moe_w_up, moe_w_down):
    for i in range(DEPTH):
        slot = i // 2
        h = rms_norm(x, norm_g[i, 0])
        if i % N_MIXERS == 0:
            y = pool_mixer(h, pool_w[slot], pool_scale[slot])
        else:
            y = forgetting_attention(h, attn_w_in[slot], attn_b_f[slot], attn_w_out[slot])
        x = x + rms_norm(y, norm_g[i, 1])
        h = rms_norm(x, norm_g[i, 2])
        if i % 2 == 0:
            y = swiglu(h, ffn_w_gate[slot], ffn_w_up[slot], ffn_w_down[slot])
        else:
            y = moe_swiglu(h, moe_w_router[slot], moe_w_gate[slot], moe_w_up[slot], moe_w_down[slot])
        x = x + rms_norm(y, norm_g[i, 3])
    return x
```

```cpp
#include <hip/hip_runtime.h>
#include <hip/hip_bf16.h>
#include <cstdio>
#include <cstdint>
#include <cmath>

#ifndef MK_PER_PHASE
#define MK_PER_PHASE 0
#endif
#ifndef MK_LAST_PHASE
#define MK_LAST_PHASE 16
#endif

namespace pg8 {
#define PG8_LAS __attribute__((address_space(3)))
typedef unsigned short bf16_t;
typedef short bf16x8 __attribute__((ext_vector_type(8)));
typedef float f32x4 __attribute__((ext_vector_type(4)));
typedef unsigned u32x4 __attribute__((ext_vector_type(4)));
constexpr int BM = 256, BK = 64, HALF = 128, HTB = HALF * BK * 2, STAGE_BYTES = 8 * HTB, NXCD = 8, WGM = 8;

__host__ __device__ __forceinline__ int lds_byte(int r, int c) { const int st = (r >> 4) * 2 + (c >> 5), rr = r & 15, cc = c & 31, ob = rr * 64 + cc * 2; return st * 1024 + (ob ^ (((ob >> 9) & 1) << 5)); }
__host__ __device__ __forceinline__ void stage_rc(int b, int& R, int& C) { const int st = b / 1024, sb = b % 1024, swz = sb ^ (((sb >> 9) & 1) << 5); R = (st >> 1) * 16 + swz / 64; C = (st & 1) * 32 + (swz % 64) / 2; }
__host__ __device__ __forceinline__ int perm32(int rho) { const int n = rho >> 4, i = rho & 15; return 8 * (i >> 2) + 4 * n + (i & 3); }

struct Unit { int pm, pn; const char* A; const char* B; };
struct GemmK { int K, lda, ldb; };

__device__ __forceinline__ void tile_of(int wgid_in, int nM, int nN, int& pm, int& pn) {
    const int nwg = nM * nN; int wgid = wgid_in;
    { const int q = nwg / NXCD, r = nwg % NXCD, xcd = wgid % NXCD, off = wgid / NXCD; wgid = (xcd < r ? xcd * (q + 1) : r * (q + 1) + (xcd - r) * q) + off; }
    const int nig = WGM * nN, gid = wgid / nig, fm = gid * WGM, gsz = (nM - fm) < WGM ? (nM - fm) : WGM;
    pm = fm + ((wgid % nig) % gsz); pn = (wgid % nig) / gsz;
}
struct DenseOrder {
    int nM, nN, nwg, G, c; const char* A; const char* B; size_t a_tile, a_pn, b_tile;
    __device__ __forceinline__ bool next(int i, Unit& u) const {
        const long L = (long)i * G + c; if (L >= nwg) return false;
        int pm, pn; tile_of((int)L, nM, nN, pm, pn);
        u.pm = pm; u.pn = pn; u.A = A + (size_t)pm * a_tile + (size_t)pn * a_pn; u.B = B + (size_t)pn * b_tile; return true;
    }
};
struct MoeOrder {
    int rt0, nM, nN, nwg, G, c; const char* A; size_t a_tile; int a_local; const char* B; size_t b_exp, b_tile; int pm_global; const PG8_LAS unsigned* toff;
    __device__ __forceinline__ bool next(int i, Unit& u) const {
        const long L = (long)i * G + c; if (L >= nwg) return false;
        int pm, pn; tile_of((int)L, nM, nN, pm, pn);
        const int rt = rt0 + pm; int e = 0;
#pragma unroll
        for (int j = 1; j < 8; ++j) e += ((unsigned)rt >= toff[j]) ? 1 : 0;
        e = __builtin_amdgcn_readfirstlane(e);
        u.pm = pm_global ? rt : pm; u.pn = pn; u.A = A + (size_t)(a_local ? pm : rt) * a_tile; u.B = B + (size_t)e * b_exp + (size_t)pn * b_tile; return true;
    }
};

__device__ __forceinline__ unsigned cvt_pk_bf16(float lo, float hi) { unsigned r; asm volatile("v_cvt_pk_bf16_f32 %0, %1, %2" : "=v"(r) : "v"(lo), "v"(hi)); return r; }

struct EpiBf16 {
    static constexpr bool PERM = true;
    bf16_t* O; int ldc; const float* cscale; int split_cols; size_t split_stride; float scale0;
    __device__ __forceinline__ void operator()(const f32x4 (&acc)[2][2][4][2], const Unit& u, int wr, int wc, int fr, int fq) const {
        const int row0 = u.pm * BM + wr * 64 + fr; int colt = u.pn * BM; bf16_t* base = O;
        float sc = split_cols ? 1.f : scale0; if (split_cols) { const int t = colt / split_cols; base += (size_t)t * split_stride; colt -= t * split_cols; if (t == 0) sc = scale0; }
        const int col0 = colt + wc * 32 + 8 * fq, scol0 = u.pn * BM + wc * 32 + 8 * fq;
        f32x4 sv[2][2];
#pragma unroll
        for (int bj = 0; bj < 2; ++bj)
#pragma unroll
            for (int n = 0; n < 2; ++n) { sv[bj][n] = cscale ? *(const f32x4*)(cscale + scol0 + bj * HALF + 4 * n) : (f32x4){1.f, 1.f, 1.f, 1.f}; sv[bj][n] = sv[bj][n] * sc; }
#pragma unroll
        for (int ai = 0; ai < 2; ++ai)
#pragma unroll
            for (int m = 0; m < 4; ++m) { bf16_t* rowp = base + (size_t)(row0 + ai * HALF + m * 16) * ldc + col0;
#pragma unroll
                for (int bj = 0; bj < 2; ++bj) { const f32x4 v0 = acc[ai][bj][m][0] * sv[bj][0], v1 = acc[ai][bj][m][1] * sv[bj][1];
                    u32x4 w; w.x = cvt_pk_bf16(v0[0], v0[1]); w.y = cvt_pk_bf16(v0[2], v0[3]); w.z = cvt_pk_bf16(v1[0], v1[1]); w.w = cvt_pk_bf16(v1[2], v1[3]);
                    *(u32x4*)(rowp + bj * HALF) = w; } }
    }
};
struct EpiQKV {
    static constexpr bool PERM = true;
    bf16_t* O; int ldc; size_t split_stride; float scale0; unsigned* maxq; unsigned* maxk;
    __device__ __forceinline__ void operator()(const f32x4 (&acc)[2][2][4][2], const Unit& u, int wr, int wc, int fr, int fq) const {
        const int row0 = u.pm * BM + wr * 64 + fr; int colt = u.pn * BM; const int t = colt >> 10; bf16_t* base = O + (size_t)t * split_stride; colt -= t << 10;
        const float sc = (t == 0) ? scale0 : 1.f;
        const int col0 = colt + wc * 32 + 8 * fq;
        float nm0 = 0.f, nm1 = 0.f;
#pragma unroll
        for (int ai = 0; ai < 2; ++ai)
#pragma unroll
            for (int m = 0; m < 4; ++m) { bf16_t* rowp = base + (size_t)(row0 + ai * HALF + m * 16) * ldc + col0;
#pragma unroll
                for (int bj = 0; bj < 2; ++bj) { const f32x4 v0 = acc[ai][bj][m][0] * sc, v1 = acc[ai][bj][m][1] * sc;
                    u32x4 w; w.x = cvt_pk_bf16(v0[0], v0[1]); w.y = cvt_pk_bf16(v0[2], v0[3]); w.z = cvt_pk_bf16(v1[0], v1[1]); w.w = cvt_pk_bf16(v1[2], v1[3]);
                    *(u32x4*)(rowp + bj * HALF) = w;
                    if (t < 2) { float s = (v0[0] * v0[0] + v0[1] * v0[1]) + (v0[2] * v0[2] + v0[3] * v0[3]) + (v1[0] * v1[0] + v1[1] * v1[1]) + (v1[2] * v1[2] + v1[3] * v1[3]);
                        s += __shfl_xor(s, 16); s += __shfl_xor(s, 32); if (bj == 0) nm0 = fmaxf(nm0, s); else nm1 = fmaxf(nm1, s); } } }
        if (t < 2) {
#pragma unroll
            for (int o = 1; o < 16; o <<= 1) { nm0 = fmaxf(nm0, __shfl_xor(nm0, o)); nm1 = fmaxf(nm1, __shfl_xor(nm1, o)); }
            if ((threadIdx.x & 63) == 0) { unsigned* dst = (t == 0 ? maxq : maxk) + (u.pm >> 5) * 16 + 4 * (u.pn & 3) + (wc >> 1);
                __hip_atomic_fetch_max(dst, __float_as_uint(sqrtf(nm0)), __ATOMIC_RELAXED, __HIP_MEMORY_SCOPE_AGENT);
                __hip_atomic_fetch_max(dst + 2, __float_as_uint(sqrtf(nm1)), __ATOMIC_RELAXED, __HIP_MEMORY_SCOPE_AGENT); }
        }
    }
};
__device__ __forceinline__ float silu_mul(float g, float u) { const float e = __builtin_amdgcn_exp2f(g * -1.4426950408889634f); return g * __builtin_amdgcn_rcpf(1.0f + e) * u; }
struct EpiSwiGLU {
    static constexpr bool PERM = true;
    bf16_t* O; int ldc;
    __device__ __forceinline__ void operator()(const f32x4 (&acc)[2][2][4][2], const Unit& u, int wr, int wc, int fr, int fq) const {
        const int row0 = u.pm * BM + wr * 64 + fr, col0 = u.pn * HALF + wc * 32 + 8 * fq;
#pragma unroll
        for (int ai = 0; ai < 2; ++ai)
#pragma unroll
            for (int m = 0; m < 4; ++m) { bf16_t* rowp = O + (size_t)(row0 + ai * HALF + m * 16) * ldc + col0;
                const f32x4 g0 = acc[ai][0][m][0], g1 = acc[ai][0][m][1], u0 = acc[ai][1][m][0], u1 = acc[ai][1][m][1];
                u32x4 w; w.x = cvt_pk_bf16(silu_mul(g0[0], u0[0]), silu_mul(g0[1], u0[1])); w.y = cvt_pk_bf16(silu_mul(g0[2], u0[2]), silu_mul(g0[3], u0[3]));
                w.z = cvt_pk_bf16(silu_mul(g1[0], u1[0]), silu_mul(g1[1], u1[1])); w.w = cvt_pk_bf16(silu_mul(g1[2], u1[2]), silu_mul(g1[3], u1[3]));
                *(u32x4*)rowp = w; }
    }
};

__device__ __forceinline__ unsigned pk4_fp8(float a, float b, float c, float d) { int w = 0; w = __builtin_amdgcn_cvt_pk_fp8_f32(a, b, w, false); w = __builtin_amdgcn_cvt_pk_fp8_f32(c, d, w, true); return (unsigned)w; }
struct EpiSwiGLU8 {
    static constexpr bool PERM = true;
    unsigned char* O; int ldc; float ascale;
    __device__ __forceinline__ void operator()(const f32x4 (&acc)[2][2][4][2], const Unit& u, int wr, int wc, int fr, int fq) const {
        const int row0 = u.pm * BM + wr * 64 + fr, col0 = u.pn * HALF + wc * 32 + 8 * fq;
#pragma unroll
        for (int ai = 0; ai < 2; ++ai)
#pragma unroll
            for (int m = 0; m < 4; ++m) { unsigned char* rowp = O + (size_t)(row0 + ai * HALF + m * 16) * ldc + col0;
                const f32x4 g0 = acc[ai][0][m][0] * ascale, g1 = acc[ai][0][m][1] * ascale, u0 = acc[ai][1][m][0] * ascale, u1 = acc[ai][1][m][1] * ascale;
                typedef unsigned u32x2 __attribute__((ext_vector_type(2)));
                u32x2 w; w.x = pk4_fp8(silu_mul(g0[0], u0[0]), silu_mul(g0[1], u0[1]), silu_mul(g0[2], u0[2]), silu_mul(g0[3], u0[3]));
                w.y = pk4_fp8(silu_mul(g1[0], u1[0]), silu_mul(g1[1], u1[1]), silu_mul(g1[2], u1[2]), silu_mul(g1[3], u1[3]));
                *(u32x2*)rowp = w; }
    }
};

typedef int v4i_t __attribute__((ext_vector_type(4)));
typedef int v8i_t __attribute__((ext_vector_type(8)));
__device__ __forceinline__ v8i_t cat8(bf16x8 lo, bf16x8 hi) { const v4i_t a = __builtin_bit_cast(v4i_t, lo), b = __builtin_bit_cast(v4i_t, hi); return __builtin_shufflevector(a, b, 0, 1, 2, 3, 4, 5, 6, 7); }
template <class Epi, class Sched, bool ALIGN_EPI, bool F8 = false>
__device__ __forceinline__ void gemm_phase(PG8_LAS unsigned char* lds, const GemmK g, const Sched& S, const Epi& E) {
    int tid_ = threadIdx.x; asm volatile("" : "+v"(tid_));
    const int tid = tid_, wid = __builtin_amdgcn_readfirstlane(tid >> 6), lane = tid & 63, wr = wid >> 2, wc = wid & 3, fr = lane & 15, fq = lane >> 4;
    const int K = g.K, nt = K / BK;
    unsigned voffA[2], voffB[2];
#pragma unroll
    for (int i = 0; i < 2; ++i) { int R, C; stage_rc(tid * 16 + i * 8192, R, C); const int Rb = Epi::PERM ? ((R & ~31) + perm32(R & 31)) : R;
        voffA[i] = (unsigned)(R * g.lda + C) * 2u; voffB[i] = (unsigned)(Rb * g.ldb + C) * 2u; }
    const size_t kstep = (size_t)(BK * 2);
    const size_t hstepA = (size_t)HALF * g.lda * 2, hstepB = (size_t)HALF * g.ldb * 2;
    const unsigned ldsw = (unsigned)wid * 1024u;
    const unsigned ldsbase = (unsigned)__builtin_amdgcn_readfirstlane((int)(unsigned)(uintptr_t)lds);
    const int aoff = lds_byte(wr * 64 + fr, fq * 8), boff = lds_byte(wc * 32 + fr, fq * 8);
#define PG8_SA(b, h) (((b) * 2 + (h)) * HTB)
#define PG8_SB(b, h) ((4 + (b) * 2 + (h)) * HTB)
#define PG8_STAGE(bufoff, gbase, voff) do { _Pragma("unroll") for (int _i = 0; _i < 2; ++_i) { unsigned keep_; \
        asm volatile("s_mov_b32 %0, m0\n\ts_mov_b32 m0, %3\n\ts_nop 2\n\tglobal_load_lds_dwordx4 %1, %2\n\ts_mov_b32 m0, %0" \
            : "=&s"(keep_) : "v"((voff)[_i]), "s"((const char*)(gbase)), "s"(ldsbase + (unsigned)(bufoff) + ldsw + (unsigned)(_i * 8192)) : "memory"); } } while (0)
#define PG8_LDA(dst, b, h) do { _Pragma("unroll") for (int m = 0; m < 4; ++m) _Pragma("unroll") for (int k = 0; k < 2; ++k) dst[m][k] = *(const PG8_LAS bf16x8*)(lds + PG8_SA(b, h) + aoff + m * 2048 + k * 1024); } while (0)
#define PG8_LDB(dst, b, h) do { _Pragma("unroll") for (int n = 0; n < 2; ++n) _Pragma("unroll") for (int k = 0; k < 2; ++k) dst[n][k] = *(const PG8_LAS bf16x8*)(lds + PG8_SB(b, h) + boff + n * 2048 + k * 1024); } while (0)
#define PG8_MMA(ai, bj, At, Bt) do { __builtin_amdgcn_s_setprio(1); if constexpr (F8) { _Pragma("unroll") for (int m = 0; m < 4; ++m) _Pragma("unroll") for (int n = 0; n < 2; ++n) \
        acc[ai][bj][m][n] = __builtin_amdgcn_mfma_scale_f32_16x16x128_f8f6f4(cat8(Bt[n][0], Bt[n][1]), cat8(At[m][0], At[m][1]), acc[ai][bj][m][n], 0, 0, 0, 0, 0, 0); } \
        else { _Pragma("unroll") for (int m = 0; m < 4; ++m) _Pragma("unroll") for (int n = 0; n < 2; ++n) _Pragma("unroll") for (int k = 0; k < 2; ++k) \
        acc[ai][bj][m][n] = __builtin_amdgcn_mfma_f32_16x16x32_bf16(Bt[n][k], At[m][k], acc[ai][bj][m][n], 0, 0, 0); } __builtin_amdgcn_s_setprio(0); } while (0)
#define PG8_WAIT_V(n) asm volatile("s_waitcnt vmcnt(" #n ")" ::: "memory")
#define PG8_WAIT_L(n) asm volatile("s_waitcnt lgkmcnt(" #n ")" ::: "memory")
#define PG8_BAR __builtin_amdgcn_s_barrier()
#define PG8_SCHED __builtin_amdgcn_sched_barrier(0)
    Unit cur, nxt; int ui = 0;
    if (!S.next(0, cur)) return;
    f32x4 acc[2][2][4][2];
#pragma unroll
    for (int a = 0; a < 2; ++a)
#pragma unroll
        for (int b = 0; b < 2; ++b)
#pragma unroll
            for (int m = 0; m < 4; ++m)
#pragma unroll
                for (int n = 0; n < 2; ++n) acc[a][b][m][n] = (f32x4){0.f, 0.f, 0.f, 0.f};
    bf16x8 At[4][2], B0[2][2], B1[2][2];
    const char* cA = cur.A; const char* cB = cur.B;
    PG8_STAGE(PG8_SB(0, 0), cB, voffB); PG8_STAGE(PG8_SB(0, 1), cB + hstepB, voffB); PG8_STAGE(PG8_SA(0, 0), cA, voffA); PG8_STAGE(PG8_SA(0, 1), cA + hstepA, voffA);
    if (wr == 1) PG8_BAR;
    PG8_WAIT_V(2); PG8_BAR;
    PG8_STAGE(PG8_SB(1, 0), cB + kstep, voffB); PG8_STAGE(PG8_SA(1, 0), cA + kstep, voffA); PG8_STAGE(PG8_SB(1, 1), cB + hstepB + kstep, voffB);
    PG8_WAIT_V(6); PG8_BAR;
    for (;;) {
        const bool has_next = S.next(ui + 1, nxt);
        const char* nA = has_next ? nxt.A : cA; const char* nB = has_next ? nxt.B : cB;
#pragma unroll 1
        for (int t = 0; t < nt; t += 2) {
            const bool last = (t == nt - 2);
            const char* a1 = cA + (size_t)(t + 1) * kstep;
            const char* a2 = last ? nA : cA + (size_t)(t + 2) * kstep; const char* b2 = last ? nB : cB + (size_t)(t + 2) * kstep;
            const char* a3 = a2 + kstep; const char* b3 = b2 + kstep;
            PG8_LDB(B0, 0, 0); PG8_LDB(B1, 0, 1); PG8_SCHED; PG8_LDA(At, 0, 0); PG8_STAGE(PG8_SA(1, 1), a1 + hstepA, voffA);
            PG8_WAIT_V(8); PG8_WAIT_L(0); PG8_BAR; PG8_MMA(0, 0, At, B0); PG8_MMA(0, 1, At, B1); PG8_BAR; PG8_SCHED;
            PG8_LDA(At, 0, 1); PG8_STAGE(PG8_SB(0, 0), b2, voffB); PG8_STAGE(PG8_SB(0, 1), b2 + hstepB, voffB); PG8_STAGE(PG8_SA(0, 0), a2, voffA);
            PG8_WAIT_V(8); PG8_WAIT_L(0); PG8_BAR; PG8_MMA(1, 0, At, B0); PG8_MMA(1, 1, At, B1); PG8_BAR; PG8_SCHED;
            PG8_LDB(B0, 1, 0); PG8_LDB(B1, 1, 1); PG8_SCHED; PG8_LDA(At, 1, 0); PG8_STAGE(PG8_SA(0, 1), a2 + hstepA, voffA);
            PG8_WAIT_V(8); PG8_WAIT_L(0); PG8_BAR; PG8_MMA(0, 0, At, B0); PG8_MMA(0, 1, At, B1); PG8_BAR; PG8_SCHED;
            PG8_LDA(At, 1, 1); PG8_STAGE(PG8_SB(1, 0), b3, voffB); PG8_STAGE(PG8_SB(1, 1), b3 + hstepB, voffB); PG8_STAGE(PG8_SA(1, 0), a3, voffA);
            PG8_WAIT_V(8); PG8_WAIT_L(0); PG8_BAR; PG8_MMA(1, 0, At, B0); PG8_MMA(1, 1, At, B1); PG8_BAR; PG8_SCHED;
        }
        if constexpr (ALIGN_EPI) { if (wr == 0) PG8_BAR; }
        { int te_ = threadIdx.x; asm volatile("" : "+v"(te_));
          E(acc, cur, wr, wc, te_ & 15, (te_ >> 4) & 3); }
        if (!has_next) break;
#pragma unroll
        for (int a = 0; a < 2; ++a)
#pragma unroll
            for (int b = 0; b < 2; ++b)
#pragma unroll
                for (int m = 0; m < 4; ++m)
#pragma unroll
                    for (int n = 0; n < 2; ++n) acc[a][b][m][n] = (f32x4){0.f, 0.f, 0.f, 0.f};
        cur = nxt; cA = nA; cB = nB; ++ui;
        if constexpr (ALIGN_EPI) { if (wr == 1) PG8_BAR; }
    }
    PG8_WAIT_V(0);
    if constexpr (!ALIGN_EPI) { if (wr == 0) PG8_BAR; }
    PG8_BAR;
#undef PG8_SA
#undef PG8_SB
#undef PG8_STAGE
#undef PG8_LDA
#undef PG8_LDB
#undef PG8_MMA
#undef PG8_WAIT_V
#undef PG8_WAIT_L
#undef PG8_BAR
#undef PG8_SCHED
}
}

namespace attn_body {
using bf16=__hip_bfloat16;
using bf16x8=__attribute__((ext_vector_type(8)))short;
using s16x4=__attribute__((ext_vector_type(4)))short;
using f32x16=__attribute__((ext_vector_type(16)))float;
using f32x4v=__attribute__((ext_vector_type(4)))float;
using u32x4=__attribute__((ext_vector_type(4)))unsigned;
constexpr int BATCH=4,NHEAD=16,SEQ=8192,D=64,DM=NHEAD*D;
constexpr int NW=8,QBLK=32,QB=QBLK*NW,KVBLK=64,NQB=SEQ/QB;
__device__ __forceinline__ int crow(int r,int hi){return (r&3)+8*(r>>2)+4*hi;}
#define SBAR() __builtin_amdgcn_sched_barrier(0)
__device__ __forceinline__ void cmask(f32x16&p0,f32x16&p1,int jb,int qrel,int hi){
  const float NEG=-INFINITY; int kb=64*jb+4*hi;
  #pragma unroll
  for(int r=0;r<16;++r){int kv=kb+(r&3)+8*(r>>2); if(kv>qrel)p0[r]=NEG; if(kv+32>qrel)p1[r]=NEG;}
}
constexpr int NSLOT=3, SLOTB=8192;
constexpr int LDS_K=0, LDS_V=NSLOT*SLOTB, LDS_WS=2*NSLOT*SLOTB, LDS_OST=LDS_WS+NW*64*4, LDS_CS=LDS_OST+NW*4096, LDS_BYTES=LDS_CS+SEQ*4;
constexpr float C2=0.125f*1.4426950408889634f;
__device__ __forceinline__ void glds16(const void*gsrc,unsigned lds_dst){unsigned keep;
  asm volatile("s_mov_b32 %0, m0\n\ts_mov_b32 m0, %2\n\ts_nop 0\n\tglobal_load_lds_dwordx4 %1, off\n\ts_mov_b32 m0, %0":"=&s"(keep):"v"(gsrc),"s"(lds_dst):"memory");}
__device__ __forceinline__ float max3f(float a,float b,float c){float r;asm("v_max3_f32 %0, %1, %2, %3":"=v"(r):"v"(a),"v"(b),"v"(c));return r;}
__device__ __forceinline__ float max2f(float a,float b){float r;asm("v_max_f32_e32 %0, %1, %2":"=v"(r):"v"(a),"v"(b));return r;}
__device__ __forceinline__ float fadd_s(float a,float b){float r;asm("v_add_f32_e32 %0, %1, %2":"=v"(r):"v"(a),"v"(b));return r;}
__device__ __forceinline__ float fsub_s(float a,float b){float r;asm("v_sub_f32_e32 %0, %1, %2":"=v"(r):"v"(a),"v"(b));return r;}
typedef float f32x2_t __attribute__((ext_vector_type(2))); typedef __bf16 bf16x2_t __attribute__((ext_vector_type(2)));
__device__ __forceinline__ unsigned cvtpk_s(float lo,float hi){f32x2_t v={lo,hi};bf16x2_t b=__builtin_convertvector(v,bf16x2_t);return __builtin_bit_cast(unsigned,b);}
#define WAIT_BAR(N) asm volatile("s_waitcnt vmcnt(" #N ") lgkmcnt(0)\n\ts_barrier":::"memory")
typedef __attribute__((address_space(3))) const char* lds_cptr;
typedef short v4i16_t __attribute__((ext_vector_type(4)));
__device__ __forceinline__ void ldbias(f32x16&c0,f32x16&c1,lds_cptr csp,float negm){
  #pragma unroll
  for(int g=0;g<4;++g){ const f32x4v a=*(const __attribute__((address_space(3))) f32x4v*)(csp+g*32); const f32x4v b=*(const __attribute__((address_space(3))) f32x4v*)(csp+128+g*32);
    c0[4*g]=a[0]+negm;c0[4*g+1]=a[1]+negm;c0[4*g+2]=a[2]+negm;c0[4*g+3]=a[3]+negm; c1[4*g]=b[0]+negm;c1[4*g+1]=b[1]+negm;c1[4*g+2]=b[2]+negm;c1[4*g+3]=b[3]+negm; }
}
__device__ __forceinline__ void qkt(f32x16&p0,f32x16&p1,const char*Kslot,const bf16x8*qr,int r32,int hi){
  const char*kb=Kslot+hi*1024+r32*16;
  #pragma unroll
  for(int d0=0;d0<4;++d0){
    const bf16x8 b0=*reinterpret_cast<const bf16x8*>(kb+d0*2048);
    const bf16x8 b1=*reinterpret_cast<const bf16x8*>(kb+d0*2048+512);
    p0=__builtin_amdgcn_mfma_f32_32x32x16_bf16(b0,qr[d0],p0,0,0,0);p1=__builtin_amdgcn_mfma_f32_32x32x16_bf16(b1,qr[d0],p1,0,0,0);}
}
__device__ __forceinline__ void kload8(bf16x8*kf,lds_cptr kp){
  kf[0]=*(const __attribute__((address_space(3))) bf16x8*)(kp);      kf[1]=*(const __attribute__((address_space(3))) bf16x8*)(kp+512);
  kf[2]=*(const __attribute__((address_space(3))) bf16x8*)(kp+2048); kf[3]=*(const __attribute__((address_space(3))) bf16x8*)(kp+2560);
  kf[4]=*(const __attribute__((address_space(3))) bf16x8*)(kp+4096); kf[5]=*(const __attribute__((address_space(3))) bf16x8*)(kp+4608);
  kf[6]=*(const __attribute__((address_space(3))) bf16x8*)(kp+6144); kf[7]=*(const __attribute__((address_space(3))) bf16x8*)(kp+6656);
}
__device__ __forceinline__ void kload2(bf16x8*kf,lds_cptr kp,int j){ kf[2*j]=*(const __attribute__((address_space(3))) bf16x8*)(kp+j*2048); kf[2*j+1]=*(const __attribute__((address_space(3))) bf16x8*)(kp+j*2048+512); }
__device__ __forceinline__ s16x4 vtr(lds_cptr p){ return __builtin_bit_cast(s16x4,__builtin_amdgcn_ds_read_tr16_b64_v4i16((__attribute__((address_space(3))) v4i16_t*)p)); }
__device__ __forceinline__ float rowmax(const f32x16&p0,const f32x16&p1){
  float a=max3f(p0[0],p0[1],p1[0]),b=max3f(p0[2],p0[3],p1[1]);a=max3f(a,p1[2],p1[3]);
  #pragma unroll
  for(int r=4;r<16;r+=4){a=max3f(a,p0[r],p0[r+1]);b=max3f(b,p0[r+2],p0[r+3]);a=max3f(a,p1[r],p1[r+1]);b=max3f(b,p1[r+2],p1[r+3]);}
  const float m=max2f(a,b);
  auto rr=__builtin_amdgcn_permlane32_swap(__float_as_uint(m),__float_as_uint(m),false,false);
  return max2f(__uint_as_float(rr[0]),__uint_as_float(rr[1]));
}
__device__ __forceinline__ void pv(f32x16*o,int vb,bf16x8 pa0,bf16x8 pa1,bf16x8 pa2,bf16x8 pa3){
  #pragma unroll
  for(int d0=0;d0<2;++d0){s16x4 lo[4],hi[4];
    #pragma unroll
    for(int ks=0;ks<4;++ks){
      asm volatile("ds_read_b64_tr_b16 %0,%1 offset:%c2":"=&v"(lo[ks]):"v"(vb),"i"(d0*4096+ks*1024):"memory");
      asm volatile("ds_read_b64_tr_b16 %0,%1 offset:%c2":"=&v"(hi[ks]):"v"(vb),"i"(d0*4096+ks*1024+512):"memory");}
    asm volatile("s_waitcnt lgkmcnt(0)":::"memory");SBAR();
    #define PK(k) (bf16x8){lo[k][0],lo[k][1],lo[k][2],lo[k][3],hi[k][0],hi[k][1],hi[k][2],hi[k][3]}
    o[d0]=__builtin_amdgcn_mfma_f32_32x32x16_bf16(pa0,PK(0),o[d0],0,0,0);
    o[d0]=__builtin_amdgcn_mfma_f32_32x32x16_bf16(pa1,PK(1),o[d0],0,0,0);
    o[d0]=__builtin_amdgcn_mfma_f32_32x32x16_bf16(pa2,PK(2),o[d0],0,0,0);
    o[d0]=__builtin_amdgcn_mfma_f32_32x32x16_bf16(pa3,PK(3),o[d0],0,0,0);
    #undef PK
  }
}
#define ATTN_STORE16(p,v) (*(u32x4*)(p)=(v))
template<int THRL> __device__ __forceinline__ void attn_unit(int b,int h,int qb,int tstart,const bf16*Q,const bf16*__restrict__ K,const bf16*__restrict__ V,bf16*O,const float*NCS,char*shm){
  int tid_=threadIdx.x; asm volatile("":"+v"(tid_));
  const int tid=tid_,lane=tid&63,r32=lane&31,hi=lane>>5; const int wid=__builtin_amdgcn_readfirstlane(tid>>6);
  const long rowbase=(long)b*SEQ; const int q0=qb*QB;
  const bf16*Qw=Q+(rowbase+q0+wid*QBLK)*DM+h*D;
  const bf16*Kh=K+(rowbase+(long)tstart*KVBLK)*DM+h*D,*Vh=V+(rowbase+(long)tstart*KVBLK)*DM+h*D;
  const unsigned lds0=(unsigned)(uintptr_t)shm;
  float*wsf=(float*)(shm+LDS_WS)+wid*64;
  const lds_cptr shm3=(lds_cptr)shm;
  { const float*ncs=NCS+(size_t)(b*NHEAD+h)*SEQ+tstart*KVBLK; const int n4=(q0+QB-tstart*KVBLK)>>2;
    for(int i=tid;i<n4;i+=NW*64){ const f32x4v v=*(const f32x4v*)(ncs+4*i); *(__attribute__((address_space(3))) f32x4v*)((__attribute__((address_space(3))) char*)shm3+LDS_CS+16*i)=v; } }
  const bf16*ksrc=Kh+(long)lane*DM+wid*8;
  const bf16*vsrc=Vh+(long)(16*(wid&3)+(lane>>2))*DM+(wid>>2)*32+(lane&3)*8;
  const unsigned kdst=lds0+LDS_K+wid*1024, vdst=lds0+LDS_V+wid*1024;
  #define DMA_K(t,slot) glds16(ksrc+(long)(t)*KVBLK*DM,(unsigned)__builtin_amdgcn_readfirstlane(kdst+(slot)))
  #define DMA_V(t,slot) glds16(vsrc+(long)(t)*KVBLK*DM,(unsigned)__builtin_amdgcn_readfirstlane(vdst+(slot)))
  const int vb0=(int)(lds0+LDS_V)+((lane>>4)&1)*32+(lane&3)*8+(4*hi+((lane&15)>>2))*64;
  const char*Kbase=shm+LDS_K; bf16x8 kf[8];
  const lds_cptr kp0=shm3+LDS_K+hi*1024+r32*16; const lds_cptr vp0=shm3+LDS_V+((lane>>4)&1)*32+(lane&3)*8+(4*hi+((lane&15)>>2))*64;
  const lds_cptr csp0=shm3+LDS_CS+hi*16;
  const int NT=(q0+QB)/KVBLK-tstart;
  DMA_K(0,0);DMA_V(0,0);DMA_K(1,SLOTB);
  bf16x8 qr[4];
  #pragma unroll
  for(int d0=0;d0<4;++d0)qr[d0]=*reinterpret_cast<const bf16x8*>(&Qw[(long)r32*DM+d0*16+hi*8]);
  float mhat=0.f,l_reg=0.f,negm1=0.f;f32x16 o[2];o[0]=f32x16{};o[1]=f32x16{};
  const int qrel=wid*QBLK+r32;
  #define CMASK(P0,P1,t) do{int jb_=(t)-(NT-4); if(jb_>=0)cmask(P0,P1,jb_,qrel,hi);}while(0)
  bool resc=false;
  #define START(P0,P1) do{ const float rm=rowmax(P0,P1); resc=false; \
    { const float dl=rm; mhat=fadd_s(mhat,dl); \
      _Pragma("unroll") for(int r=0;r<16;++r){P0[r]=fsub_s(P0[r],dl);P1[r]=fsub_s(P1[r],dl);} \
      negm1=-mhat; } \
    _Pragma("unroll") for(int r=0;r<16;++r)P0[r]=__builtin_amdgcn_exp2f(P0[r]); }while(0)
  #define RESC() do{ if(resc){ asm volatile("s_waitcnt lgkmcnt(0)":::"memory"); \
      _Pragma("unroll") for(int d_=0;d_<2;++d_) _Pragma("unroll") for(int r=0;r<16;++r)o[d_][r]*=wsf[crow(r,hi)]; } }while(0)
  f32x16 pA0,pA1,pB0,pB1;
  int sl_prev=0,sl_cur=0,sl_next=SLOTB;
  #define ROT() do{sl_prev=sl_cur;sl_cur=sl_next;sl_next=(sl_next==(NSLOT-1)*SLOTB)?0:sl_next+SLOTB;}while(0)
  DMA_K(2,2*SLOTB);
  WAIT_BAR(3);
  ldbias(pA0,pA1,csp0,0.f);
  qkt(pA0,pA1,Kbase,qr,r32,hi);asm volatile("s_nop 15\n\ts_nop 7":"+v"(pA0),"+v"(pA1));CMASK(pA0,pA1,0);
  START(pA0,pA1);
  _Pragma("unroll") for(int r=0;r<16;++r)pA1[r]=__builtin_amdgcn_exp2f(pA1[r]);
  WAIT_BAR(0);
  DMA_K(3,0);DMA_V(1,SLOTB);
  ROT();
  kload8(kf,kp0+sl_cur);
  WAIT_BAR(2);
  s16x4 vlo[8],vhi[8]; u32x4 pw0,pw1,pw2,pw3;
  #define PKW(P,B) cvtpk_s(P[B],P[B+1])
  #define PAF(k) __builtin_bit_cast(bf16x8,pw##k)
  #define VFR(i) (bf16x8){vlo[i][0],vlo[i][1],vlo[i][2],vlo[i][3],vhi[i][0],vhi[i][1],vhi[i][2],vhi[i][3]}
  #define PIN(x) asm volatile("":"+v"(x))
  #define MX3(a,b,c) __builtin_fmaxf(__builtin_fmaxf((a),(b)),(c))
  #define GAPA(MF,A0,A1,A2,A3,W0,W1,PW) do{ MF; sacc+=A0; sacc+=A1; sacc+=A2; sacc+=A3; PIN(sacc); W0; W1; PIN(PW); SBAR(); }while(0)
  #define EX(v) __builtin_amdgcn_exp2f(v)
  #define GAPB(MF,X,B) do{ MF; X[B]=EX(X[B]); X[B+1]=EX(X[B+1]); X[B+2]=EX(X[B+2]); X[B+3]=EX(X[B+3]); PIN(X); SBAR(); }while(0)
  #define VRD(i) do{ vlo[i]=vtr(vp_+(((i)>>2)*4096+((i)&3)*1024)); vhi[i]=vtr(vp_+(((i)>>2)*4096+((i)&3)*1024+512)); }while(0)
  #define KRD(G,j) do{ if(G){ kload2(kf,kp0+sl_next,j); SBAR(); } }while(0)
  #define STEP(C0,C1,P0,P1,t,GK,GV,GL) do{ SBAR(); \
    const lds_cptr vp_=vp0+sl_prev; \
    ldbias(C0,C1,csp0+(t)*256,negm1); PIN(C0); PIN(C1); SBAR(); \
    VRD(0); SBAR(); float sacc=(P0[0]+P0[1]); \
    GAPA(C0=__builtin_amdgcn_mfma_f32_32x32x16_bf16(kf[0],qr[0],C0,0,0,0), P0[2],P0[3],P0[4],P0[5],     pw0[0]=PKW(P0,0), pw0[1]=PKW(P0,2), pw0); \
    VRD(4); SBAR(); GAPA(C1=__builtin_amdgcn_mfma_f32_32x32x16_bf16(kf[1],qr[0],C1,0,0,0), P0[6],P0[7],P0[8],P0[9],     pw0[2]=PKW(P0,4), pw0[3]=PKW(P0,6), pw0); \
    VRD(1); SBAR(); GAPA(C0=__builtin_amdgcn_mfma_f32_32x32x16_bf16(kf[2],qr[1],C0,0,0,0),   P0[10],P0[11],P0[12],P0[13], pw1[0]=PKW(P0,8), pw1[1]=PKW(P0,10), pw1); \
    VRD(5); SBAR(); GAPA(C1=__builtin_amdgcn_mfma_f32_32x32x16_bf16(kf[3],qr[1],C1,0,0,0),   P0[14],P0[15],P1[0],P1[1],   pw1[2]=PKW(P0,12),pw1[3]=PKW(P0,14), pw1); \
    VRD(2); SBAR(); GAPA(C0=__builtin_amdgcn_mfma_f32_32x32x16_bf16(kf[4],qr[2],C0,0,0,0),   P1[2],P1[3],P1[4],P1[5],     pw2[0]=PKW(P1,0), pw2[1]=PKW(P1,2), pw2); \
    VRD(6); SBAR(); GAPA(C1=__builtin_amdgcn_mfma_f32_32x32x16_bf16(kf[5],qr[2],C1,0,0,0),   P1[6],P1[7],P1[8],P1[9],     pw2[2]=PKW(P1,4), pw2[3]=PKW(P1,6), pw2); \
    VRD(3); SBAR(); GAPA(C0=__builtin_amdgcn_mfma_f32_32x32x16_bf16(kf[6],qr[3],C0,0,0,0),   P1[10],P1[11],P1[12],P1[13], pw3[0]=PKW(P1,8), pw3[1]=PKW(P1,10), pw3); \
    VRD(7); SBAR(); GAPA(C1=__builtin_amdgcn_mfma_f32_32x32x16_bf16(kf[7],qr[3],C1,0,0,0),   P1[14],P1[15],0.f,0.f,       pw3[2]=PKW(P1,12),pw3[3]=PKW(P1,14), pw3); \
    l_reg+=sacc; \
    if(GK){DMA_K((t)+3,sl_cur);} if(GV){DMA_V((t)+1,sl_next);} \
    CMASK(C0,C1,t); \
    { float a=MX3(C0[0],C0[1],C1[0]),b=MX3(C0[2],C0[3],C1[1]); a=MX3(a,C1[2],C1[3]); \
      _Pragma("unroll") for(int r=4;r<16;r+=4){a=MX3(a,C0[r],C0[r+1]);b=MX3(b,C0[r+2],C0[r+3]);a=MX3(a,C1[r],C1[r+1]);b=MX3(b,C1[r+2],C1[r+3]);} \
      float rm=__builtin_fmaxf(a,b); { auto rr=__builtin_amdgcn_permlane32_swap(__float_as_uint(rm),__float_as_uint(rm),false,false); rm=__builtin_fmaxf(__uint_as_float(rr[0]),__uint_as_float(rr[1])); } \
      resc=false; \
      if(__builtin_expect(__any(rm>(float)THRL),0)){ const float dl=__builtin_fmaxf(rm,0.f); mhat+=dl; \
        _Pragma("unroll") for(int r=0;r<16;++r){C0[r]-=dl;C1[r]-=dl;} \
        negm1=-mhat; \
        const float f=__builtin_amdgcn_exp2f(-dl); l_reg*=f; if(hi==0)wsf[r32]=f; resc=true; } } \
    SBAR(); \
    GAPB(o[0]=__builtin_amdgcn_mfma_f32_32x32x16_bf16(PAF(0),VFR(0),o[0],0,0,0), C0,0); \
    GAPB(o[1]=__builtin_amdgcn_mfma_f32_32x32x16_bf16(PAF(0),VFR(4),o[1],0,0,0), C0,4); \
    KRD(GL,0); GAPB(o[0]=__builtin_amdgcn_mfma_f32_32x32x16_bf16(PAF(1),VFR(1),o[0],0,0,0), C0,8); \
    KRD(GL,1); GAPB(o[1]=__builtin_amdgcn_mfma_f32_32x32x16_bf16(PAF(1),VFR(5),o[1],0,0,0), C0,12); \
    KRD(GL,2); GAPB(o[0]=__builtin_amdgcn_mfma_f32_32x32x16_bf16(PAF(2),VFR(2),o[0],0,0,0), C1,0); \
    KRD(GL,3); GAPB(o[1]=__builtin_amdgcn_mfma_f32_32x32x16_bf16(PAF(2),VFR(6),o[1],0,0,0), C1,4); \
    GAPB(o[0]=__builtin_amdgcn_mfma_f32_32x32x16_bf16(PAF(3),VFR(3),o[0],0,0,0), C1,8); \
    GAPB(o[1]=__builtin_amdgcn_mfma_f32_32x32x16_bf16(PAF(3),VFR(7),o[1],0,0,0), C1,12); \
    }while(0)
  int t=1;
  #undef CMASK
  #define CMASK(P0,P1,t) do{}while(0)
  for(;t+5<NT;t+=2){
    STEP(pB0,pB1,pA0,pA1,t,true,true,true);     WAIT_BAR(2); RESC(); ROT();
    STEP(pA0,pA1,pB0,pB1,t+1,true,true,true);   WAIT_BAR(2); RESC(); ROT();
  }
  #undef CMASK
  #define CMASK(P0,P1,t) do{int jb_=(t)-(NT-4); if(jb_>=0)cmask(P0,P1,jb_,qrel,hi);}while(0)
  #define ENDW(tt) do{ if((tt)+3<NT){WAIT_BAR(2);} else if((tt)+2<NT){WAIT_BAR(1);} else {WAIT_BAR(0);} }while(0)
  for(;t+1<NT;t+=2){
    STEP(pB0,pB1,pA0,pA1,t,(t+3<NT),(t+1<NT),(t+1<NT));       ENDW(t);   RESC(); ROT();
    STEP(pA0,pA1,pB0,pB1,t+1,(t+4<NT),(t+2<NT),(t+2<NT));     ENDW(t+1); RESC(); ROT();
  }
  STEP(pB0,pB1,pA0,pA1,NT-1,false,false,false); RESC();
  { float sacc=pB0[0]+pB0[1]; _Pragma("unroll") for(int r=2;r<16;++r)sacc+=pB0[r]; _Pragma("unroll") for(int r=0;r<16;++r)sacc+=pB1[r]; l_reg+=sacc;
    pw0=(u32x4){PKW(pB0,0),PKW(pB0,2),PKW(pB0,4),PKW(pB0,6)};pw1=(u32x4){PKW(pB0,8),PKW(pB0,10),PKW(pB0,12),PKW(pB0,14)};pw2=(u32x4){PKW(pB1,0),PKW(pB1,2),PKW(pB1,4),PKW(pB1,6)};pw3=(u32x4){PKW(pB1,8),PKW(pB1,10),PKW(pB1,12),PKW(pB1,14)};
    SBAR(); pv(o,vb0+sl_cur,PAF(0),PAF(1),PAF(2),PAF(3)); }
  #undef PKW
  #undef PAF
  #undef VFR
  #undef PIN
  #undef MX3
  #undef GAPA
  #undef GAPB
  #undef EX
  #undef VRD
  #undef KRD
  #undef STEP
  #undef ENDW
  {auto rr=__builtin_amdgcn_permlane32_swap(__float_as_uint(l_reg),__float_as_uint(l_reg),false,false);l_reg=__uint_as_float(rr[0])+__uint_as_float(rr[1]);}
  if(hi==0)wsf[32+r32]=l_reg;asm volatile("s_waitcnt lgkmcnt(0)":::"memory");
  float rli[16];
  #pragma unroll
  for(int r=0;r<16;++r)rli[r]=__builtin_amdgcn_rcpf(wsf[32+crow(r,hi)]);
  bf16*Ow=O+(rowbase+q0+wid*QBLK)*DM+h*D;
  { bf16*stg=(bf16*)(shm+LDS_OST)+wid*2048;
    #pragma unroll
    for(int r=0;r<16;++r){const int orow=crow(r,hi);
      #pragma unroll
      for(int d0=0;d0<2;++d0)stg[orow*64+d0*32+r32]=__float2bfloat16(o[d0][r]*rli[r]);}
    asm volatile("s_waitcnt lgkmcnt(0)":::"memory");
    #pragma unroll
    for(int i=0;i<4;++i){const int row=i*8+(lane>>3),ch=lane&7; const u32x4 v=*(const u32x4*)(stg+row*64+ch*8); ATTN_STORE16(Ow+(long)row*DM+ch*8,v);} }
  asm volatile("s_waitcnt lgkmcnt(0)\n\ts_barrier":::"memory");
  #undef DMA_K
  #undef DMA_V
  #undef CMASK
  #undef START
  #undef RESC
  #undef ROT
}
constexpr int ATTN_LDS_BYTES=LDS_BYTES;
#undef SBAR
#undef WAIT_BAR
}

constexpr int NWAVES = 8;
constexpr int BATCH = 4, SEQ = 8192, D = 1024, NH = 16, HD = 64, FF0 = 2816, FFE = 3584, NE = 8;
constexpr int T = BATCH * SEQ;
constexpr int NWIN = 3 * D + NH;
constexpr float RMS_EPS = 1e-6f;
constexpr int MAXRT = 264, MAXROWS = MAXRT * 256;
constexpr int CHUNK_RT = 128;
constexpr int MAXCHUNK = 2;
constexpr float WGU_PRESCALE = 32.f, WD_PRESCALE = 64.f;
constexpr int PH_PRO = 0, PH_POOL = 1, PH_THA = 2, PH_GU0 = 3, PH_DN0 = 4, PH_THB = 5, PH_QKV = 6, PH_ATT = 7, PH_WO = 8, PH_THC = 9, PH_PERM = 10, PH_MOE = 11, PH_FIN = PH_MOE + 2 * MAXCHUNK, N_PH = PH_FIN + 1;
static_assert(N_PH == 16, "phase count");

constexpr size_t MiB = 1u << 20;
constexpr size_t WS_CTL = 0, CTL_ZERO_BYTES = 1 * MiB;
constexpr size_t WS_WPOOL = 1 * MiB;
constexpr size_t WS_WFT = WS_WPOOL + 512 * 1024;
constexpr size_t WS_WRT = WS_WFT + 64 * 1024;
constexpr size_t WS_RTPOS = 2 * MiB;
constexpr size_t WS_RTG = WS_RTPOS + 256 * 1024;
constexpr size_t WS_LOGF = 3 * MiB;
constexpr size_t WS_NCS = 5 * MiB;
constexpr size_t WS_WIN = 8 * MiB;
constexpr size_t WS_WOUT = 14 * MiB;
constexpr size_t WS_WGU0 = 16 * MiB;
constexpr size_t WS_WD0 = 27 * MiB;
constexpr size_t WS_WGU = 34 * MiB;
constexpr size_t WS_WD = 90 * MiB;
constexpr size_t WS_H = 118 * MiB;
constexpr size_t WS_R = 182 * MiB;
constexpr size_t WS_YB = WS_R, WS_ACT0 = WS_R + 64 * MiB;
constexpr size_t WS_Q = WS_R, WS_K = WS_R + 64 * MiB, WS_V = WS_R + 128 * MiB, WS_YATT = WS_K;
constexpr size_t WS_HS = WS_R;
constexpr size_t WS_YS = WS_R + 66 * MiB;
constexpr size_t WS_ACTC = WS_YS + 132 * MiB;
constexpr size_t WS_END = WS_ACTC + 119 * MiB;
static_assert(WS_WD0 + (size_t)D * FF0 * 2 <= WS_WGU && WS_WGU + (size_t)NE * 2 * FFE * D <= WS_WD && WS_WD + (size_t)NE * D * FFE <= WS_H && WS_ACT0 + (size_t)T * FF0 * 2 <= WS_END &&
              WS_HS + (size_t)MAXROWS * D <= WS_YS && WS_ACTC + (size_t)(MAXRT - CHUNK_RT) * 256 * FFE <= WS_END && WS_END <= 512 * MiB, "ws map");
constexpr int CW_TMO = 0, CW_CODE = 1, CW_BAR = 4096, CW_CNT = 16384, CW_AQ = 20480, CW_CQ = 20480 + 256, CW_MAXQ = 24576, CW_MAXK = 24576 + 64;

constexpr int RING_OFF = 0, RING_BYTES = 131072;
constexpr int LDSCTL_OFF = RING_BYTES, MISC_OFF = LDSCTL_OFF + 320;
constexpr int LDS_BYTES = 147456;
static_assert(MISC_OFF + 128 <= LDS_BYTES && attn_body::ATTN_LDS_BYTES <= RING_BYTES, "LDS map");

#define GAS __attribute__((address_space(1)))
#define LAS __attribute__((address_space(3)))
typedef unsigned short bf16;
typedef unsigned v4u __attribute__((ext_vector_type(4)));
typedef unsigned v2u __attribute__((ext_vector_type(2)));
typedef float f32x4 __attribute__((ext_vector_type(4)));
typedef float f32x2 __attribute__((ext_vector_type(2)));
typedef GAS unsigned gu32;
#define RLX_AGENT __ATOMIC_RELAXED, __HIP_MEMORY_SCOPE_AGENT
#define LDS_WAIT() asm volatile("s_waitcnt lgkmcnt(0)" ::: "memory")
#define VM_WAIT() asm volatile("s_waitcnt vmcnt(0)" ::: "memory")
__device__ __forceinline__ unsigned f2bf(float f) { unsigned u = __builtin_bit_cast(unsigned, f); return (u + 0x7fffu + ((u >> 16) & 1u)) >> 16; }
__device__ __forceinline__ unsigned pk2(float lo, float hi) { return f2bf(lo) | (f2bf(hi) << 16); }
__device__ __forceinline__ float bf_lo(unsigned w) { return __builtin_bit_cast(float, w << 16); }
__device__ __forceinline__ float bf_hi(unsigned w) { return __builtin_bit_cast(float, w & 0xffff0000u); }

#define XB_TMO      128
#define XB_XCNT(j)  (256  + 64 * (j))
#define XB_XSUB(j)  (1280 + 64 * (j))
#define XB_XGEN(j)  (2304 + 64 * (j))
#define XB_TOP      3328
#define XB_TOPGEN   3392
#define XCD_BAR_WORDS 3456
#define XB_SPIN_CAP (1u << 18)
__device__ __forceinline__ unsigned xb_ld(unsigned* p)              { return __hip_atomic_load(p, __ATOMIC_RELAXED, __HIP_MEMORY_SCOPE_AGENT); }
__device__ __forceinline__ unsigned xb_add(unsigned* p, unsigned v) { return __hip_atomic_fetch_add(p, v, __ATOMIC_RELAXED, __HIP_MEMORY_SCOPE_AGENT); }
__device__ __forceinline__ unsigned xb_xcc_id() { return (unsigned)__builtin_amdgcn_s_getreg((3 << 11) | 20) & 0xFu; }
#define XB_SPIN(cond, bar) do { unsigned _sp = 0; while (cond) { __builtin_amdgcn_s_sleep(1); \
    if ((++_sp & 255u) == 0u) { if (xb_ld(&(bar)[XB_TMO])) break; if (_sp > XB_SPIN_CAP) { atomicAdd(&(bar)[XB_TMO], 1u); break; } } } } while (0)
struct XcdBarrier { unsigned* bar; unsigned x; volatile LAS unsigned* st; };
__device__ __forceinline__ XcdBarrier xcd_barrier_post(unsigned* bar, volatile LAS unsigned* st) {
    XcdBarrier b; b.bar = bar; b.x = xb_xcc_id(); b.st = st;
    if (threadIdx.x == 0) (void)xb_add(&bar[XB_XCNT(b.x)], 1u);
    return b;
}
__device__ __forceinline__ void xcd_barrier_complete(unsigned* bar, unsigned x, unsigned& nloc, unsigned& nx) {
    const unsigned G = gridDim.x * gridDim.y * gridDim.z;
    unsigned sum, cnt, mine, sp = 0u;
    for (;;) {
        sum = 0u; cnt = 0u; mine = 0u;
#pragma unroll
        for (unsigned j = 0; j < 16; ++j) { const unsigned c = xb_ld(&bar[XB_XCNT(j)]); sum += c; cnt += (c > 0u) ? 1u : 0u; mine = (j == x) ? c : mine; }
        if (sum == G) break;
        __builtin_amdgcn_s_sleep(1);
        if ((++sp & 255u) == 0u) { if (xb_ld(&bar[XB_TMO])) break; if (sp > XB_SPIN_CAP) { atomicAdd(&bar[XB_TMO], 1u); break; } }
    }
    nloc = mine > 0u ? mine : 1u; nx = cnt > 0u ? cnt : 1u;
}
__device__ __forceinline__ void xcd_barrier(const XcdBarrier& b) {
    asm volatile("s_waitcnt vmcnt(0)" ::: "memory");
    __syncthreads();
    if (threadIdx.x == 0) {
        unsigned* bar = b.bar;
        __builtin_amdgcn_s_waitcnt(0);
        unsigned nloc = b.st[0], nx = b.st[1];
        if (nloc == 0u) { xcd_barrier_complete(bar, b.x, nloc, nx); b.st[0] = nloc; b.st[1] = nx; }
        const unsigned old = xb_add(&bar[XB_XSUB(b.x)], 1u);
        const unsigned gen = old / nloc;
        if (old + 1u == (gen + 1u) * nloc) {
            __builtin_amdgcn_fence(__ATOMIC_RELEASE, "agent");
            asm volatile("s_waitcnt vmcnt(0)" ::: "memory");
            const unsigned og = xb_add(&bar[XB_TOP], 1u);
            const unsigned tg = og / nx;
            if (og + 1u == (tg + 1u) * nx) xb_add(&bar[XB_TOPGEN], 1u);
            else XB_SPIN(xb_ld(&bar[XB_TOPGEN]) == tg, bar);
            __builtin_amdgcn_fence(__ATOMIC_ACQUIRE, "agent");
            xb_add(&bar[XB_XGEN(b.x)], 1u);
            asm volatile("s_waitcnt vmcnt(0)" ::: "memory");
        } else {
            XB_SPIN(xb_ld(&bar[XB_XGEN(b.x)]) == gen, bar);
            __builtin_amdgcn_fence(__ATOMIC_ACQUIRE, "agent");
            asm volatile("s_waitcnt vmcnt(0)" ::: "memory");
        }
    }
    __syncthreads();
}

struct Frame {
    LAS unsigned char* lds;
    volatile LAS unsigned* MISC;
    gu32* ctl;
    int tid, lane, wave;
    int vcu, G;
    unsigned char* ws;
};
__device__ __forceinline__ float wave_sum(float v) {
#pragma unroll
    for (int o = 1; o < 64; o <<= 1) v += __shfl_xor(v, o);
    return v;
}
__device__ __forceinline__ void load_row_f32(const float* p, int lane, f32x4 (&v)[4]) {
#pragma unroll
    for (int j = 0; j < 4; ++j) v[j] = ((const f32x4*)p)[64 * j + lane];
}
__device__ __forceinline__ void store_row_f32(float* p, int lane, const f32x4 (&v)[4]) {
#pragma unroll
    for (int j = 0; j < 4; ++j) ((f32x4*)p)[64 * j + lane] = v[j];
}
__device__ __forceinline__ void load_row_bf16(const bf16* p, int lane, f32x4 (&v)[4]) {
#pragma unroll
    for (int j = 0; j < 4; ++j) { const v2u w = ((const v2u*)p)[64 * j + lane]; v[j] = (f32x4){bf_lo(w.x), bf_hi(w.x), bf_lo(w.y), bf_hi(w.y)}; }
}
__device__ __forceinline__ void store_row_bf16(bf16* p, int lane, const f32x4 (&v)[4]) {
#pragma unroll
    for (int j = 0; j < 4; ++j) { v2u w; w.x = pk2(v[j].x, v[j].y); w.y = pk2(v[j].z, v[j].w); ((v2u*)p)[64 * j + lane] = w; }
}
__device__ __forceinline__ float row_rstd(const f32x4 (&v)[4]) {
    float s = 0.f;
#pragma unroll
    for (int j = 0; j < 4; ++j) s += (v[j].x * v[j].x + v[j].y * v[j].y) + (v[j].z * v[j].z + v[j].w * v[j].w);
    s = wave_sum(s);
    return 1.0f / sqrtf(s * (1.0f / D) + RMS_EPS);
}

__device__ __forceinline__ void p0_transpose_item(const float* W, int ldw, int k0, int n0, bf16* dst, int dK, int drow0, LAS unsigned* scr, int lane) {
    const int nq = lane & 15, kr = lane >> 4;
#pragma unroll 4
    for (int it = 0; it < 8; ++it) { const int kp = it * 4 + kr;
        const f32x4 a = *(const f32x4*)(W + (size_t)(k0 + 2 * kp) * ldw + n0 + 4 * nq), b = *(const f32x4*)(W + (size_t)(k0 + 2 * kp + 1) * ldw + n0 + 4 * nq);
        scr[(4 * nq + 0) * 33 + kp] = pk2(a.x, b.x); scr[(4 * nq + 1) * 33 + kp] = pk2(a.y, b.y); scr[(4 * nq + 2) * 33 + kp] = pk2(a.z, b.z); scr[(4 * nq + 3) * 33 + kp] = pk2(a.w, b.w); }
    LDS_WAIT(); asm volatile("" ::: "memory");
    const int c = lane & 7;
#pragma unroll
    for (int ps = 0; ps < 8; ++ps) { const int n = (lane >> 3) + 8 * ps; const LAS unsigned* s = scr + n * 33 + 4 * c;
        v4u o; o.x = s[0]; o.y = s[1]; o.z = s[2]; o.w = s[3];
        *(v4u*)(dst + (size_t)(drow0 + n) * dK + k0 + 8 * c) = o; }
    LDS_WAIT(); asm volatile("" ::: "memory");
}
__device__ __forceinline__ void p0_transpose_item8(const float* W, int ldw, int k0, int n0, unsigned char* dst, int dK, int drow0, float scale, LAS unsigned* scr, int lane) {
    const int nq = lane & 15, kr = lane >> 4;
#pragma unroll 2
    for (int it = 0; it < 8; ++it) { const int k4 = it * 4 + kr; const float* p = W + (size_t)(k0 + 4 * k4) * ldw + n0 + 4 * nq;
        const f32x4 a = *(const f32x4*)p * scale, b = *(const f32x4*)(p + ldw) * scale, c = *(const f32x4*)(p + 2 * (size_t)ldw) * scale, d = *(const f32x4*)(p + 3 * (size_t)ldw) * scale;
        scr[(4 * nq + 0) * 33 + k4] = pg8::pk4_fp8(a.x, b.x, c.x, d.x); scr[(4 * nq + 1) * 33 + k4] = pg8::pk4_fp8(a.y, b.y, c.y, d.y);
        scr[(4 * nq + 2) * 33 + k4] = pg8::pk4_fp8(a.z, b.z, c.z, d.z); scr[(4 * nq + 3) * 33 + k4] = pg8::pk4_fp8(a.w, b.w, c.w, d.w); }
    LDS_WAIT(); asm volatile("" ::: "memory");
    const int c = lane & 7;
#pragma unroll
    for (int ps = 0; ps < 8; ++ps) { const int n = (lane >> 3) + 8 * ps; const LAS unsigned* s = scr + n * 33 + 4 * c;
        v4u o; o.x = s[0]; o.y = s[1]; o.z = s[2]; o.w = s[3];
        *(v4u*)(dst + (size_t)(drow0 + n) * dK + k0 + 16 * c) = o; }
    LDS_WAIT(); asm volatile("" ::: "memory");
}
struct In { const float *x, *norm_g, *pool_w, *pool_scale, *w_in, *b_f, *w_out, *w_gate, *w_up, *w_down, *w_router, *mw_gate, *mw_up, *mw_down; };

constexpr int MOE_CONV_UNITS = NE * 3 * 448 / 32;
__device__ __forceinline__ void moe_conv_unit(Frame& F, const In& I, int cu) {
    LAS unsigned* scr = (LAS unsigned*)(F.lds + RING_OFF + F.wave * 16384);
    unsigned char* const wgu = F.ws + WS_WGU; unsigned char* const wd = F.ws + WS_WD;
#pragma unroll 1
    for (int k = 0; k < 4; ++k) {
        int r = cu * 32 + F.wave * 4 + k; const int e = r / 1344; r -= e * 1344;
        if (r < 896) { const int up = r >= 448; if (up) r -= 448; const int kb = r / 56, nb = r % 56, n0 = 64 * nb;
            p0_transpose_item8((up ? I.mw_up : I.mw_gate) + (size_t)e * D * FFE, FFE, 128 * kb, n0, wgu + (size_t)e * 2 * FFE * D, D, ((n0 >> 7) << 8) + (n0 & 127) + (up ? 128 : 0), WGU_PRESCALE, scr, F.lane); }
        else { r -= 896; const int kb = r / 16, nb = r % 16; p0_transpose_item8(I.mw_down + (size_t)e * FFE * D, D, 128 * kb, 64 * nb, wd + (size_t)e * D * FFE, FFE, 64 * nb, WD_PRESCALE, scr, F.lane); }
    }
}
__device__ __forceinline__ void p0_prologue(Frame& F, const In& I) {
    LAS unsigned* scr = (LAS unsigned*)(F.lds + RING_OFF + F.wave * 16384);
    const int gw = F.vcu * NWAVES + F.wave, NGW = F.G * NWAVES;
    constexpr int I_POOL = 4 * 4 * 4, I_WIN = 16 * 48, I_WOUT = 16 * 16, I_G0 = 16 * 44, I_D0 = 44 * 16;
    constexpr int NITEMS = I_POOL + I_WIN + I_WOUT + 2 * I_G0 + I_D0;
    bf16* const wpool = (bf16*)(F.ws + WS_WPOOL); bf16* const win = (bf16*)(F.ws + WS_WIN); bf16* const wout = (bf16*)(F.ws + WS_WOUT);
    bf16* const wgu0 = (bf16*)(F.ws + WS_WGU0); bf16* const wd0 = (bf16*)(F.ws + WS_WD0);
    for (int it = gw; it < NITEMS; it += NGW) {
        int r = it;
        if (r < I_POOL) { const int g = r >> 4, q = r & 15, kb = q >> 2, nb = q & 3; p0_transpose_item(I.pool_w + (size_t)g * 65536, 256, 64 * kb, 64 * nb, wpool + (size_t)g * 65536, 256, 64 * nb, scr, F.lane); continue; } r -= I_POOL;
        if (r < I_WIN) { const int kb = r / 48, nb = r % 48; p0_transpose_item(I.w_in, NWIN, 64 * kb, 64 * nb, win, D, 64 * nb, scr, F.lane); continue; } r -= I_WIN;
        if (r < I_WOUT) { const int kb = r / 16, nb = r % 16; p0_transpose_item(I.w_out, D, 64 * kb, 64 * nb, wout, D, 64 * nb, scr, F.lane); continue; } r -= I_WOUT;
        if (r < 2 * I_G0) { const int up = r >= I_G0; if (up) r -= I_G0; const int kb = r / 44, nb = r % 44, n0 = 64 * nb;
            p0_transpose_item(up ? I.w_up : I.w_gate, FF0, 64 * kb, n0, wgu0, D, ((n0 >> 7) << 8) + (n0 & 127) + (up ? 128 : 0), scr, F.lane); continue; } r -= 2 * I_G0;
        { const int kb = r / 16, nb = r % 16; p0_transpose_item(I.w_down, D, 64 * kb, 64 * nb, wd0, FF0, 64 * nb, scr, F.lane); }
    }
    { float* wft = (float*)(F.ws + WS_WFT); float* wrt = (float*)(F.ws + WS_WRT); const int gt = F.vcu * (NWAVES * 64) + F.tid, NGT = F.G * NWAVES * 64;
      for (int i = gt; i < 16 * D; i += NGT) { const int j = i / D, c = i % D; wft[i] = I.w_in[(size_t)c * NWIN + 3 * D + j]; }
      for (int i = gt; i < NE * D; i += NGT) { const int e = i / D, c = i % D; wrt[i] = I.w_router[(size_t)c * NE + e]; } }
    __syncthreads();
    LAS float* rs = (LAS float*)(F.lds + RING_OFF);
    bf16* const Hb = (bf16*)(F.ws + WS_H);
    for (int tile = F.vcu; tile < T / 128; tile += F.G) {
        const int hh = F.tid >> 8, t0 = tile * 128 + hh * 64, tb0 = t0 & (SEQ - 1);
        const int hw = F.wave & 3;
        for (int r = hw; r < 79; r += 4) { const int tb = tb0 - 15 + r; float rv = 0.f;
            if (tb >= 0) { f32x4 v[4]; load_row_f32(I.x + (size_t)(t0 - 15 + r) * D, F.lane, v); rv = row_rstd(v); }
            if (F.lane == 0) rs[hh * 80 + r] = rv; }
        __syncthreads();
        { const int tl = F.tid & 255, c4 = tl;
          const int w = 2 << (tl >> 6);
          const f32x4 g = ((const f32x4*)I.norm_g)[c4];
          const float* xc = I.x + 4 * c4; const LAS float* rsh = rs + hh * 80 + 15;
          f32x4 Sx = (f32x4){0.f, 0.f, 0.f, 0.f};
          for (int i = 1 - w; i < 0; ++i) { if (tb0 + i >= 0) { const f32x4 xv = *(const f32x4*)(xc + (size_t)(t0 + i) * D); Sx += xv * (g * rsh[i]); } }
#pragma unroll 4
          for (int i = 0; i < 64; ++i) {
              const f32x4 xv = *(const f32x4*)(xc + (size_t)(t0 + i) * D); const f32x4 hv = xv * (g * rsh[i]);
              Sx += hv;
              const int tb = tb0 + i; const float inv = 1.0f / (float)((tb + 1 < w) ? (tb + 1) : w);
              const f32x4 pv_ = Sx * inv - hv;
              v2u o; o.x = pk2(pv_.x, pv_.y); o.y = pk2(pv_.z, pv_.w);
              *(v2u*)(Hb + (size_t)(t0 + i) * D + 4 * c4) = o;
              const int io = i - w + 1;
              if (tb0 + io >= 0) { const f32x4 xo = *(const f32x4*)(xc + (size_t)(t0 + io) * D); Sx -= xo * (g * rsh[io]); }
          } }
        __syncthreads();
    }
}

__device__ __forceinline__ void row_rstd2(const f32x4 (&a)[4], const f32x4 (&b)[4], float& ra, float& rb) {
    float s = 0.f, t = 0.f;
#pragma unroll
    for (int j = 0; j < 4; ++j) { s += (a[j].x * a[j].x + a[j].y * a[j].y) + (a[j].z * a[j].z + a[j].w * a[j].w); t += (b[j].x * b[j].x + b[j].y * b[j].y) + (b[j].z * b[j].z + b[j].w * b[j].w); }
#pragma unroll
    for (int o = 1; o < 64; o <<= 1) { s += __shfl_xor(s, o); t += __shfl_xor(t, o); }
    ra = 1.0f / sqrtf(s * (1.0f / D) + RMS_EPS); rb = 1.0f / sqrtf(t * (1.0f / D) + RMS_EPS);
}
template <int MODE>
__device__ __forceinline__ void thin_phase(Frame& F, const In& I, const bf16* Y, const float* xin, float* xout, const float* gpost_p, const float* gpre_p) {
    bf16* const Hb = (bf16*)(F.ws + WS_H);
    LAS float* wl = (LAS float*)(F.lds + RING_OFF);
    LAS unsigned* rte = (LAS unsigned*)(F.lds + RING_OFF + 65536);
    LAS float* rtg = (LAS float*)(F.lds + RING_OFF + 65536 + 512);
    LAS unsigned* wtot = (LAS unsigned*)(F.lds + RING_OFF + 65536 + 2048);
    if (MODE == 1) { const f32x4* src = (const f32x4*)(F.ws + WS_WFT); for (int i = F.tid; i < 16 * D / 4; i += NWAVES * 64) ((LAS f32x4*)wl)[i] = src[i]; }
    if (MODE == 2) { const f32x4* src = (const f32x4*)(F.ws + WS_WRT); for (int i = F.tid; i < NE * D / 4; i += NWAVES * 64) ((LAS f32x4*)wl)[i] = src[i]; }
    f32x4 gpost[4], gpre[4];
    load_row_f32(gpost_p, F.lane, gpost); load_row_f32(gpre_p, F.lane, gpre);
    __syncthreads();
    for (int tile = F.vcu; tile < T / 128; tile += F.G) {
        const int mb = tile * 128 + F.wave * 16;
        f32x4 ynA[4], xnA[4], ynB[4], xnB[4];
        load_row_bf16(Y + (size_t)mb * D, F.lane, ynA); load_row_f32(xin + (size_t)mb * D, F.lane, xnA);
        load_row_bf16(Y + (size_t)(mb + 1) * D, F.lane, ynB); load_row_f32(xin + (size_t)(mb + 1) * D, F.lane, xnB);
#pragma unroll 1
        for (int i = 0; i < 16; i += 2) {
            const int m = mb + i, tl = F.wave * 16 + i;
            f32x4 yA[4], xA[4], yB[4], xB[4];
#pragma unroll
            for (int j = 0; j < 4; ++j) { yA[j] = ynA[j]; xA[j] = xnA[j]; yB[j] = ynB[j]; xB[j] = xnB[j]; }
            if (i + 2 < 16) { load_row_bf16(Y + (size_t)(m + 2) * D, F.lane, ynA); load_row_f32(xin + (size_t)(m + 2) * D, F.lane, xnA);
                              load_row_bf16(Y + (size_t)(m + 3) * D, F.lane, ynB); load_row_f32(xin + (size_t)(m + 3) * D, F.lane, xnB); }
            float r1A, r1B; row_rstd2(yA, yB, r1A, r1B);
#pragma unroll
            for (int j = 0; j < 4; ++j) { xA[j] += yA[j] * r1A * gpost[j]; xB[j] += yB[j] * r1B * gpost[j]; }
            store_row_f32(xout + (size_t)m * D, F.lane, xA); store_row_f32(xout + (size_t)(m + 1) * D, F.lane, xB);
            float r2A, r2B; row_rstd2(xA, xB, r2A, r2B);
#pragma unroll
            for (int j = 0; j < 4; ++j) { xA[j] = xA[j] * r2A * gpre[j]; xB[j] = xB[j] * r2B * gpre[j]; }
            if (MODE == 2) {
#pragma unroll
                for (int j = 0; j < 4; ++j) { ((unsigned*)((unsigned char*)Hb + (size_t)m * D))[64 * j + F.lane] = pg8::pk4_fp8(xA[j].x, xA[j].y, xA[j].z, xA[j].w);
                                              ((unsigned*)((unsigned char*)Hb + (size_t)(m + 1) * D))[64 * j + F.lane] = pg8::pk4_fp8(xB[j].x, xB[j].y, xB[j].z, xB[j].w); }
            } else { store_row_bf16(Hb + (size_t)m * D, F.lane, xA); store_row_bf16(Hb + (size_t)(m + 1) * D, F.lane, xB); }
            if (MODE == 1) {
                float zA = 0.f, zB = 0.f;
#pragma unroll 2
                for (int q = 0; q < 16; ++q) { float s = 0.f, t = 0.f;
#pragma unroll
                    for (int j = 0; j < 4; ++j) { const f32x4 w = ((const LAS f32x4*)wl)[q * 256 + 64 * j + F.lane];
                        s += (xA[j].x * w.x + xA[j].y * w.y) + (xA[j].z * w.z + xA[j].w * w.w); t += (xB[j].x * w.x + xB[j].y * w.y) + (xB[j].z * w.z + xB[j].w * w.w); }
#pragma unroll
                    for (int o = 1; o < 64; o <<= 1) { s += __shfl_xor(s, o); t += __shfl_xor(t, o); }
                    if (F.lane == q) { zA = s; zB = t; } }
                if (F.lane < 16) { const float bf = I.b_f[F.lane]; zA += bf; zB += bf;
                    ((float*)(F.ws + WS_LOGF))[(size_t)m * 16 + F.lane] = fminf(zA, 0.f) - log1pf(expf(-fabsf(zA)));
                    ((float*)(F.ws + WS_LOGF))[(size_t)(m + 1) * 16 + F.lane] = fminf(zB, 0.f) - log1pf(expf(-fabsf(zB))); }
            }
            if (MODE == 2) {
                float lgA[8], lgB[8];
#pragma unroll
                for (int q = 0; q < 8; ++q) { float s = 0.f, t = 0.f;
#pragma unroll
                    for (int j = 0; j < 4; ++j) { const f32x4 w = ((const LAS f32x4*)wl)[q * 256 + 64 * j + F.lane];
                        s += (xA[j].x * w.x + xA[j].y * w.y) + (xA[j].z * w.z + xA[j].w * w.w); t += (xB[j].x * w.x + xB[j].y * w.y) + (xB[j].z * w.z + xB[j].w * w.w); }
#pragma unroll
                    for (int o = 1; o < 64; o <<= 1) { s += __shfl_xor(s, o); t += __shfl_xor(t, o); }
                    lgA[q] = s; lgB[q] = t; }
#pragma unroll
                for (int rr = 0; rr < 2; ++rr) {
                    int e1 = 0; float v1 = rr ? lgB[0] : lgA[0];
#pragma unroll
                    for (int q = 1; q < 8; ++q) { const float v = rr ? lgB[q] : lgA[q]; if (v > v1) { v1 = v; e1 = q; } }
                    int e2 = -1; float v2 = -INFINITY;
#pragma unroll
                    for (int q = 0; q < 8; ++q) { const float v = rr ? lgB[q] : lgA[q]; if (q != e1 && v > v2) { v2 = v; e2 = q; } }
                    const float ex = expf(v2 - v1), g1 = 1.0f / (1.0f + ex), g2 = ex * g1;
                    if (F.lane == 0) { rte[tl + rr] = (unsigned)e1 | ((unsigned)e2 << 8); rtg[2 * (tl + rr)] = g1; rtg[2 * (tl + rr) + 1] = g2; }
                }
            }
        }
        if (MODE == 2) {
            __syncthreads();
            unsigned e1 = 0, e2 = 0, r1 = 0, r2 = 0; const int tl = F.tid;
            if (F.wave < 2) { const unsigned w = rte[tl]; e1 = w & 255u; e2 = w >> 8;
                const unsigned long long lt = (1ull << F.lane) - 1ull;
#pragma unroll
                for (unsigned e = 0; e < 8; ++e) { const unsigned long long m1 = __ballot(e1 == e), m2 = __ballot(e2 == e);
                    if (e1 == e) r1 = (unsigned)__popcll(m1 & lt); if (e2 == e) r2 = (unsigned)(__popcll(m1) + __popcll(m2 & lt));
                    if (F.lane == 0) wtot[F.wave * 8 + e] = (unsigned)(__popcll(m1) + __popcll(m2)); } }
            __syncthreads();
            if (F.tid < 8) { const unsigned n = wtot[F.tid] + wtot[8 + F.tid]; wtot[16 + F.tid] = __hip_atomic_fetch_add(F.ctl + CW_CNT + 64 * F.tid, n, RLX_AGENT); }
            __syncthreads();
            if (F.wave < 2) { const int m = tile * 128 + tl;
                const unsigned p1 = wtot[16 + e1] + (F.wave ? wtot[e1] : 0u) + r1, p2 = wtot[16 + e2] + (F.wave ? wtot[e2] : 0u) + r2;
                v2u pp; pp.x = (e1 << 20) | p1; pp.y = (e2 << 20) | p2; ((v2u*)(F.ws + WS_RTPOS))[m] = pp;
                ((f32x2*)(F.ws + WS_RTG))[m] = (f32x2){rtg[2 * tl], rtg[2 * tl + 1]}; }
            __syncthreads();
        }
    }
}

__device__ __forceinline__ void moe_offsets(Frame& F) {
    if (F.tid == 0) { unsigned acc = 0u;
        for (int e = 0; e < NE; ++e) { F.MISC[12 + e] = acc; const unsigned c = __hip_atomic_load(F.ctl + CW_CNT + 64 * e, RLX_AGENT); acc += (c + 255u) >> 8; }
        F.MISC[12 + NE] = acc; F.MISC[10] = acc; }
    __syncthreads();
}
__device__ __forceinline__ void permute_phase(Frame& F) {
    moe_offsets(F);
    const unsigned char* Hb = F.ws + WS_H; unsigned char* HS = F.ws + WS_HS;
    const int gw = F.vcu * NWAVES + F.wave, NGW = F.G * NWAVES;
    for (int mb = gw * 16; mb < T; mb += NGW * 16) {
        unsigned d1 = 0u, d2 = 0u;
        if (F.lane < 16) { v2u pp = ((const v2u*)(F.ws + WS_RTPOS))[mb + F.lane];
            const unsigned e1 = pp.x >> 20, e2 = pp.y >> 20; d1 = F.MISC[12 + e1] * 256u + (pp.x & 0xfffffu); d2 = F.MISC[12 + e2] * 256u + (pp.y & 0xfffffu);
            pp.x = d1; pp.y = d2; ((v2u*)(F.ws + WS_RTPOS))[mb + F.lane] = pp; }
#pragma unroll 1
        for (int i = 0; i < 16; i += 8) {
            v4u a[8];
#pragma unroll
            for (int k = 0; k < 8; ++k) a[k] = ((const v4u*)(Hb + (size_t)(mb + i + k) * D))[F.lane];
#pragma unroll
            for (int k = 0; k < 8; ++k) { const unsigned p1 = (unsigned)__shfl((int)d1, i + k), p2 = (unsigned)__shfl((int)d2, i + k);
                ((v4u*)(HS + (size_t)p1 * D))[F.lane] = a[k]; ((v4u*)(HS + (size_t)p2 * D))[F.lane] = a[k]; }
        }
    }
    int k = 0;
    for (int e = 0; e < NE; ++e) { const unsigned c = __hip_atomic_load(F.ctl + CW_CNT + 64 * e, RLX_AGENT); const unsigned r0 = F.MISC[12 + e] * 256u + c, r1 = F.MISC[13 + e] * 256u;
        for (unsigned r = r0; r < r1; ++r, ++k) if ((k % NGW) == gw) { const v4u z = (v4u){0u, 0u, 0u, 0u}; ((v4u*)(HS + (size_t)r * D))[F.lane] = z; } }
}
__device__ __forceinline__ void final_phase(Frame& F, const In& I, float* xio) {
    const bf16* YS = (const bf16*)(F.ws + WS_YS);
    f32x4 gp[4]; load_row_f32(I.norm_g + (size_t)(1 * 4 + 3) * D, F.lane, gp);
    for (int tile = F.vcu; tile < T / 128; tile += F.G) {
        const int mb = tile * 128 + F.wave * 16;
        v2u pp = (v2u){0u, 0u}; f32x2 gg = (f32x2){0.f, 0.f};
        if (F.lane < 16) { pp = ((const v2u*)(F.ws + WS_RTPOS))[mb + F.lane]; gg = ((const f32x2*)(F.ws + WS_RTG))[mb + F.lane]; }
        f32x4 anA[4], bnA[4], xnA[4], anB[4], bnB[4], xnB[4];
        load_row_bf16(YS + (size_t)(unsigned)__shfl((int)pp.x, 0) * D, F.lane, anA); load_row_bf16(YS + (size_t)(unsigned)__shfl((int)pp.y, 0) * D, F.lane, bnA); load_row_f32(xio + (size_t)mb * D, F.lane, xnA);
        load_row_bf16(YS + (size_t)(unsigned)__shfl((int)pp.x, 1) * D, F.lane, anB); load_row_bf16(YS + (size_t)(unsigned)__shfl((int)pp.y, 1) * D, F.lane, bnB); load_row_f32(xio + (size_t)(mb + 1) * D, F.lane, xnB);
#pragma unroll 1
        for (int i = 0; i < 16; i += 2) {
            const int m = mb + i;
            f32x4 aA[4], xA[4], aB[4], xB[4];
            const float g1A = __shfl(gg.x, i), g2A = __shfl(gg.y, i), g1B = __shfl(gg.x, i + 1), g2B = __shfl(gg.y, i + 1);
#pragma unroll
            for (int j = 0; j < 4; ++j) { aA[j] = anA[j] * g1A + bnA[j] * g2A; aB[j] = anB[j] * g1B + bnB[j] * g2B; xA[j] = xnA[j]; xB[j] = xnB[j]; }
            if (i + 2 < 16) {
                load_row_bf16(YS + (size_t)(unsigned)__shfl((int)pp.x, i + 2) * D, F.lane, anA); load_row_bf16(YS + (size_t)(unsigned)__shfl((int)pp.y, i + 2) * D, F.lane, bnA); load_row_f32(xio + (size_t)(m + 2) * D, F.lane, xnA);
                load_row_bf16(YS + (size_t)(unsigned)__shfl((int)pp.x, i + 3) * D, F.lane, anB); load_row_bf16(YS + (size_t)(unsigned)__shfl((int)pp.y, i + 3) * D, F.lane, bnB); load_row_f32(xio + (size_t)(m + 3) * D, F.lane, xnB); }
            float rA, rB; row_rstd2(aA, aB, rA, rB);
#pragma unroll
            for (int j = 0; j < 4; ++j) { xA[j] += aA[j] * rA * gp[j]; xB[j] += aB[j] * rB * gp[j]; }
            store_row_f32(xio + (size_t)m * D, F.lane, xA); store_row_f32(xio + (size_t)(m + 1) * D, F.lane, xB);
        }
    }
}
__device__ __forceinline__ void scan_phase(Frame& F, int bh) {
    const int b = bh / NH, h = bh % NH; const float* lf = (const float*)(F.ws + WS_LOGF) + (size_t)b * SEQ * 16 + h; float* ncs = (float*)(F.ws + WS_NCS) + (size_t)bh * SEQ;
    LAS float* part = (LAS float*)(F.lds + RING_OFF);
    float v[16]; float s = 0.f; const int s0 = F.tid * 16;
#pragma unroll
    for (int i = 0; i < 16; ++i) { v[i] = lf[(size_t)(s0 + i) * 16]; s += v[i]; }
    float incl = s;
#pragma unroll
    for (int o = 1; o < 64; o <<= 1) { const float t = __shfl_up(incl, o); if (F.lane >= o) incl += t; }
    if (F.lane == 63) part[F.wave] = incl;
    __syncthreads();
    float base = incl - s;
    for (int w = 0; w < F.wave; ++w) base += part[w];
    float run = base;
#pragma unroll
    for (int i = 0; i < 16; i += 4) { f32x4 o4; run += v[i]; o4.x = -1.4426950408889634f * run; run += v[i + 1]; o4.y = -1.4426950408889634f * run; run += v[i + 2]; o4.z = -1.4426950408889634f * run; run += v[i + 3]; o4.w = -1.4426950408889634f * run;
        *(f32x4*)(ncs + s0 + i) = o4; }
    __syncthreads();
}

__device__ __forceinline__ bool attn_next(int vcu, int G, int i, int& bh, int& qb) {
    if (G == 256) { if (i >= 8) return false; const int s = vcu & 3; bh = vcu >> 2; const int base = 8 * (i >> 1); qb = (i & 1) ? base + 7 - s : base + s; return true; }
    const int u = vcu + i * G; if (u >= 64 * 32) return false; bh = u >> 5; qb = 31 - (u & 31); return true;
}

struct Args { const float* in[14]; float* out; unsigned char* ws; int ph_lo, ph_hi; };
__global__ void __launch_bounds__(NWAVES * 64, 2) trunk_fwd(Args args) {
    extern __shared__ __attribute__((aligned(16))) unsigned char lds[];
    Frame F;
    F.lds = (LAS unsigned char*)lds;
    F.MISC = (volatile LAS unsigned*)(F.lds + MISC_OFF);
    F.tid = threadIdx.x; F.lane = F.tid & 63; F.wave = __builtin_amdgcn_readfirstlane(F.tid >> 6);
    F.G = gridDim.x; { const int bx = blockIdx.x; F.vcu = (F.G % 8 == 0) ? (bx % 8) * (F.G / 8) + bx / 8 : bx; }
    F.ws = args.ws; F.ctl = (gu32*)(args.ws + WS_CTL);
    const __attribute__((address_space(4))) Args* const ka = (const __attribute__((address_space(4))) Args*)__builtin_amdgcn_kernarg_segment_ptr();
#define KA_IN(i) ((const float*)*(const float* const volatile __attribute__((address_space(4)))*)&ka->in[i])
#define LOAD_IN() In I; I.x = KA_IN(0); I.norm_g = KA_IN(1); I.pool_w = KA_IN(2); I.pool_scale = KA_IN(3); I.w_in = KA_IN(4); I.b_f = KA_IN(5); I.w_out = KA_IN(6); \
    I.w_gate = KA_IN(7); I.w_up = KA_IN(8); I.w_down = KA_IN(9); I.w_router = KA_IN(10); I.mw_gate = KA_IN(11); I.mw_up = KA_IN(12); I.mw_down = KA_IN(13); \
    float* const out = (float*)*(float* const volatile __attribute__((address_space(4)))*)&ka->out; (void)out; (void)I; RELAUNDER()
#define RELAUNDER() do { int t_ = threadIdx.x; asm volatile("" : "+v"(t_)); F.tid = t_; F.lane = t_ & 63; } while (0)
    unsigned char* const ws = args.ws;
    for (int u = F.tid; u < (LDS_BYTES - LDSCTL_OFF) / 4; u += NWAVES * 64) ((LAS unsigned*)(F.lds + LDSCTL_OFF))[u] = 0u;
    __syncthreads();
    XcdBarrier bar; bar.bar = (unsigned*)(F.ctl + CW_BAR); bar.x = 0; bar.st = nullptr;
#if !MK_PER_PHASE
    bar = xcd_barrier_post((unsigned*)(F.ctl + CW_BAR), F.MISC + 8);
#endif
    const int lo = args.ph_lo, hi = args.ph_hi;
#define IN(k) (lo <= (k) && (k) < hi)
#ifndef MK_REPEAT
#define MK_REPEAT (-1)
#endif
#define PHASE(k) for (int rep_ = 0; rep_ < ((MK_REPEAT == (k)) ? 2 : 1); ++rep_) if (rep_ ? (xcd_barrier(bar), true) : true) if (IN(k))
#define SEAM(k) do { if (IN(k) && IN((k) + 1)) { xcd_barrier(bar); } } while (0)
    const int cblk = (int)blockIdx.x;

    PHASE(PH_PRO) { LOAD_IN(); p0_prologue(F, I); } SEAM(PH_PRO);

    PHASE(PH_POOL) {
        LOAD_IN();
        pg8::GemmK g{256, D, 256};
        pg8::DenseOrder S{T / 256, 4, (T / 256) * 4, F.G, cblk, (const char*)(ws + WS_H), (const char*)(ws + WS_WPOOL), (size_t)256 * D * 2, (size_t)256 * 2, (size_t)256 * 256 * 2};
        pg8::EpiBf16 E{(bf16*)(ws + WS_YB), D, I.pool_scale, 0, 0, 1.f};
        pg8::gemm_phase<pg8::EpiBf16, pg8::DenseOrder, true>(F.lds + RING_OFF, g, S, E);
    } SEAM(PH_POOL);

    PHASE(PH_THA) { LOAD_IN(); thin_phase<0>(F, I, (const bf16*)(ws + WS_YB), I.x, out, I.norm_g + 1 * D, I.norm_g + 2 * D); } SEAM(PH_THA);

    PHASE(PH_GU0) {
        pg8::GemmK g{D, D, D};
        pg8::DenseOrder S{T / 256, FF0 / 128, (T / 256) * (FF0 / 128), F.G, cblk, (const char*)(ws + WS_H), (const char*)(ws + WS_WGU0), (size_t)256 * D * 2, 0, (size_t)256 * D * 2};
        pg8::EpiSwiGLU E{(bf16*)(ws + WS_ACT0), FF0};
        pg8::gemm_phase<pg8::EpiSwiGLU, pg8::DenseOrder, true>(F.lds + RING_OFF, g, S, E);
    } SEAM(PH_GU0);

    PHASE(PH_DN0) {
        pg8::GemmK g{FF0, FF0, FF0};
        pg8::DenseOrder S{T / 256, D / 256, (T / 256) * (D / 256), F.G, cblk, (const char*)(ws + WS_ACT0), (const char*)(ws + WS_WD0), (size_t)256 * FF0 * 2, 0, (size_t)256 * FF0 * 2};
        pg8::EpiBf16 E{(bf16*)(ws + WS_YB), D, nullptr, 0, 0, 1.f};
        pg8::gemm_phase<pg8::EpiBf16, pg8::DenseOrder, true>(F.lds + RING_OFF, g, S, E);
    } SEAM(PH_DN0);

    PHASE(PH_THB) { LOAD_IN(); thin_phase<1>(F, I, (const bf16*)(ws + WS_YB), out, out, I.norm_g + 3 * D, I.norm_g + 4 * D); } SEAM(PH_THB);

    PHASE(PH_QKV) {
        RELAUNDER();
        for (int bh = cblk; bh < BATCH * NH; bh += F.G) scan_phase(F, bh);
        pg8::GemmK g{D, D, D};
        pg8::DenseOrder S{T / 256, 12, (T / 256) * 12, F.G, cblk, (const char*)(ws + WS_H), (const char*)(ws + WS_WIN), (size_t)256 * D * 2, 0, (size_t)256 * D * 2};
        pg8::EpiQKV E{(bf16*)(ws + WS_Q), D, (size_t)(WS_K - WS_Q) / 2, attn_body::C2, (unsigned*)(F.ctl + CW_MAXQ), (unsigned*)(F.ctl + CW_MAXK)};
        pg8::gemm_phase<pg8::EpiQKV, pg8::DenseOrder, true>(F.lds + RING_OFF, g, S, E);
    } SEAM(PH_QKV);

    PHASE(PH_ATT) {
        RELAUNDER();
        LOAD_IN();
        unsigned nxt = 0u;
        if (F.tid == 0) { nxt = __hip_atomic_fetch_add(F.ctl + CW_AQ + 64 * rep_, 1u, RLX_AGENT); F.MISC[11] = nxt; }
        __syncthreads();
        unsigned cur = (unsigned)__builtin_amdgcn_readfirstlane((int)F.MISC[11]);
        bool conv_left = true; int k_att = 0;
        for (;;) {
            const bool have_att = cur < (unsigned)(BATCH * NH * 32);
            if (have_att) {
            if (F.tid == 0) nxt = __hip_atomic_fetch_add(F.ctl + CW_AQ + 64 * rep_, 1u, RLX_AGENT);
            const int qb = 31 - (int)(cur >> 6), bh = (int)(cur & 63u), q0 = qb * 256, NT = (q0 + 256) / 64;
            const float* ncs = (const float*)(ws + WS_NCS) + (size_t)bh * SEQ;
            const float mq = __uint_as_float(__hip_atomic_load(F.ctl + CW_MAXQ + bh, RLX_AGENT)), mk = __uint_as_float(__hip_atomic_load(F.ctl + CW_MAXK + bh, RLX_AGENT));
            const float theta = 4.08f * mq * mk + 40.f;
            const int j = 2 * F.lane + 1; bool skip = false;
            if (j + 5 <= NT) skip = (ncs[q0] - ncs[64 * j + 63]) >= theta;
            const int tstart = 2 * (int)__popcll(__ballot(skip));
            attn_body::attn_unit<24>(bh / NH, bh % NH, qb, tstart, (const attn_body::bf16*)(ws + WS_Q), (const attn_body::bf16*)(ws + WS_K), (const attn_body::bf16*)(ws + WS_V), (attn_body::bf16*)(ws + WS_H),
                                     (const float*)(ws + WS_NCS), (char*)lds + RING_OFF);
            if (F.tid == 0) F.MISC[11] = nxt;
            ++k_att;
            }
            const bool want_conv = conv_left && (!have_att || (k_att & 3) == 0);
            if (want_conv && F.tid == 0) F.MISC[21] = __hip_atomic_fetch_add(F.ctl + CW_CQ + 64 * rep_, 1u, RLX_AGENT);
            __syncthreads();
            cur = (unsigned)__builtin_amdgcn_readfirstlane((int)F.MISC[11]);
            if (want_conv) {
                const unsigned cu = (unsigned)__builtin_amdgcn_readfirstlane((int)F.MISC[21]);
                if (cu < (unsigned)MOE_CONV_UNITS) moe_conv_unit(F, I, (int)cu); else conv_left = false;
                __syncthreads();
            }
            if (!have_att && !conv_left) break;
        }
    } SEAM(PH_ATT);

    PHASE(PH_WO) {
        pg8::GemmK g{D, D, D};
        pg8::DenseOrder S{T / 256, D / 256, (T / 256) * (D / 256), F.G, cblk, (const char*)(ws + WS_H), (const char*)(ws + WS_WOUT), (size_t)256 * D * 2, 0, (size_t)256 * D * 2};
        pg8::EpiBf16 E{(bf16*)(ws + WS_YATT), D, nullptr, 0, 0, 1.f};
        pg8::gemm_phase<pg8::EpiBf16, pg8::DenseOrder, true>(F.lds + RING_OFF, g, S, E);
    } SEAM(PH_WO);

    PHASE(PH_THC) { LOAD_IN(); thin_phase<2>(F, I, (const bf16*)(ws + WS_YATT), out, out, I.norm_g + 5 * D, I.norm_g + 6 * D); } SEAM(PH_THC);

    PHASE(PH_PERM) { RELAUNDER(); permute_phase(F); } SEAM(PH_PERM);

    if (hi > PH_MOE && lo < PH_FIN) {
        RELAUNDER();
        moe_offsets(F);
        const int nRT = (int)F.MISC[10];
        for (int c = 0; c < MAXCHUNK; ++c) {
            const int rt0 = c * CHUNK_RT; int nM = nRT - rt0; if (c == 0 && nM > CHUNK_RT) nM = CHUNK_RT;
            PHASE(PH_MOE + 2 * c) if (nM > 0) {
                pg8::GemmK g{D / 2, D / 2, D / 2};
                pg8::MoeOrder S{rt0, nM, FFE / 128, nM * (FFE / 128), F.G, cblk, (const char*)(ws + WS_HS), (size_t)256 * D, 0, (const char*)(ws + WS_WGU), (size_t)2 * FFE * D, (size_t)256 * D, 0, (const LAS unsigned*)(F.lds + MISC_OFF + 48)};
                pg8::EpiSwiGLU8 E{ws + WS_ACTC, FFE, 1.0f / WGU_PRESCALE};
                pg8::gemm_phase<pg8::EpiSwiGLU8, pg8::MoeOrder, true, true>(F.lds + RING_OFF, g, S, E);
            }
            SEAM(PH_MOE + 2 * c);
            PHASE(PH_MOE + 2 * c + 1) if (nM > 0) {
                pg8::GemmK g{FFE / 2, FFE / 2, FFE / 2};
                pg8::MoeOrder S{rt0, nM, D / 256, nM * (D / 256), F.G, cblk, (const char*)(ws + WS_ACTC), (size_t)256 * FFE, 1, (const char*)(ws + WS_WD), (size_t)D * FFE, (size_t)256 * FFE, 1, (const LAS unsigned*)(F.lds + MISC_OFF + 48)};
                pg8::EpiBf16 E{(bf16*)(ws + WS_YS), D, nullptr, 0, 0, 1.0f / WD_PRESCALE};
                pg8::gemm_phase<pg8::EpiBf16, pg8::MoeOrder, true, true>(F.lds + RING_OFF, g, S, E);
            }
            SEAM(PH_MOE + 2 * c + 1);
        }
    }

    PHASE(PH_FIN) { LOAD_IN(); final_phase(F, I, out); }
#undef IN
#undef SEAM
}

extern "C" void kernel_launch(void* const* d_in, const int* in_sizes, int n_in, void* d_out, int out_size, void* d_ws, size_t ws_size, hipStream_t stream) {
    static int grid = 0;
    if (grid == 0) {
        if (n_in != 14 || in_sizes[0] != T * D || out_size != T * D || ws_size < WS_END) { fprintf(stderr, "kernel_launch: unexpected shapes (n_in %d, in0 %d, out %d, ws %zu); nothing launched\n", n_in, n_in > 0 ? in_sizes[0] : -1, out_size, ws_size); grid = -1; return; }
        int dev = 0, cus = 0, per_cu = 0;
        if (hipGetDevice(&dev) != hipSuccess || hipDeviceGetAttribute(&cus, hipDeviceAttributeMultiprocessorCount, dev) != hipSuccess) { grid = -1; return; }
        if (hipFuncSetAttribute((const void*)trunk_fwd, hipFuncAttributeMaxDynamicSharedMemorySize, LDS_BYTES) != hipSuccess) { fprintf(stderr, "kernel_launch: hipFuncSetAttribute failed\n"); grid = -1; return; }
        if (hipOccupancyMaxActiveBlocksPerMultiprocessor(&per_cu, (const void*)trunk_fwd, NWAVES * 64, LDS_BYTES) != hipSuccess || per_cu < 1)
            fprintf(stderr, "kernel_launch: note: occupancy query reports %d workgroups per CU\n", per_cu);
        (void)hipGetLastError();
        grid = cus;
    }
    if (grid < 0) return;
    if (hipMemsetAsync((char*)d_ws + WS_CTL, 0, CTL_ZERO_BYTES, stream) != hipSuccess) return;
    Args a{};
    for (int i = 0; i < 14; ++i) a.in[i] = (const float*)d_in[i];
    a.out = (float*)d_out; a.ws = (unsigned char*)d_ws;
#if MK_PER_PHASE
    for (int p = 0; p < MK_LAST_PHASE; ++p) { a.ph_lo = p; a.ph_hi = p + 1; hipLaunchKernelGGL(trunk_fwd, dim3(grid), dim3(NWAVES * 64), LDS_BYTES, stream, a); }
#else
    a.ph_lo = 0; a.ph_hi = MK_LAST_PHASE;
    hipLaunchKernelGGL(trunk_fwd, dim3(grid), dim3(NWAVES * 64), LDS_BYTES, stream, a);
#endif
}
```

```cpp
#include <hip/hip_runtime.h>
#include <hip/hip_bf16.h>
#include <cstdio>
#include <cstdint>
#include <cmath>

#ifndef MK_PER_PHASE
#define MK_PER_PHASE 0
#endif
#ifndef MK_LAST_PHASE
#define MK_LAST_PHASE 15
#endif

namespace pg8 {
#define PG8_LAS __attribute__((address_space(3)))
typedef unsigned short bf16_t;
typedef short bf16x8 __attribute__((ext_vector_type(8)));
typedef float f32x4 __attribute__((ext_vector_type(4)));
typedef unsigned u32x4 __attribute__((ext_vector_type(4)));
constexpr int BM = 256, BK = 64, HALF = 128, HTB = HALF * BK * 2, STAGE_BYTES = 8 * HTB, NXCD = 8, WGM = 8;

__host__ __device__ __forceinline__ int lds_byte(int r, int c) { const int st = (r >> 4) * 2 + (c >> 5), rr = r & 15, cc = c & 31, ob = rr * 64 + cc * 2; return st * 1024 + (ob ^ (((ob >> 9) & 1) << 5)); }
__host__ __device__ __forceinline__ void stage_rc(int b, int& R, int& C) { const int st = b / 1024, sb = b % 1024, swz = sb ^ (((sb >> 9) & 1) << 5); R = (st >> 1) * 16 + swz / 64; C = (st & 1) * 32 + (swz % 64) / 2; }
__host__ __device__ __forceinline__ int perm32(int rho) { const int n = rho >> 4, i = rho & 15; return 8 * (i >> 2) + 4 * n + (i & 3); }

struct Unit { int pm, pn; const char* A; const char* B; };
struct GemmK { int K, lda, ldb; };

__device__ __forceinline__ void tile_of(int wgid_in, int nM, int nN, int& pm, int& pn) {
    const int nwg = nM * nN; int wgid = wgid_in;
    { const int q = nwg / NXCD, r = nwg % NXCD, xcd = wgid % NXCD, off = wgid / NXCD; wgid = (xcd < r ? xcd * (q + 1) : r * (q + 1) + (xcd - r) * q) + off; }
    const int nig = WGM * nN, gid = wgid / nig, fm = gid * WGM, gsz = (nM - fm) < WGM ? (nM - fm) : WGM;
    pm = fm + ((wgid % nig) % gsz); pn = (wgid % nig) / gsz;
}
struct DenseOrder {
    int nM, nN, nwg, G, c; const char* A; const char* B; size_t a_tile, a_pn, b_tile;
    __device__ __forceinline__ bool next(int i, Unit& u) const {
        const long L = (long)i * G + c; if (L >= nwg) return false;
        int pm, pn; tile_of((int)L, nM, nN, pm, pn);
        u.pm = pm; u.pn = pn; u.A = A + (size_t)pm * a_tile + (size_t)pn * a_pn; u.B = B + (size_t)pn * b_tile; return true;
    }
};
struct MoeOrder {
    int rt0, nM, nN, nwg, G, c; const char* A; size_t a_tile; int a_local; const char* B; size_t b_exp, b_tile; int pm_global; const PG8_LAS unsigned* toff;
    __device__ __forceinline__ bool next(int i, Unit& u) const {
        const long L = (long)i * G + c; if (L >= nwg) return false;
        int pm, pn; tile_of((int)L, nM, nN, pm, pn);
        const int rt = rt0 + pm; int e = 0;
#pragma unroll
        for (int j = 1; j < 8; ++j) e += ((unsigned)rt >= toff[j]) ? 1 : 0;
        e = __builtin_amdgcn_readfirstlane(e);
        u.pm = pm_global ? rt : pm; u.pn = pn; u.A = A + (size_t)(a_local ? pm : rt) * a_tile; u.B = B + (size_t)e * b_exp + (size_t)pn * b_tile; return true;
    }
};

__device__ __forceinline__ unsigned cvt_pk_bf16(float lo, float hi) { unsigned r; asm volatile("v_cvt_pk_bf16_f32 %0, %1, %2" : "=v"(r) : "v"(lo), "v"(hi)); return r; }

struct EpiBf16 {
    static constexpr bool PERM = true;
    bf16_t* O; int ldc; const float* cscale; int split_cols; size_t split_stride; float scale0;
    __device__ __forceinline__ void operator()(const f32x4 (&acc)[2][2][4][2], const Unit& u, int wr, int wc, int fr, int fq) const {
        const int row0 = u.pm * BM + wr * 64 + fr; int colt = u.pn * BM; bf16_t* base = O;
        float sc = split_cols ? 1.f : scale0; if (split_cols) { const int t = colt / split_cols; base += (size_t)t * split_stride; colt -= t * split_cols; if (t == 0) sc = scale0; }
        const int col0 = colt + wc * 32 + 8 * fq, scol0 = u.pn * BM + wc * 32 + 8 * fq;
        f32x4 sv[2][2];
#pragma unroll
        for (int bj = 0; bj < 2; ++bj)
#pragma unroll
            for (int n = 0; n < 2; ++n) { sv[bj][n] = cscale ? *(const f32x4*)(cscale + scol0 + bj * HALF + 4 * n) : (f32x4){1.f, 1.f, 1.f, 1.f}; sv[bj][n] = sv[bj][n] * sc; }
#pragma unroll
        for (int ai = 0; ai < 2; ++ai)
#pragma unroll
            for (int m = 0; m < 4; ++m) { bf16_t* rowp = base + (size_t)(row0 + ai * HALF + m * 16) * ldc + col0;
#pragma unroll
                for (int bj = 0; bj < 2; ++bj) { const f32x4 v0 = acc[ai][bj][m][0] * sv[bj][0], v1 = acc[ai][bj][m][1] * sv[bj][1];
                    u32x4 w; w.x = cvt_pk_bf16(v0[0], v0[1]); w.y = cvt_pk_bf16(v0[2], v0[3]); w.z = cvt_pk_bf16(v1[0], v1[1]); w.w = cvt_pk_bf16(v1[2], v1[3]);
                    *(u32x4*)(rowp + bj * HALF) = w; } }
    }
};
struct EpiQKV {
    static constexpr bool PERM = true;
    bf16_t* O; int ldc; size_t split_stride; float scale0; unsigned* maxq; unsigned* maxk;
    __device__ __forceinline__ void operator()(const f32x4 (&acc)[2][2][4][2], const Unit& u, int wr, int wc, int fr, int fq) const {
        const int row0 = u.pm * BM + wr * 64 + fr; int colt = u.pn * BM; const int t = colt >> 10; bf16_t* base = O + (size_t)t * split_stride; colt -= t << 10;
        const float sc = (t == 0) ? scale0 : 1.f;
        const int col0 = colt + wc * 32 + 8 * fq;
        float nm0 = 0.f, nm1 = 0.f;
#pragma unroll
        for (int ai = 0; ai < 2; ++ai)
#pragma unroll
            for (int m = 0; m < 4; ++m) { bf16_t* rowp = base + (size_t)(row0 + ai * HALF + m * 16) * ldc + col0;
#pragma unroll
                for (int bj = 0; bj < 2; ++bj) { const f32x4 v0 = acc[ai][bj][m][0] * sc, v1 = acc[ai][bj][m][1] * sc;
                    u32x4 w; w.x = cvt_pk_bf16(v0[0], v0[1]); w.y = cvt_pk_bf16(v0[2], v0[3]); w.z = cvt_pk_bf16(v1[0], v1[1]); w.w = cvt_pk_bf16(v1[2], v1[3]);
                    *(u32x4*)(rowp + bj * HALF) = w;
                    if (t < 2) { float s = (v0[0] * v0[0] + v0[1] * v0[1]) + (v0[2] * v0[2] + v0[3] * v0[3]) + (v1[0] * v1[0] + v1[1] * v1[1]) + (v1[2] * v1[2] + v1[3] * v1[3]);
                        s += __shfl_xor(s, 16); s += __shfl_xor(s, 32); if (bj == 0) nm0 = fmaxf(nm0, s); else nm1 = fmaxf(nm1, s); } } }
        if (t < 2) {
#pragma unroll
            for (int o = 1; o < 16; o <<= 1) { nm0 = fmaxf(nm0, __shfl_xor(nm0, o)); nm1 = fmaxf(nm1, __shfl_xor(nm1, o)); }
            if ((threadIdx.x & 63) == 0) { unsigned* dst = (t == 0 ? maxq : maxk) + (u.pm >> 5) * 16 + 4 * (u.pn & 3) + (wc >> 1);
                __hip_atomic_fetch_max(dst, __float_as_uint(sqrtf(nm0)), __ATOMIC_RELAXED, __HIP_MEMORY_SCOPE_AGENT);
                __hip_atomic_fetch_max(dst + 2, __float_as_uint(sqrtf(nm1)), __ATOMIC_RELAXED, __HIP_MEMORY_SCOPE_AGENT); }
        }
    }
};
__device__ __forceinline__ float silu_mul(float g, float u) { const float e = __builtin_amdgcn_exp2f(g * -1.4426950408889634f); return g * __builtin_amdgcn_rcpf(1.0f + e) * u; }
struct EpiSwiGLU {
    static constexpr bool PERM = true;
    bf16_t* O; int ldc;
    __device__ __forceinline__ void operator()(const f32x4 (&acc)[2][2][4][2], const Unit& u, int wr, int wc, int fr, int fq) const {
        const int row0 = u.pm * BM + wr * 64 + fr, col0 = u.pn * HALF + wc * 32 + 8 * fq;
#pragma unroll
        for (int ai = 0; ai < 2; ++ai)
#pragma unroll
            for (int m = 0; m < 4; ++m) { bf16_t* rowp = O + (size_t)(row0 + ai * HALF + m * 16) * ldc + col0;
                const f32x4 g0 = acc[ai][0][m][0], g1 = acc[ai][0][m][1], u0 = acc[ai][1][m][0], u1 = acc[ai][1][m][1];
                u32x4 w; w.x = cvt_pk_bf16(silu_mul(g0[0], u0[0]), silu_mul(g0[1], u0[1])); w.y = cvt_pk_bf16(silu_mul(g0[2], u0[2]), silu_mul(g0[3], u0[3]));
                w.z = cvt_pk_bf16(silu_mul(g1[0], u1[0]), silu_mul(g1[1], u1[1])); w.w = cvt_pk_bf16(silu_mul(g1[2], u1[2]), silu_mul(g1[3], u1[3]));
                *(u32x4*)rowp = w; }
    }
};

__device__ __forceinline__ unsigned pk4_fp8(float a, float b, float c, float d) { int w = 0; w = __builtin_amdgcn_cvt_pk_fp8_f32(a, b, w, false); w = __builtin_amdgcn_cvt_pk_fp8_f32(c, d, w, true); return (unsigned)w; }
struct EpiSwiGLU8 {
    static constexpr bool PERM = true;
    unsigned char* O; int ldc; float ascale;
    __device__ __forceinline__ void operator()(const f32x4 (&acc)[2][2][4][2], const Unit& u, int wr, int wc, int fr, int fq) const {
        const int row0 = u.pm * BM + wr * 64 + fr, col0 = u.pn * HALF + wc * 32 + 8 * fq;
#pragma unroll
        for (int ai = 0; ai < 2; ++ai)
#pragma unroll
            for (int m = 0; m < 4; ++m) { unsigned char* rowp = O + (size_t)(row0 + ai * HALF + m * 16) * ldc + col0;
                const f32x4 g0 = acc[ai][0][m][0] * ascale, g1 = acc[ai][0][m][1] * ascale, u0 = acc[ai][1][m][0] * ascale, u1 = acc[ai][1][m][1] * ascale;
                typedef unsigned u32x2 __attribute__((ext_vector_type(2)));
                u32x2 w; w.x = pk4_fp8(silu_mul(g0[0], u0[0]), silu_mul(g0[1], u0[1]), silu_mul(g0[2], u0[2]), silu_mul(g0[3], u0[3]));
                w.y = pk4_fp8(silu_mul(g1[0], u1[0]), silu_mul(g1[1], u1[1]), silu_mul(g1[2], u1[2]), silu_mul(g1[3], u1[3]));
                *(u32x2*)rowp = w; }
    }
};

typedef int v4i_t __attribute__((ext_vector_type(4)));
typedef int v8i_t __attribute__((ext_vector_type(8)));
__device__ __forceinline__ v8i_t cat8(bf16x8 lo, bf16x8 hi) { const v4i_t a = __builtin_bit_cast(v4i_t, lo), b = __builtin_bit_cast(v4i_t, hi); return __builtin_shufflevector(a, b, 0, 1, 2, 3, 4, 5, 6, 7); }
template <class Epi, class Sched, bool ALIGN_EPI, bool F8 = false>
__device__ __forceinline__ void gemm_phase(PG8_LAS unsigned char* lds, const GemmK g, const Sched& S, const Epi& E) {
    int tid_ = threadIdx.x; asm volatile("" : "+v"(tid_));
    const int tid = tid_, wid = __builtin_amdgcn_readfirstlane(tid >> 6), lane = tid & 63, wr = wid >> 2, wc = wid & 3, fr = lane & 15, fq = lane >> 4;
    const int K = g.K, nt = K / BK;
    unsigned voffA[2], voffB[2];
#pragma unroll
    for (int i = 0; i < 2; ++i) { int R, C; stage_rc(tid * 16 + i * 8192, R, C); const int Rb = Epi::PERM ? ((R & ~31) + perm32(R & 31)) : R;
        voffA[i] = (unsigned)(R * g.lda + C) * 2u; voffB[i] = (unsigned)(Rb * g.ldb + C) * 2u; }
    const size_t kstep = (size_t)(BK * 2);
    const size_t hstepA = (size_t)HALF * g.lda * 2, hstepB = (size_t)HALF * g.ldb * 2;
    const unsigned ldsw = (unsigned)wid * 1024u;
    const unsigned ldsbase = (unsigned)__builtin_amdgcn_readfirstlane((int)(unsigned)(uintptr_t)lds);
    const int aoff = lds_byte(wr * 64 + fr, fq * 8), boff = lds_byte(wc * 32 + fr, fq * 8);
#define PG8_SA(b, h) (((b) * 2 + (h)) * HTB)
#define PG8_SB(b, h) ((4 + (b) * 2 + (h)) * HTB)
#define PG8_STAGE(bufoff, gbase, voff) do { _Pragma("unroll") for (int _i = 0; _i < 2; ++_i) { unsigned keep_; \
        asm volatile("s_mov_b32 %0, m0\n\ts_mov_b32 m0, %3\n\ts_nop 2\n\tglobal_load_lds_dwordx4 %1, %2\n\ts_mov_b32 m0, %0" \
            : "=&s"(keep_) : "v"((voff)[_i]), "s"((const char*)(gbase)), "s"(ldsbase + (unsigned)(bufoff) + ldsw + (unsigned)(_i * 8192)) : "memory"); } } while (0)
#define PG8_LDA(dst, b, h) do { _Pragma("unroll") for (int m = 0; m < 4; ++m) _Pragma("unroll") for (int k = 0; k < 2; ++k) dst[m][k] = *(const PG8_LAS bf16x8*)(lds + PG8_SA(b, h) + aoff + m * 2048 + k * 1024); } while (0)
#define PG8_LDB(dst, b, h) do { _Pragma("unroll") for (int n = 0; n < 2; ++n) _Pragma("unroll") for (int k = 0; k < 2; ++k) dst[n][k] = *(const PG8_LAS bf16x8*)(lds + PG8_SB(b, h) + boff + n * 2048 + k * 1024); } while (0)
#define PG8_MMA(ai, bj, At, Bt) do { __builtin_amdgcn_s_setprio(1); if constexpr (F8) { _Pragma("unroll") for (int m = 0; m < 4; ++m) _Pragma("unroll") for (int n = 0; n < 2; ++n) \
        acc[ai][bj][m][n] = __builtin_amdgcn_mfma_scale_f32_16x16x128_f8f6f4(cat8(Bt[n][0], Bt[n][1]), cat8(At[m][0], At[m][1]), acc[ai][bj][m][n], 0, 0, 0, 0, 0, 0); } \
        else { _Pragma("unroll") for (int m = 0; m < 4; ++m) _Pragma("unroll") for (int n = 0; n < 2; ++n) _Pragma("unroll") for (int k = 0; k < 2; ++k) \
        acc[ai][bj][m][n] = __builtin_amdgcn_mfma_f32_16x16x32_bf16(Bt[n][k], At[m][k], acc[ai][bj][m][n], 0, 0, 0); } __builtin_amdgcn_s_setprio(0); } while (0)
#define PG8_WAIT_V(n) asm volatile("s_waitcnt vmcnt(" #n ")" ::: "memory")
#define PG8_WAIT_L(n) asm volatile("s_waitcnt lgkmcnt(" #n ")" ::: "memory")
#define PG8_BAR __builtin_amdgcn_s_barrier()
#define PG8_SCHED __builtin_amdgcn_sched_barrier(0)
    Unit cur, nxt; int ui = 0;
    if (!S.next(0, cur)) return;
    f32x4 acc[2][2][4][2];
#pragma unroll
    for (int a = 0; a < 2; ++a)
#pragma unroll
        for (int b = 0; b < 2; ++b)
#pragma unroll
            for (int m = 0; m < 4; ++m)
#pragma unroll
                for (int n = 0; n < 2; ++n) acc[a][b][m][n] = (f32x4){0.f, 0.f, 0.f, 0.f};
    bf16x8 At[4][2], B0[2][2], B1[2][2];
    const char* cA = cur.A; const char* cB = cur.B;
    PG8_STAGE(PG8_SB(0, 0), cB, voffB); PG8_STAGE(PG8_SB(0, 1), cB + hstepB, voffB); PG8_STAGE(PG8_SA(0, 0), cA, voffA); PG8_STAGE(PG8_SA(0, 1), cA + hstepA, voffA);
    if (wr == 1) PG8_BAR;
    PG8_WAIT_V(2); PG8_BAR;
    PG8_STAGE(PG8_SB(1, 0), cB + kstep, voffB); PG8_STAGE(PG8_SA(1, 0), cA + kstep, voffA); PG8_STAGE(PG8_SB(1, 1), cB + hstepB + kstep, voffB);
    PG8_WAIT_V(6); PG8_BAR;
    for (;;) {
        const bool has_next = S.next(ui + 1, nxt);
        const char* nA = has_next ? nxt.A : cA; const char* nB = has_next ? nxt.B : cB;
#pragma unroll 1
        for (int t = 0; t < nt; t += 2) {
            const bool last = (t == nt - 2);
            const char* a1 = cA + (size_t)(t + 1) * kstep;
            const char* a2 = last ? nA : cA + (size_t)(t + 2) * kstep; const char* b2 = last ? nB : cB + (size_t)(t + 2) * kstep;
            const char* a3 = a2 + kstep; const char* b3 = b2 + kstep;
            PG8_LDB(B0, 0, 0); PG8_LDB(B1, 0, 1); PG8_SCHED; PG8_LDA(At, 0, 0); PG8_STAGE(PG8_SA(1, 1), a1 + hstepA, voffA);
            PG8_WAIT_V(8); PG8_WAIT_L(0); PG8_BAR; PG8_MMA(0, 0, At, B0); PG8_MMA(0, 1, At, B1); PG8_BAR; PG8_SCHED;
            PG8_LDA(At, 0, 1); PG8_STAGE(PG8_SB(0, 0), b2, voffB); PG8_STAGE(PG8_SB(0, 1), b2 + hstepB, voffB); PG8_STAGE(PG8_SA(0, 0), a2, voffA);
            PG8_WAIT_V(8); PG8_WAIT_L(0); PG8_BAR; PG8_MMA(1, 0, At, B0); PG8_MMA(1, 1, At, B1); PG8_BAR; PG8_SCHED;
            PG8_LDB(B0, 1, 0); PG8_LDB(B1, 1, 1); PG8_SCHED; PG8_LDA(At, 1, 0); PG8_STAGE(PG8_SA(0, 1), a2 + hstepA, voffA);
            PG8_WAIT_V(8); PG8_WAIT_L(0); PG8_BAR; PG8_MMA(0, 0, At, B0); PG8_MMA(0, 1, At, B1); PG8_BAR; PG8_SCHED;
            PG8_LDA(At, 1, 1); PG8_STAGE(PG8_SB(1, 0), b3, voffB); PG8_STAGE(PG8_SB(1, 1), b3 + hstepB, voffB); PG8_STAGE(PG8_SA(1, 0), a3, voffA);
            PG8_WAIT_V(8); PG8_WAIT_L(0); PG8_BAR; PG8_MMA(1, 0, At, B0); PG8_MMA(1, 1, At, B1); PG8_BAR; PG8_SCHED;
        }
        if constexpr (ALIGN_EPI) { if (wr == 0) PG8_BAR; }
        { int te_ = threadIdx.x; asm volatile("" : "+v"(te_));
          E(acc, cur, wr, wc, te_ & 15, (te_ >> 4) & 3); }
        if (!has_next) break;
#pragma unroll
        for (int a = 0; a < 2; ++a)
#pragma unroll
            for (int b = 0; b < 2; ++b)
#pragma unroll
                for (int m = 0; m < 4; ++m)
#pragma unroll
                    for (int n = 0; n < 2; ++n) acc[a][b][m][n] = (f32x4){0.f, 0.f, 0.f, 0.f};
        cur = nxt; cA = nA; cB = nB; ++ui;
        if constexpr (ALIGN_EPI) { if (wr == 1) PG8_BAR; }
    }
    PG8_WAIT_V(0);
    if constexpr (!ALIGN_EPI) { if (wr == 0) PG8_BAR; }
    PG8_BAR;
#undef PG8_SA
#undef PG8_SB
#undef PG8_STAGE
#undef PG8_LDA
#undef PG8_LDB
#undef PG8_MMA
#undef PG8_WAIT_V
#undef PG8_WAIT_L
#undef PG8_BAR
#undef PG8_SCHED
}
}

namespace attn_body {
using bf16=__hip_bfloat16;
using bf16x8=__attribute__((ext_vector_type(8)))short;
using s16x4=__attribute__((ext_vector_type(4)))short;
using f32x16=__attribute__((ext_vector_type(16)))float;
using f32x4v=__attribute__((ext_vector_type(4)))float;
using u32x4=__attribute__((ext_vector_type(4)))unsigned;
constexpr int BATCH=4,NHEAD=16,SEQ=8192,D=64,DM=NHEAD*D;
constexpr int NW=8,QBLK=32,QB=QBLK*NW,KVBLK=64,NQB=SEQ/QB;
__device__ __forceinline__ int crow(int r,int hi){return (r&3)+8*(r>>2)+4*hi;}
#define SBAR() __builtin_amdgcn_sched_barrier(0)
__device__ __forceinline__ void cmask(f32x16&p0,f32x16&p1,int jb,int qrel,int hi){
  const float NEG=-INFINITY; int kb=64*jb+4*hi;
  #pragma unroll
  for(int r=0;r<16;++r){int kv=kb+(r&3)+8*(r>>2); if(kv>qrel)p0[r]=NEG; if(kv+32>qrel)p1[r]=NEG;}
}
constexpr int NSLOT=3, SLOTB=8192;
constexpr int LDS_K=0, LDS_V=NSLOT*SLOTB, LDS_WS=2*NSLOT*SLOTB, LDS_OST=LDS_WS+NW*64*4, LDS_CS=LDS_OST+NW*4096, LDS_BYTES=LDS_CS+SEQ*4;
constexpr float C2=0.125f*1.4426950408889634f;
__device__ __forceinline__ void glds16(const void*gsrc,unsigned lds_dst){unsigned keep;
  asm volatile("s_mov_b32 %0, m0\n\ts_mov_b32 m0, %2\n\ts_nop 0\n\tglobal_load_lds_dwordx4 %1, off\n\ts_mov_b32 m0, %0":"=&s"(keep):"v"(gsrc),"s"(lds_dst):"memory");}
__device__ __forceinline__ float max3f(float a,float b,float c){float r;asm("v_max3_f32 %0, %1, %2, %3":"=v"(r):"v"(a),"v"(b),"v"(c));return r;}
__device__ __forceinline__ float max2f(float a,float b){float r;asm("v_max_f32_e32 %0, %1, %2":"=v"(r):"v"(a),"v"(b));return r;}
__device__ __forceinline__ float fadd_s(float a,float b){float r;asm("v_add_f32_e32 %0, %1, %2":"=v"(r):"v"(a),"v"(b));return r;}
__device__ __forceinline__ float fsub_s(float a,float b){float r;asm("v_sub_f32_e32 %0, %1, %2":"=v"(r):"v"(a),"v"(b));return r;}
typedef float f32x2_t __attribute__((ext_vector_type(2))); typedef __bf16 bf16x2_t __attribute__((ext_vector_type(2)));
__device__ __forceinline__ unsigned cvtpk_s(float lo,float hi){f32x2_t v={lo,hi};bf16x2_t b=__builtin_convertvector(v,bf16x2_t);return __builtin_bit_cast(unsigned,b);}
#define WAIT_BAR(N) asm volatile("s_waitcnt vmcnt(" #N ") lgkmcnt(0)\n\ts_barrier":::"memory")
typedef __attribute__((address_space(3))) const char* lds_cptr;
typedef short v4i16_t __attribute__((ext_vector_type(4)));
__device__ __forceinline__ void ldbias(f32x16&c0,f32x16&c1,lds_cptr csp,float negm){
  #pragma unroll
  for(int g=0;g<4;++g){ const f32x4v a=*(const __attribute__((address_space(3))) f32x4v*)(csp+g*32); const f32x4v b=*(const __attribute__((address_space(3))) f32x4v*)(csp+128+g*32);
    c0[4*g]=a[0]+negm;c0[4*g+1]=a[1]+negm;c0[4*g+2]=a[2]+negm;c0[4*g+3]=a[3]+negm; c1[4*g]=b[0]+negm;c1[4*g+1]=b[1]+negm;c1[4*g+2]=b[2]+negm;c1[4*g+3]=b[3]+negm; }
}
__device__ __forceinline__ void qkt(f32x16&p0,f32x16&p1,const char*Kslot,const bf16x8*qr,int r32,int hi){
  const char*kb=Kslot+hi*1024+r32*16;
  #pragma unroll
  for(int d0=0;d0<4;++d0){
    const bf16x8 b0=*reinterpret_cast<const bf16x8*>(kb+d0*2048);
    const bf16x8 b1=*reinterpret_cast<const bf16x8*>(kb+d0*2048+512);
    p0=__builtin_amdgcn_mfma_f32_32x32x16_bf16(b0,qr[d0],p0,0,0,0);p1=__builtin_amdgcn_mfma_f32_32x32x16_bf16(b1,qr[d0],p1,0,0,0);}
}
__device__ __forceinline__ void kload8(bf16x8*kf,lds_cptr kp){
  kf[0]=*(const __attribute__((address_space(3))) bf16x8*)(kp);      kf[1]=*(const __attribute__((address_space(3))) bf16x8*)(kp+512);
  kf[2]=*(const __attribute__((address_space(3))) bf16x8*)(kp+2048); kf[3]=*(const __attribute__((address_space(3))) bf16x8*)(kp+2560);
  kf[4]=*(const __attribute__((address_space(3))) bf16x8*)(kp+4096); kf[5]=*(const __attribute__((address_space(3))) bf16x8*)(kp+4608);
  kf[6]=*(const __attribute__((address_space(3))) bf16x8*)(kp+6144); kf[7]=*(const __attribute__((address_space(3))) bf16x8*)(kp+6656);
}
__device__ __forceinline__ void kload2(bf16x8*kf,lds_cptr kp,int j){ kf[2*j]=*(const __attribute__((address_space(3))) bf16x8*)(kp+j*2048); kf[2*j+1]=*(const __attribute__((address_space(3))) bf16x8*)(kp+j*2048+512); }
__device__ __forceinline__ s16x4 vtr(lds_cptr p){ return __builtin_bit_cast(s16x4,__builtin_amdgcn_ds_read_tr16_b64_v4i16((__attribute__((address_space(3))) v4i16_t*)p)); }
__device__ __forceinline__ float rowmax(const f32x16&p0,const f32x16&p1){
  float a=max3f(p0[0],p0[1],p1[0]),b=max3f(p0[2],p0[3],p1[1]);a=max3f(a,p1[2],p1[3]);
  #pragma unroll
  for(int r=4;r<16;r+=4){a=max3f(a,p0[r],p0[r+1]);b=max3f(b,p0[r+2],p0[r+3]);a=max3f(a,p1[r],p1[r+1]);b=max3f(b,p1[r+2],p1[r+3]);}
  const float m=max2f(a,b);
  auto rr=__builtin_amdgcn_permlane32_swap(__float_as_uint(m),__float_as_uint(m),false,false);
  return max2f(__uint_as_float(rr[0]),__uint_as_float(rr[1]));
}
__device__ __forceinline__ void pv(f32x16*o,int vb,bf16x8 pa0,bf16x8 pa1,bf16x8 pa2,bf16x8 pa3){
  #pragma unroll
  for(int d0=0;d0<2;++d0){s16x4 lo[4],hi[4];
    #pragma unroll
    for(int ks=0;ks<4;++ks){
      asm volatile("ds_read_b64_tr_b16 %0,%1 offset:%c2":"=&v"(lo[ks]):"v"(vb),"i"(d0*4096+ks*1024):"memory");
      asm volatile("ds_read_b64_tr_b16 %0,%1 offset:%c2":"=&v"(hi[ks]):"v"(vb),"i"(d0*4096+ks*1024+512):"memory");}
    asm volatile("s_waitcnt lgkmcnt(0)":::"memory");SBAR();
    #define PK(k) (bf16x8){lo[k][0],lo[k][1],lo[k][2],lo[k][3],hi[k][0],hi[k][1],hi[k][2],hi[k][3]}
    o[d0]=__builtin_amdgcn_mfma_f32_32x32x16_bf16(pa0,PK(0),o[d0],0,0,0);
    o[d0]=__builtin_amdgcn_mfma_f32_32x32x16_bf16(pa1,PK(1),o[d0],0,0,0);
    o[d0]=__builtin_amdgcn_mfma_f32_32x32x16_bf16(pa2,PK(2),o[d0],0,0,0);
    o[d0]=__builtin_amdgcn_mfma_f32_32x32x16_bf16(pa3,PK(3),o[d0],0,0,0);
    #undef PK
  }
}
#define ATTN_STORE16(p,v) (*(u32x4*)(p)=(v))
template<int THRL> __device__ __forceinline__ void attn_unit(int b,int h,int qb,int tstart,const bf16*Q,const bf16*__restrict__ K,const bf16*__restrict__ V,bf16*O,const float*NCS,char*shm){
  int tid_=threadIdx.x; asm volatile("":"+v"(tid_));
  const int tid=tid_,lane=tid&63,r32=lane&31,hi=lane>>5; const int wid=__builtin_amdgcn_readfirstlane(tid>>6);
  const long rowbase=(long)b*SEQ; const int q0=qb*QB;
  const bf16*Qw=Q+(rowbase+q0+wid*QBLK)*DM+h*D;
  const bf16*Kh=K+(rowbase+(long)tstart*KVBLK)*DM+h*D,*Vh=V+(rowbase+(long)tstart*KVBLK)*DM+h*D;
  const unsigned lds0=(unsigned)(uintptr_t)shm;
  float*wsf=(float*)(shm+LDS_WS)+wid*64;
  const lds_cptr shm3=(lds_cptr)shm;
  { const float*ncs=NCS+(size_t)(b*NHEAD+h)*SEQ+tstart*KVBLK; const int n4=(q0+QB-tstart*KVBLK)>>2;
    for(int i=tid;i<n4;i+=NW*64){ const f32x4v v=*(const f32x4v*)(ncs+4*i); *(__attribute__((address_space(3))) f32x4v*)((__attribute__((address_space(3))) char*)shm3+LDS_CS+16*i)=v; } }
  const bf16*ksrc=Kh+(long)lane*DM+wid*8;
  const bf16*vsrc=Vh+(long)(16*(wid&3)+(lane>>2))*DM+(wid>>2)*32+(lane&3)*8;
  const unsigned kdst=lds0+LDS_K+wid*1024, vdst=lds0+LDS_V+wid*1024;
  #define DMA_K(t,slot) glds16(ksrc+(long)(t)*KVBLK*DM,(unsigned)__builtin_amdgcn_readfirstlane(kdst+(slot)))
  #define DMA_V(t,slot) glds16(vsrc+(long)(t)*KVBLK*DM,(unsigned)__builtin_amdgcn_readfirstlane(vdst+(slot)))
  const int vb0=(int)(lds0+LDS_V)+((lane>>4)&1)*32+(lane&3)*8+(4*hi+((lane&15)>>2))*64;
  const char*Kbase=shm+LDS_K; bf16x8 kf[8];
  const lds_cptr kp0=shm3+LDS_K+hi*1024+r32*16; const lds_cptr vp0=shm3+LDS_V+((lane>>4)&1)*32+(lane&3)*8+(4*hi+((lane&15)>>2))*64;
  const lds_cptr csp0=shm3+LDS_CS+hi*16;
  const int NT=(q0+QB)/KVBLK-tstart;
  DMA_K(0,0);DMA_V(0,0);DMA_K(1,SLOTB);
  bf16x8 qr[4];
  #pragma unroll
  for(int d0=0;d0<4;++d0)qr[d0]=*reinterpret_cast<const bf16x8*>(&Qw[(long)r32*DM+d0*16+hi*8]);
  float mhat=0.f,l_reg=0.f,negm1=0.f;f32x16 o[2];o[0]=f32x16{};o[1]=f32x16{};
  const int qrel=wid*QBLK+r32;
  #define CMASK(P0,P1,t) do{int jb_=(t)-(NT-4); if(jb_>=0)cmask(P0,P1,jb_,qrel,hi);}while(0)
  bool resc=false;
  #define START(P0,P1) do{ const float rm=rowmax(P0,P1); resc=false; \
    { const float dl=rm; mhat=fadd_s(mhat,dl); \
      _Pragma("unroll") for(int r=0;r<16;++r){P0[r]=fsub_s(P0[r],dl);P1[r]=fsub_s(P1[r],dl);} \
      negm1=-mhat; } \
    _Pragma("unroll") for(int r=0;r<16;++r)P0[r]=__builtin_amdgcn_exp2f(P0[r]); }while(0)
  #define RESC() do{ if(resc){ asm volatile("s_waitcnt lgkmcnt(0)":::"memory"); \
      _Pragma("unroll") for(int d_=0;d_<2;++d_) _Pragma("unroll") for(int r=0;r<16;++r)o[d_][r]*=wsf[crow(r,hi)]; } }while(0)
  f32x16 pA0,pA1,pB0,pB1;
  int sl_prev=0,sl_cur=0,sl_next=SLOTB;
  #define ROT() do{sl_prev=sl_cur;sl_cur=sl_next;sl_next=(sl_next==(NSLOT-1)*SLOTB)?0:sl_next+SLOTB;}while(0)
  DMA_K(2,2*SLOTB);
  WAIT_BAR(3);
  ldbias(pA0,pA1,csp0,0.f);
  qkt(pA0,pA1,Kbase,qr,r32,hi);asm volatile("s_nop 15\n\ts_nop 7":"+v"(pA0),"+v"(pA1));CMASK(pA0,pA1,0);
  START(pA0,pA1);
  _Pragma("unroll") for(int r=0;r<16;++r)pA1[r]=__builtin_amdgcn_exp2f(pA1[r]);
  WAIT_BAR(0);
  DMA_K(3,0);DMA_V(1,SLOTB);
  ROT();
  kload8(kf,kp0+sl_cur);
  WAIT_BAR(2);
  s16x4 vlo[8],vhi[8]; u32x4 pw0,pw1,pw2,pw3;
  #define PKW(P,B) cvtpk_s(P[B],P[B+1])
  #define PAF(k) __builtin_bit_cast(bf16x8,pw##k)
  #define VFR(i) (bf16x8){vlo[i][0],vlo[i][1],vlo[i][2],vlo[i][3],vhi[i][0],vhi[i][1],vhi[i][2],vhi[i][3]}
  #define PIN(x) asm volatile("":"+v"(x))
  #define MX3(a,b,c) __builtin_fmaxf(__builtin_fmaxf((a),(b)),(c))
  #define GAPA(MF,A0,A1,A2,A3,W0,W1,PW) do{ MF; sacc+=A0; sacc+=A1; sacc+=A2; sacc+=A3; PIN(sacc); W0; W1; PIN(PW); SBAR(); }while(0)
  #define EX(v) __builtin_amdgcn_exp2f(v)
  #define GAPB(MF,X,B) do{ MF; X[B]=EX(X[B]); X[B+1]=EX(X[B+1]); X[B+2]=EX(X[B+2]); X[B+3]=EX(X[B+3]); PIN(X); SBAR(); }while(0)
  #define VRD(i) do{ vlo[i]=vtr(vp_+(((i)>>2)*4096+((i)&3)*1024)); vhi[i]=vtr(vp_+(((i)>>2)*4096+((i)&3)*1024+512)); }while(0)
  #define KRD(G,j) do{ if(G){ kload2(kf,kp0+sl_next,j); SBAR(); } }while(0)
  #define STEP(C0,C1,P0,P1,t,GK,GV,GL) do{ SBAR(); \
    const lds_cptr vp_=vp0+sl_prev; \
    ldbias(C0,C1,csp0+(t)*256,negm1); PIN(C0); PIN(C1); SBAR(); \
    VRD(0); SBAR(); float sacc=(P0[0]+P0[1]); \
    GAPA(C0=__builtin_amdgcn_mfma_f32_32x32x16_bf16(kf[0],qr[0],C0,0,0,0), P0[2],P0[3],P0[4],P0[5],     pw0[0]=PKW(P0,0), pw0[1]=PKW(P0,2), pw0); \
    VRD(4); SBAR(); GAPA(C1=__builtin_amdgcn_mfma_f32_32x32x16_bf16(kf[1],qr[0],C1,0,0,0), P0[6],P0[7],P0[8],P0[9],     pw0[2]=PKW(P0,4), pw0[3]=PKW(P0,6), pw0); \
    VRD(1); SBAR(); GAPA(C0=__builtin_amdgcn_mfma_f32_32x32x16_bf16(kf[2],qr[1],C0,0,0,0),   P0[10],P0[11],P0[12],P0[13], pw1[0]=PKW(P0,8), pw1[1]=PKW(P0,10), pw1); \
    VRD(5); SBAR(); GAPA(C1=__builtin_amdgcn_mfma_f32_32x32x16_bf16(kf[3],qr[1],C1,0,0,0),   P0[14],P0[15],P1[0],P1[1],   pw1[2]=PKW(P0,12),pw1[3]=PKW(P0,14), pw1); \
    VRD(2); SBAR(); GAPA(C0=__builtin_amdgcn_mfma_f32_32x32x16_bf16(kf[4],qr[2],C0,0,0,0),   P1[2],P1[3],P1[4],P1[5],     pw2[0]=PKW(P1,0), pw2[1]=PKW(P1,2), pw2); \
    VRD(6); SBAR(); GAPA(C1=__builtin_amdgcn_mfma_f32_32x32x16_bf16(kf[5],qr[2],C1,0,0,0),   P1[6],P1[7],P1[8],P1[9],     pw2[2]=PKW(P1,4), pw2[3]=PKW(P1,6), pw2); \
    VRD(3); SBAR(); GAPA(C0=__builtin_amdgcn_mfma_f32_32x32x16_bf16(kf[6],qr[3],C0,0,0,0),   P1[10],P1[11],P1[12],P1[13], pw3[0]=PKW(P1,8), pw3[1]=PKW(P1,10), pw3); \
    VRD(7); SBAR(); GAPA(C1=__builtin_amdgcn_mfma_f32_32x32x16_bf16(kf[7],qr[3],C1,0,0,0),   P1[14],P1[15],0.f,0.f,       pw3[2]=PKW(P1,12),pw3[3]=PKW(P1,14), pw3); \
    l_reg+=sacc; \
    if(GK){DMA_K((t)+3,sl_cur);} if(GV){DMA_V((t)+1,sl_next);} \
    CMASK(C0,C1,t); \
    { float a=MX3(C0[0],C0[1],C1[0]),b=MX3(C0[2],C0[3],C1[1]); a=MX3(a,C1[2],C1[3]); \
      _Pragma("unroll") for(int r=4;r<16;r+=4){a=MX3(a,C0[r],C0[r+1]);b=MX3(b,C0[r+2],C0[r+3]);a=MX3(a,C1[r],C1[r+1]);b=MX3(b,C1[r+2],C1[r+3]);} \
      float rm=__builtin_fmaxf(a,b); { auto rr=__builtin_amdgcn_permlane32_swap(__float_as_uint(rm),__float_as_uint(rm),false,false); rm=__builtin_fmaxf(__uint_as_float(rr[0]),__uint_as_float(rr[1])); } \
      resc=false; \
      if(__builtin_expect(__any(rm>(float)THRL),0)){ const float dl=__builtin_fmaxf(rm,0.f); mhat+=dl; \
        _Pragma("unroll") for(int r=0;r<16;++r){C0[r]-=dl;C1[r]-=dl;} \
        negm1=-mhat; \
        const float f=__builtin_amdgcn_exp2f(-dl); l_reg*=f; if(hi==0)wsf[r32]=f; resc=true; } } \
    SBAR(); \
    GAPB(o[0]=__builtin_amdgcn_mfma_f32_32x32x16_bf16(PAF(0),VFR(0),o[0],0,0,0), C0,0); \
    GAPB(o[1]=__builtin_amdgcn_mfma_f32_32x32x16_bf16(PAF(0),VFR(4),o[1],0,0,0), C0,4); \
    KRD(GL,0); GAPB(o[0]=__builtin_amdgcn_mfma_f32_32x32x16_bf16(PAF(1),VFR(1),o[0],0,0,0), C0,8); \
    KRD(GL,1); GAPB(o[1]=__builtin_amdgcn_mfma_f32_32x32x16_bf16(PAF(1),VFR(5),o[1],0,0,0), C0,12); \
    KRD(GL,2); GAPB(o[0]=__builtin_amdgcn_mfma_f32_32x32x16_bf16(PAF(2),VFR(2),o[0],0,0,0), C1,0); \
    KRD(GL,3); GAPB(o[1]=__builtin_amdgcn_mfma_f32_32x32x16_bf16(PAF(2),VFR(6),o[1],0,0,0), C1,4); \
    GAPB(o[0]=__builtin_amdgcn_mfma_f32_32x32x16_bf16(PAF(3),VFR(3),o[0],0,0,0), C1,8); \
    GAPB(o[1]=__builtin_amdgcn_mfma_f32_32x32x16_bf16(PAF(3),VFR(7),o[1],0,0,0), C1,12); \
    }while(0)
  int t=1;
  #undef CMASK
  #define CMASK(P0,P1,t) do{}while(0)
  for(;t+5<NT;t+=2){
    STEP(pB0,pB1,pA0,pA1,t,true,true,true);     WAIT_BAR(2); RESC(); ROT();
    STEP(pA0,pA1,pB0,pB1,t+1,true,true,true);   WAIT_BAR(2); RESC(); ROT();
  }
  #undef CMASK
  #define CMASK(P0,P1,t) do{int jb_=(t)-(NT-4); if(jb_>=0)cmask(P0,P1,jb_,qrel,hi);}while(0)
  #define ENDW(tt) do{ if((tt)+3<NT){WAIT_BAR(2);} else if((tt)+2<NT){WAIT_BAR(1);} else {WAIT_BAR(0);} }while(0)
  for(;t+1<NT;t+=2){
    STEP(pB0,pB1,pA0,pA1,t,(t+3<NT),(t+1<NT),(t+1<NT));       ENDW(t);   RESC(); ROT();
    STEP(pA0,pA1,pB0,pB1,t+1,(t+4<NT),(t+2<NT),(t+2<NT));     ENDW(t+1); RESC(); ROT();
  }
  STEP(pB0,pB1,pA0,pA1,NT-1,false,false,false); RESC();
  { float sacc=pB0[0]+pB0[1]; _Pragma("unroll") for(int r=2;r<16;++r)sacc+=pB0[r]; _Pragma("unroll") for(int r=0;r<16;++r)sacc+=pB1[r]; l_reg+=sacc;
    pw0=(u32x4){PKW(pB0,0),PKW(pB0,2),PKW(pB0,4),PKW(pB0,6)};pw1=(u32x4){PKW(pB0,8),PKW(pB0,10),PKW(pB0,12),PKW(pB0,14)};pw2=(u32x4){PKW(pB1,0),PKW(pB1,2),PKW(pB1,4),PKW(pB1,6)};pw3=(u32x4){PKW(pB1,8),PKW(pB1,10),PKW(pB1,12),PKW(pB1,14)};
    SBAR(); pv(o,vb0+sl_cur,PAF(0),PAF(1),PAF(2),PAF(3)); }
  #undef PKW
  #undef PAF
  #undef VFR
  #undef PIN
  #undef MX3
  #undef GAPA
  #undef GAPB
  #undef EX
  #undef VRD
  #undef KRD
  #undef STEP
  #undef ENDW
  {auto rr=__builtin_amdgcn_permlane32_swap(__float_as_uint(l_reg),__float_as_uint(l_reg),false,false);l_reg=__uint_as_float(rr[0])+__uint_as_float(rr[1]);}
  if(hi==0)wsf[32+r32]=l_reg;asm volatile("s_waitcnt lgkmcnt(0)":::"memory");
  float rli[16];
  #pragma unroll
  for(int r=0;r<16;++r)rli[r]=__builtin_amdgcn_rcpf(wsf[32+crow(r,hi)]);
  bf16*Ow=O+(rowbase+q0+wid*QBLK)*DM+h*D;
  { bf16*stg=(bf16*)(shm+LDS_OST)+wid*2048;
    #pragma unroll
    for(int r=0;r<16;++r){const int orow=crow(r,hi);
      #pragma unroll
      for(int d0=0;d0<2;++d0)stg[orow*64+d0*32+r32]=__float2bfloat16(o[d0][r]*rli[r]);}
    asm volatile("s_waitcnt lgkmcnt(0)":::"memory");
    #pragma unroll
    for(int i=0;i<4;++i){const int row=i*8+(lane>>3),ch=lane&7; const u32x4 v=*(const u32x4*)(stg+row*64+ch*8); ATTN_STORE16(Ow+(long)row*DM+ch*8,v);} }
  asm volatile("s_waitcnt lgkmcnt(0)\n\ts_barrier":::"memory");
  #undef DMA_K
  #undef DMA_V
  #undef CMASK
  #undef START
  #undef RESC
  #undef ROT
}
constexpr int ATTN_LDS_BYTES=LDS_BYTES;
#undef SBAR
#undef WAIT_BAR
}

constexpr int NWAVES = 8;
constexpr int BATCH = 4, SEQ = 8192, D = 1024, NH = 16, HD = 64, FF0 = 2816, FFE = 3584, NE = 8;
constexpr int T = BATCH * SEQ;
constexpr int NWIN = 3 * D + NH;
constexpr float RMS_EPS = 1e-6f;
constexpr int MAXRT = 264, MAXROWS = MAXRT * 256;
constexpr int CHUNK_RT = 128;
constexpr int MAXCHUNK = 2;
constexpr float WGU_PRESCALE = 32.f, WD_PRESCALE = 64.f;
constexpr int PH_PRO = 0, PH_MIX0 = 1, PH_GU0 = 2, PH_DN0 = 3, PH_THB = 4, PH_QKV = 5, PH_ATT = 6, PH_WO = 7, PH_THC = 8, PH_PERM = 9, PH_MOE = 10, PH_FIN = PH_MOE + 2 * MAXCHUNK, N_PH = PH_FIN + 1;
static_assert(N_PH == 15, "phase count");

constexpr size_t MiB = 1u << 20;
constexpr size_t WS_CTL = 0, CTL_ZERO_BYTES = 1 * MiB;
constexpr size_t WS_WPOOL = 1 * MiB;
constexpr size_t WS_WFT = WS_WPOOL + 512 * 1024;
constexpr size_t WS_WRT = WS_WFT + 64 * 1024;
constexpr size_t WS_RTPOS = 2 * MiB;
constexpr size_t WS_RTG = WS_RTPOS + 256 * 1024;
constexpr size_t WS_LOGF = 3 * MiB;
constexpr size_t WS_NCS = 5 * MiB;
constexpr size_t WS_WIN = 8 * MiB;
constexpr size_t WS_WOUT = 14 * MiB;
constexpr size_t WS_WGU0 = 16 * MiB;
constexpr size_t WS_WD0 = 27 * MiB;
constexpr size_t WS_WGU = 34 * MiB;
constexpr size_t WS_WD = 90 * MiB;
constexpr size_t WS_H = 118 * MiB;
constexpr size_t WS_R = 182 * MiB;
constexpr size_t WS_YB = WS_R, WS_ACT0 = WS_R + 64 * MiB;
constexpr size_t WS_Q = WS_R, WS_K = WS_R + 64 * MiB, WS_V = WS_R + 128 * MiB, WS_YATT = WS_K;
constexpr size_t WS_HS = WS_R;
constexpr size_t WS_YS = WS_R + 66 * MiB;
constexpr size_t WS_ACTC = WS_YS + 132 * MiB;
constexpr size_t WS_END = WS_ACTC + 119 * MiB;
static_assert(WS_WD0 + (size_t)D * FF0 * 2 <= WS_WGU && WS_WGU + (size_t)NE * 2 * FFE * D <= WS_WD && WS_WD + (size_t)NE * D * FFE <= WS_H && WS_ACT0 + (size_t)T * FF0 * 2 <= WS_END &&
              WS_HS + (size_t)MAXROWS * D <= WS_YS && WS_ACTC + (size_t)(MAXRT - CHUNK_RT) * 256 * FFE <= WS_END && WS_END <= 512 * MiB, "ws map");
constexpr int CW_TMO = 0, CW_CODE = 1, CW_BAR = 4096, CW_CNT = 16384, CW_AQ = 20480, CW_MAXQ = 24576, CW_MAXK = 24576 + 64;

constexpr int RING_OFF = 0, RING_BYTES = 131072;
constexpr int LDSCTL_OFF = RING_BYTES, MISC_OFF = LDSCTL_OFF + 320;
constexpr int LDS_BYTES = 147456;
static_assert(MISC_OFF + 128 <= LDS_BYTES && attn_body::ATTN_LDS_BYTES <= RING_BYTES, "LDS map");

#define GAS __attribute__((address_space(1)))
#define LAS __attribute__((address_space(3)))
typedef unsigned short bf16;
typedef unsigned v4u __attribute__((ext_vector_type(4)));
typedef unsigned v2u __attribute__((ext_vector_type(2)));
typedef float f32x4 __attribute__((ext_vector_type(4)));
typedef float f32x2 __attribute__((ext_vector_type(2)));
typedef GAS unsigned gu32;
#define RLX_AGENT __ATOMIC_RELAXED, __HIP_MEMORY_SCOPE_AGENT
#define LDS_WAIT() asm volatile("s_waitcnt lgkmcnt(0)" ::: "memory")
#define VM_WAIT() asm volatile("s_waitcnt vmcnt(0)" ::: "memory")
__device__ __forceinline__ unsigned f2bf(float f) { unsigned u = __builtin_bit_cast(unsigned, f); return (u + 0x7fffu + ((u >> 16) & 1u)) >> 16; }
__device__ __forceinline__ unsigned pk2(float lo, float hi) { return f2bf(lo) | (f2bf(hi) << 16); }
__device__ __forceinline__ float bf_lo(unsigned w) { return __builtin_bit_cast(float, w << 16); }
__device__ __forceinline__ float bf_hi(unsigned w) { return __builtin_bit_cast(float, w & 0xffff0000u); }

#define XB_TMO      128
#define XB_XCNT(j)  (256  + 64 * (j))
#define XB_XSUB(j)  (1280 + 64 * (j))
#define XB_XGEN(j)  (2304 + 64 * (j))
#define XB_TOP      3328
#define XB_TOPGEN   3392
#define XCD_BAR_WORDS 3456
#define XB_SPIN_CAP (1u << 18)
__device__ __forceinline__ unsigned xb_ld(unsigned* p)              { return __hip_atomic_load(p, __ATOMIC_RELAXED, __HIP_MEMORY_SCOPE_AGENT); }
__device__ __forceinline__ unsigned xb_add(unsigned* p, unsigned v) { return __hip_atomic_fetch_add(p, v, __ATOMIC_RELAXED, __HIP_MEMORY_SCOPE_AGENT); }
__device__ __forceinline__ unsigned xb_xcc_id() { return (unsigned)__builtin_amdgcn_s_getreg((3 << 11) | 20) & 0xFu; }
#define XB_SPIN(cond, bar) do { unsigned _sp = 0; while (cond) { __builtin_amdgcn_s_sleep(1); \
    if ((++_sp & 255u) == 0u) { if (xb_ld(&(bar)[XB_TMO])) break; if (_sp > XB_SPIN_CAP) { atomicAdd(&(bar)[XB_TMO], 1u); break; } } } } while (0)
struct XcdBarrier { unsigned* bar; unsigned x; volatile LAS unsigned* st; };
__device__ __forceinline__ XcdBarrier xcd_barrier_post(unsigned* bar, volatile LAS unsigned* st) {
    XcdBarrier b; b.bar = bar; b.x = xb_xcc_id(); b.st = st;
    if (threadIdx.x == 0) (void)xb_add(&bar[XB_XCNT(b.x)], 1u);
    return b;
}
__device__ __forceinline__ void xcd_barrier_complete(unsigned* bar, unsigned x, unsigned& nloc, unsigned& nx) {
    const unsigned G = gridDim.x * gridDim.y * gridDim.z;
    unsigned sum, cnt, mine, sp = 0u;
    for (;;) {
        sum = 0u; cnt = 0u; mine = 0u;
#pragma unroll
        for (unsigned j = 0; j < 16; ++j) { const unsigned c = xb_ld(&bar[XB_XCNT(j)]); sum += c; cnt += (c > 0u) ? 1u : 0u; mine = (j == x) ? c : mine; }
        if (sum == G) break;
        __builtin_amdgcn_s_sleep(1);
        if ((++sp & 255u) == 0u) { if (xb_ld(&bar[XB_TMO])) break; if (sp > XB_SPIN_CAP) { atomicAdd(&bar[XB_TMO], 1u); break; } }
    }
    nloc = mine > 0u ? mine : 1u; nx = cnt > 0u ? cnt : 1u;
}
__device__ __forceinline__ void xcd_barrier(const XcdBarrier& b) {
    asm volatile("s_waitcnt vmcnt(0)" ::: "memory");
    __syncthreads();
    if (threadIdx.x == 0) {
        unsigned* bar = b.bar;
        __builtin_amdgcn_s_waitcnt(0);
        unsigned nloc = b.st[0], nx = b.st[1];
        if (nloc == 0u) { xcd_barrier_complete(bar, b.x, nloc, nx); b.st[0] = nloc; b.st[1] = nx; }
        const unsigned old = xb_add(&bar[XB_XSUB(b.x)], 1u);
        const unsigned gen = old / nloc;
        if (old + 1u == (gen + 1u) * nloc) {
            __builtin_amdgcn_fence(__ATOMIC_RELEASE, "agent");
            asm volatile("s_waitcnt vmcnt(0)" ::: "memory");
            const unsigned og = xb_add(&bar[XB_TOP], 1u);
            const unsigned tg = og / nx;
            if (og + 1u == (tg + 1u) * nx) xb_add(&bar[XB_TOPGEN], 1u);
            else XB_SPIN(xb_ld(&bar[XB_TOPGEN]) == tg, bar);
            __builtin_amdgcn_fence(__ATOMIC_ACQUIRE, "agent");
            xb_add(&bar[XB_XGEN(b.x)], 1u);
            asm volatile("s_waitcnt vmcnt(0)" ::: "memory");
        } else {
            XB_SPIN(xb_ld(&bar[XB_XGEN(b.x)]) == gen, bar);
            __builtin_amdgcn_fence(__ATOMIC_ACQUIRE, "agent");
            asm volatile("s_waitcnt vmcnt(0)" ::: "memory");
        }
    }
    __syncthreads();
}

struct Frame {
    LAS unsigned char* lds;
    volatile LAS unsigned* MISC;
    gu32* ctl;
    int tid, lane, wave;
    int vcu, G;
    unsigned char* ws;
};
__device__ __forceinline__ float wave_sum(float v) {
#pragma unroll
    for (int o = 1; o < 64; o <<= 1) v += __shfl_xor(v, o);
    return v;
}
__device__ __forceinline__ void load_row_f32(const float* p, int lane, f32x4 (&v)[4]) {
#pragma unroll
    for (int j = 0; j < 4; ++j) v[j] = ((const f32x4*)p)[64 * j + lane];
}
__device__ __forceinline__ void store_row_f32(float* p, int lane, const f32x4 (&v)[4]) {
#pragma unroll
    for (int j = 0; j < 4; ++j) ((f32x4*)p)[64 * j + lane] = v[j];
}
__device__ __forceinline__ void load_row_bf16(const bf16* p, int lane, f32x4 (&v)[4]) {
#pragma unroll
    for (int j = 0; j < 4; ++j) { const v2u w = ((const v2u*)p)[64 * j + lane]; v[j] = (f32x4){bf_lo(w.x), bf_hi(w.x), bf_lo(w.y), bf_hi(w.y)}; }
}
__device__ __forceinline__ void store_row_bf16(bf16* p, int lane, const f32x4 (&v)[4]) {
#pragma unroll
    for (int j = 0; j < 4; ++j) { v2u w; w.x = pk2(v[j].x, v[j].y); w.y = pk2(v[j].z, v[j].w); ((v2u*)p)[64 * j + lane] = w; }
}
__device__ __forceinline__ float row_rstd(const f32x4 (&v)[4]) {
    float s = 0.f;
#pragma unroll
    for (int j = 0; j < 4; ++j) s += (v[j].x * v[j].x + v[j].y * v[j].y) + (v[j].z * v[j].z + v[j].w * v[j].w);
    s = wave_sum(s);
    return 1.0f / sqrtf(s * (1.0f / D) + RMS_EPS);
}

__device__ __forceinline__ void p0_transpose_item(const float* W, int ldw, int k0, int n0, bf16* dst, int dK, int drow0, LAS unsigned* scr, int lane) {
    const int nq = lane & 15, kr = lane >> 4;
#pragma unroll 4
    for (int it = 0; it < 8; ++it) { const int kp = it * 4 + kr;
        const f32x4 a = *(const f32x4*)(W + (size_t)(k0 + 2 * kp) * ldw + n0 + 4 * nq), b = *(const f32x4*)(W + (size_t)(k0 + 2 * kp + 1) * ldw + n0 + 4 * nq);
        scr[(4 * nq + 0) * 33 + kp] = pk2(a.x, b.x); scr[(4 * nq + 1) * 33 + kp] = pk2(a.y, b.y); scr[(4 * nq + 2) * 33 + kp] = pk2(a.z, b.z); scr[(4 * nq + 3) * 33 + kp] = pk2(a.w, b.w); }
    LDS_WAIT(); asm volatile("" ::: "memory");
    const int c = lane & 7;
#pragma unroll
    for (int ps = 0; ps < 8; ++ps) { const int n = (lane >> 3) + 8 * ps; const LAS unsigned* s = scr + n * 33 + 4 * c;
        v4u o; o.x = s[0]; o.y = s[1]; o.z = s[2]; o.w = s[3];
        *(v4u*)(dst + (size_t)(drow0 + n) * dK + k0 + 8 * c) = o; }
    LDS_WAIT(); asm volatile("" ::: "memory");
}
__device__ __forceinline__ void p0_transpose_item8(const float* W, int ldw, int k0, int n0, unsigned char* dst, int dK, int drow0, float scale, LAS unsigned* scr, int lane) {
    const int nq = lane & 15, kr = lane >> 4;
#pragma unroll 2
    for (int it = 0; it < 8; ++it) { const int k4 = it * 4 + kr; const float* p = W + (size_t)(k0 + 4 * k4) * ldw + n0 + 4 * nq;
        const f32x4 a = *(const f32x4*)p * scale, b = *(const f32x4*)(p + ldw) * scale, c = *(const f32x4*)(p + 2 * (size_t)ldw) * scale, d = *(const f32x4*)(p + 3 * (size_t)ldw) * scale;
        scr[(4 * nq + 0) * 33 + k4] = pg8::pk4_fp8(a.x, b.x, c.x, d.x); scr[(4 * nq + 1) * 33 + k4] = pg8::pk4_fp8(a.y, b.y, c.y, d.y);
        scr[(4 * nq + 2) * 33 + k4] = pg8::pk4_fp8(a.z, b.z, c.z, d.z); scr[(4 * nq + 3) * 33 + k4] = pg8::pk4_fp8(a.w, b.w, c.w, d.w); }
    LDS_WAIT(); asm volatile("" ::: "memory");
    const int c = lane & 7;
#pragma unroll
    for (int ps = 0; ps < 8; ++ps) { const int n = (lane >> 3) + 8 * ps; const LAS unsigned* s = scr + n * 33 + 4 * c;
        v4u o; o.x = s[0]; o.y = s[1]; o.z = s[2]; o.w = s[3];
        *(v4u*)(dst + (size_t)(drow0 + n) * dK + k0 + 16 * c) = o; }
    LDS_WAIT(); asm volatile("" ::: "memory");
}
struct In { const float *x, *norm_g, *pool_w, *pool_scale, *w_in, *b_f, *w_out, *w_gate, *w_up, *w_down, *w_router, *mw_gate, *mw_up, *mw_down; };

__device__ __forceinline__ void p0_prologue(Frame& F, const In& I) {
    LAS unsigned* scr = (LAS unsigned*)(F.lds + RING_OFF + F.wave * 16384);
    const int gw = F.vcu * NWAVES + F.wave, NGW = F.G * NWAVES;
    constexpr int I_POOL = 4 * 4 * 4, I_WIN = 16 * 48, I_WOUT = 16 * 16, I_G0 = 16 * 44, I_D0 = 44 * 16, I_GE = 8 * 56, I_DE = 28 * 16;
    constexpr int NITEMS = I_POOL + I_WIN + I_WOUT + 2 * I_G0 + I_D0 + NE * (2 * I_GE + I_DE);
    bf16* const wpool = (bf16*)(F.ws + WS_WPOOL); bf16* const win = (bf16*)(F.ws + WS_WIN); bf16* const wout = (bf16*)(F.ws + WS_WOUT);
    bf16* const wgu0 = (bf16*)(F.ws + WS_WGU0); bf16* const wd0 = (bf16*)(F.ws + WS_WD0); unsigned char* const wgu = F.ws + WS_WGU; unsigned char* const wd = F.ws + WS_WD;
    for (int it = gw; it < NITEMS; it += NGW) {
        int r = it;
        if (r < I_POOL) { const int g = r >> 4, q = r & 15, kb = q >> 2, nb = q & 3; p0_transpose_item(I.pool_w + (size_t)g * 65536, 256, 64 * kb, 64 * nb, wpool + (size_t)g * 65536, 256, 64 * nb, scr, F.lane); continue; } r -= I_POOL;
        if (r < I_WIN) { const int kb = r / 48, nb = r % 48; p0_transpose_item(I.w_in, NWIN, 64 * kb, 64 * nb, win, D, 64 * nb, scr, F.lane); continue; } r -= I_WIN;
        if (r < I_WOUT) { const int kb = r / 16, nb = r % 16; p0_transpose_item(I.w_out, D, 64 * kb, 64 * nb, wout, D, 64 * nb, scr, F.lane); continue; } r -= I_WOUT;
        if (r < 2 * I_G0) { const int up = r >= I_G0; if (up) r -= I_G0; const int kb = r / 44, nb = r % 44, n0 = 64 * nb;
            p0_transpose_item(up ? I.w_up : I.w_gate, FF0, 64 * kb, n0, wgu0, D, ((n0 >> 7) << 8) + (n0 & 127) + (up ? 128 : 0), scr, F.lane); continue; } r -= 2 * I_G0;
        if (r < I_D0) { const int kb = r / 16, nb = r % 16; p0_transpose_item(I.w_down, D, 64 * kb, 64 * nb, wd0, FF0, 64 * nb, scr, F.lane); continue; } r -= I_D0;
        { const int e = r / (2 * I_GE + I_DE); r -= e * (2 * I_GE + I_DE);
          if (r < 2 * I_GE) { const int up = r >= I_GE; if (up) r -= I_GE; const int kb = r / 56, nb = r % 56, n0 = 64 * nb;
              p0_transpose_item8((up ? I.mw_up : I.mw_gate) + (size_t)e * D * FFE, FFE, 128 * kb, n0, wgu + (size_t)e * 2 * FFE * D, D, ((n0 >> 7) << 8) + (n0 & 127) + (up ? 128 : 0), WGU_PRESCALE, scr, F.lane); continue; } r -= 2 * I_GE;
          { const int kb = r / 16, nb = r % 16; p0_transpose_item8(I.mw_down + (size_t)e * FFE * D, D, 128 * kb, 64 * nb, wd + (size_t)e * D * FFE, FFE, 64 * nb, WD_PRESCALE, scr, F.lane); } }
    }
    { float* wft = (float*)(F.ws + WS_WFT); float* wrt = (float*)(F.ws + WS_WRT); const int gt = F.vcu * (NWAVES * 64) + F.tid, NGT = F.G * NWAVES * 64;
      for (int i = gt; i < 16 * D; i += NGT) { const int j = i / D, c = i % D; wft[i] = I.w_in[(size_t)c * NWIN + 3 * D + j]; }
      for (int i = gt; i < NE * D; i += NGT) { const int e = i / D, c = i % D; wrt[i] = I.w_router[(size_t)c * NE + e]; } }
}

__device__ __forceinline__ void row_rstd2(const f32x4 (&a)[4], const f32x4 (&b)[4], float& ra, float& rb) {
    float s = 0.f, t = 0.f;
#pragma unroll
    for (int j = 0; j < 4; ++j) { s += (a[j].x * a[j].x + a[j].y * a[j].y) + (a[j].z * a[j].z + a[j].w * a[j].w); t += (b[j].x * b[j].x + b[j].y * b[j].y) + (b[j].z * b[j].z + b[j].w * b[j].w); }
#pragma unroll
    for (int o = 1; o < 64; o <<= 1) { s += __shfl_xor(s, o); t += __shfl_xor(t, o); }
    ra = 1.0f / sqrtf(s * (1.0f / D) + RMS_EPS); rb = 1.0f / sqrtf(t * (1.0f / D) + RMS_EPS);
}
template <int MODE>
__device__ __forceinline__ void thin_phase(Frame& F, const In& I, const bf16* Y, const float* xin, float* xout, const float* gpost_p, const float* gpre_p) {
    bf16* const Hb = (bf16*)(F.ws + WS_H);
    LAS float* wl = (LAS float*)(F.lds + RING_OFF);
    LAS unsigned* rte = (LAS unsigned*)(F.lds + RING_OFF + 65536);
    LAS float* rtg = (LAS float*)(F.lds + RING_OFF + 65536 + 512);
    LAS unsigned* wtot = (LAS unsigned*)(F.lds + RING_OFF + 65536 + 2048);
    if (MODE == 1) { const f32x4* src = (const f32x4*)(F.ws + WS_WFT); for (int i = F.tid; i < 16 * D / 4; i += NWAVES * 64) ((LAS f32x4*)wl)[i] = src[i]; }
    if (MODE == 2) { const f32x4* src = (const f32x4*)(F.ws + WS_WRT); for (int i = F.tid; i < NE * D / 4; i += NWAVES * 64) ((LAS f32x4*)wl)[i] = src[i]; }
    f32x4 gpost[4], gpre[4];
    load_row_f32(gpost_p, F.lane, gpost); load_row_f32(gpre_p, F.lane, gpre);
    __syncthreads();
    for (int tile = F.vcu; tile < T / 128; tile += F.G) {
        const int mb = tile * 128 + F.wave * 16;
        f32x4 ynA[4], xnA[4], ynB[4], xnB[4];
        load_row_bf16(Y + (size_t)mb * D, F.lane, ynA); load_row_f32(xin + (size_t)mb * D, F.lane, xnA);
        load_row_bf16(Y + (size_t)(mb + 1) * D, F.lane, ynB); load_row_f32(xin + (size_t)(mb + 1) * D, F.lane, xnB);
#pragma unroll 1
        for (int i = 0; i < 16; i += 2) {
            const int m = mb + i, tl = F.wave * 16 + i;
            f32x4 yA[4], xA[4], yB[4], xB[4];
#pragma unroll
            for (int j = 0; j < 4; ++j) { yA[j] = ynA[j]; xA[j] = xnA[j]; yB[j] = ynB[j]; xB[j] = xnB[j]; }
            if (i + 2 < 16) { load_row_bf16(Y + (size_t)(m + 2) * D, F.lane, ynA); load_row_f32(xin + (size_t)(m + 2) * D, F.lane, xnA);
                              load_row_bf16(Y + (size_t)(m + 3) * D, F.lane, ynB); load_row_f32(xin + (size_t)(m + 3) * D, F.lane, xnB); }
            float r1A, r1B; row_rstd2(yA, yB, r1A, r1B);
#pragma unroll
            for (int j = 0; j < 4; ++j) { xA[j] += yA[j] * r1A * gpost[j]; xB[j] += yB[j] * r1B * gpost[j]; }
            store_row_f32(xout + (size_t)m * D, F.lane, xA); store_row_f32(xout + (size_t)(m + 1) * D, F.lane, xB);
            float r2A, r2B; row_rstd2(xA, xB, r2A, r2B);
#pragma unroll
            for (int j = 0; j < 4; ++j) { xA[j] = xA[j] * r2A * gpre[j]; xB[j] = xB[j] * r2B * gpre[j]; }
            if (MODE == 2) {
#pragma unroll
                for (int j = 0; j < 4; ++j) { ((unsigned*)((unsigned char*)Hb + (size_t)m * D))[64 * j + F.lane] = pg8::pk4_fp8(xA[j].x, xA[j].y, xA[j].z, xA[j].w);
                                              ((unsigned*)((unsigned char*)Hb + (size_t)(m + 1) * D))[64 * j + F.lane] = pg8::pk4_fp8(xB[j].x, xB[j].y, xB[j].z, xB[j].w); }
            } else { store_row_bf16(Hb + (size_t)m * D, F.lane, xA); store_row_bf16(Hb + (size_t)(m + 1) * D, F.lane, xB); }
            if (MODE == 1) {
                float zA = 0.f, zB = 0.f;
#pragma unroll 2
                for (int q = 0; q < 16; ++q) { float s = 0.f, t = 0.f;
#pragma unroll
                    for (int j = 0; j < 4; ++j) { const f32x4 w = ((const LAS f32x4*)wl)[q * 256 + 64 * j + F.lane];
                        s += (xA[j].x * w.x + xA[j].y * w.y) + (xA[j].z * w.z + xA[j].w * w.w); t += (xB[j].x * w.x + xB[j].y * w.y) + (xB[j].z * w.z + xB[j].w * w.w); }
#pragma unroll
                    for (int o = 1; o < 64; o <<= 1) { s += __shfl_xor(s, o); t += __shfl_xor(t, o); }
                    if (F.lane == q) { zA = s; zB = t; } }
                if (F.lane < 16) { const float bf = I.b_f[F.lane]; zA += bf; zB += bf;
                    ((float*)(F.ws + WS_LOGF))[(size_t)m * 16 + F.lane] = fminf(zA, 0.f) - log1pf(expf(-fabsf(zA)));
                    ((float*)(F.ws + WS_LOGF))[(size_t)(m + 1) * 16 + F.lane] = fminf(zB, 0.f) - log1pf(expf(-fabsf(zB))); }
            }
            if (MODE == 2) {
                float lgA[8], lgB[8];
#pragma unroll
                for (int q = 0; q < 8; ++q) { float s = 0.f, t = 0.f;
#pragma unroll
                    for (int j = 0; j < 4; ++j) { const f32x4 w = ((const LAS f32x4*)wl)[q * 256 + 64 * j + F.lane];
                        s += (xA[j].x * w.x + xA[j].y * w.y) + (xA[j].z * w.z + xA[j].w * w.w); t += (xB[j].x * w.x + xB[j].y * w.y) + (xB[j].z * w.z + xB[j].w * w.w); }
#pragma unroll
                    for (int o = 1; o < 64; o <<= 1) { s += __shfl_xor(s, o); t += __shfl_xor(t, o); }
                    lgA[q] = s; lgB[q] = t; }
#pragma unroll
                for (int rr = 0; rr < 2; ++rr) {
                    int e1 = 0; float v1 = rr ? lgB[0] : lgA[0];
#pragma unroll
                    for (int q = 1; q < 8; ++q) { const float v = rr ? lgB[q] : lgA[q]; if (v > v1) { v1 = v; e1 = q; } }
                    int e2 = -1; float v2 = -INFINITY;
#pragma unroll
                    for (int q = 0; q < 8; ++q) { const float v = rr ? lgB[q] : lgA[q]; if (q != e1 && v > v2) { v2 = v; e2 = q; } }
                    const float ex = expf(v2 - v1), g1 = 1.0f / (1.0f + ex), g2 = ex * g1;
                    if (F.lane == 0) { rte[tl + rr] = (unsigned)e1 | ((unsigned)e2 << 8); rtg[2 * (tl + rr)] = g1; rtg[2 * (tl + rr) + 1] = g2; }
                }
            }
        }
        if (MODE == 2) {
            __syncthreads();
            unsigned e1 = 0, e2 = 0, r1 = 0, r2 = 0; const int tl = F.tid;
            if (F.wave < 2) { const unsigned w = rte[tl]; e1 = w & 255u; e2 = w >> 8;
                const unsigned long long lt = (1ull << F.lane) - 1ull;
#pragma unroll
                for (unsigned e = 0; e < 8; ++e) { const unsigned long long m1 = __ballot(e1 == e), m2 = __ballot(e2 == e);
                    if (e1 == e) r1 = (unsigned)__popcll(m1 & lt); if (e2 == e) r2 = (unsigned)(__popcll(m1) + __popcll(m2 & lt));
                    if (F.lane == 0) wtot[F.wave * 8 + e] = (unsigned)(__popcll(m1) + __popcll(m2)); } }
            __syncthreads();
            if (F.tid < 8) { const unsigned n = wtot[F.tid] + wtot[8 + F.tid]; wtot[16 + F.tid] = __hip_atomic_fetch_add(F.ctl + CW_CNT + 64 * F.tid, n, RLX_AGENT); }
            __syncthreads();
            if (F.wave < 2) { const int m = tile * 128 + tl;
                const unsigned p1 = wtot[16 + e1] + (F.wave ? wtot[e1] : 0u) + r1, p2 = wtot[16 + e2] + (F.wave ? wtot[e2] : 0u) + r2;
                v2u pp; pp.x = (e1 << 20) | p1; pp.y = (e2 << 20) | p2; ((v2u*)(F.ws + WS_RTPOS))[m] = pp;
                ((f32x2*)(F.ws + WS_RTG))[m] = (f32x2){rtg[2 * tl], rtg[2 * tl + 1]}; }
            __syncthreads();
        }
    }
}

__device__ __forceinline__ void mix0_phase(Frame& F, const In& I, float* xout) {
    typedef short bf16x8_t __attribute__((ext_vector_type(8)));
    LAS unsigned char* const P = F.lds + RING_OFF;
    LAS float* const rs = (LAS float*)(F.lds + MISC_OFF + 128);
    const bf16* const WP = (const bf16*)(F.ws + WS_WPOOL);
    bf16* const Hb = (bf16*)(F.ws + WS_H);
    const int lane = F.lane, wave = F.wave, c16 = lane & 15, kq = lane >> 4;
    for (int tile = F.vcu; tile < T / 64; tile += F.G) {
        const int t0 = tile * 64, tb0 = t0 & (SEQ - 1);
        for (int r = wave; r < 79; r += 16) {
            const int r2 = r + 8; const bool v1 = (tb0 - 15 + r) >= 0, v2 = (r2 < 79) && (tb0 - 15 + r2) >= 0;
            f32x4 a[4], b[4];
#pragma unroll
            for (int j = 0; j < 4; ++j) { a[j] = (f32x4){0.f, 0.f, 0.f, 0.f}; b[j] = a[j]; }
            if (v1) load_row_f32(I.x + (size_t)(t0 - 15 + r) * D, lane, a);
            if (v2) load_row_f32(I.x + (size_t)(t0 - 15 + r2) * D, lane, b);
            float ra, rb; row_rstd2(a, b, ra, rb);
            if (lane == 0) { rs[r] = v1 ? ra : 0.f; if (r2 < 79) rs[r2] = v2 ? rb : 0.f; }
        }
        __syncthreads();
        { const int seg = F.tid >> 8, c4 = F.tid & 255, w = 2 << (c4 >> 6);
          const f32x4 g = ((const f32x4*)I.norm_g)[c4];
          const int tt0 = t0 + 32 * seg, tbb = tb0 + 32 * seg;
          const float* xc = I.x + 4 * c4; const LAS float* rsh = rs + 15 + 32 * seg;
          f32x4 Sx = (f32x4){0.f, 0.f, 0.f, 0.f};
          for (int i = 1 - w; i < 0; ++i) { if (tbb + i >= 0) { const f32x4 xv = *(const f32x4*)(xc + (size_t)(tt0 + i) * D); Sx += xv * (g * rsh[i]); } }
#pragma unroll 4
          for (int i = 0; i < 32; ++i) {
              const f32x4 xv = *(const f32x4*)(xc + (size_t)(tt0 + i) * D); const f32x4 hv = xv * (g * rsh[i]);
              Sx += hv;
              const int tb = tbb + i; const float inv = 1.0f / (float)((tb + 1 < w) ? (tb + 1) : w);
              const f32x4 pv_ = Sx * inv - hv;
              v2u o; o.x = pk2(pv_.x, pv_.y); o.y = pk2(pv_.z, pv_.w);
              const int row = 32 * seg + i;
              *(LAS v2u*)(P + row * 2048 + ((((c4 >> 1) ^ (row & 15))) << 4) + (c4 & 1) * 8) = o;
              const int io = i - w + 1;
              if (tbb + io >= 0) { const f32x4 xo = *(const f32x4*)(xc + (size_t)(tt0 + io) * D); Sx -= xo * (g * rsh[io]); }
          } }
        __syncthreads();
        f32x4 acc[4][8];
#pragma unroll
        for (int m = 0; m < 4; ++m)
#pragma unroll
            for (int nb = 0; nb < 8; ++nb) acc[m][nb] = (f32x4){0.f, 0.f, 0.f, 0.f};
        { const int gI = wave >> 1;
          const char* const wpb = (const char*)WP;
          const unsigned boff = (unsigned)(gI * 65536 + ((wave & 1) * 128 + c16) * 256 + 8 * kq) * 2u;
          bf16x8_t bnx[8];
          { unsigned bo = boff; asm volatile("" : "+v"(bo));
#pragma unroll
            for (int nb = 0; nb < 8; ++nb) bnx[nb] = *(const bf16x8_t*)(wpb + (size_t)(bo + (unsigned)nb * 8192u)); }
#pragma unroll 1
          for (int ks = 0; ks < 8; ++ks) {
              bf16x8_t bfr[8], afr[4];
#pragma unroll
              for (int nb = 0; nb < 8; ++nb) bfr[nb] = bnx[nb];
              if (ks + 1 < 8) { unsigned bo = boff + (unsigned)(ks + 1) * 64u; asm volatile("" : "+v"(bo));
#pragma unroll
                  for (int nb = 0; nb < 8; ++nb) bnx[nb] = *(const bf16x8_t*)(wpb + (size_t)(bo + (unsigned)nb * 8192u)); }
#pragma unroll
              for (int m = 0; m < 4; ++m) afr[m] = *(const LAS bf16x8_t*)(P + (16 * m + c16) * 2048 + (((32 * gI + 4 * ks + kq) ^ c16) << 4));
#pragma unroll
              for (int m = 0; m < 4; ++m)
#pragma unroll
                  for (int nb = 0; nb < 8; ++nb) acc[m][nb] = __builtin_amdgcn_mfma_f32_16x16x32_bf16(bfr[nb], afr[m], acc[m][nb], 0, 0, 0);
          } }
        __syncthreads();
#pragma unroll
        for (int nb = 0; nb < 8; ++nb) { const int col = 128 * wave + 16 * nb + 4 * kq; const f32x4 sc = *(const f32x4*)(I.pool_scale + col);
#pragma unroll
            for (int m = 0; m < 4; ++m) { const f32x4 v = acc[m][nb] * sc; v2u o; o.x = pk2(v.x, v.y); o.y = pk2(v.z, v.w);
                const int row = 16 * m + c16;
                *(LAS v2u*)(P + row * 2048 + ((((col >> 3) ^ c16)) << 4) + (kq & 1) * 8) = o; } }
        __syncthreads();
        { const int rb0 = wave * 8;
          f32x4 gpost[4], gpre[4];
          load_row_f32(I.norm_g + 1 * D, lane, gpost); load_row_f32(I.norm_g + 2 * D, lane, gpre);
          f32x4 xnA[4], xnB[4];
          load_row_f32(I.x + (size_t)(t0 + rb0) * D, lane, xnA); load_row_f32(I.x + (size_t)(t0 + rb0 + 1) * D, lane, xnB);
#pragma unroll 1
          for (int i = 0; i < 8; i += 2) {
              const int rA = rb0 + i, rB = rA + 1, m = t0 + rA;
              f32x4 yA[4], yB[4], xA[4], xB[4];
#pragma unroll
              for (int j = 0; j < 4; ++j) { xA[j] = xnA[j]; xB[j] = xnB[j];
                  const v2u wa = *(const LAS v2u*)(P + rA * 2048 + ((((32 * j + (lane >> 1)) ^ (rA & 15))) << 4) + (lane & 1) * 8);
                  const v2u wb2 = *(const LAS v2u*)(P + rB * 2048 + ((((32 * j + (lane >> 1)) ^ (rB & 15))) << 4) + (lane & 1) * 8);
                  yA[j] = (f32x4){bf_lo(wa.x), bf_hi(wa.x), bf_lo(wa.y), bf_hi(wa.y)}; yB[j] = (f32x4){bf_lo(wb2.x), bf_hi(wb2.x), bf_lo(wb2.y), bf_hi(wb2.y)}; }
              if (i + 2 < 8) { load_row_f32(I.x + (size_t)(m + 2) * D, lane, xnA); load_row_f32(I.x + (size_t)(m + 3) * D, lane, xnB); }
              float r1A, r1B; row_rstd2(yA, yB, r1A, r1B);
#pragma unroll
              for (int j = 0; j < 4; ++j) { xA[j] += yA[j] * r1A * gpost[j]; xB[j] += yB[j] * r1B * gpost[j]; }
              store_row_f32(xout + (size_t)m * D, lane, xA); store_row_f32(xout + (size_t)(m + 1) * D, lane, xB);
              float r2A, r2B; row_rstd2(xA, xB, r2A, r2B);
#pragma unroll
              for (int j = 0; j < 4; ++j) { xA[j] = xA[j] * r2A * gpre[j]; xB[j] = xB[j] * r2B * gpre[j]; }
              store_row_bf16(Hb + (size_t)m * D, lane, xA); store_row_bf16(Hb + (size_t)(m + 1) * D, lane, xB);
          } }
        __syncthreads();
    }
}

__device__ __forceinline__ void moe_offsets(Frame& F) {
    if (F.tid == 0) { unsigned acc = 0u;
        for (int e = 0; e < NE; ++e) { F.MISC[12 + e] = acc; const unsigned c = __hip_atomic_load(F.ctl + CW_CNT + 64 * e, RLX_AGENT); acc += (c + 255u) >> 8; }
        F.MISC[12 + NE] = acc; F.MISC[10] = acc; }
    __syncthreads();
}
__device__ __forceinline__ void permute_phase(Frame& F) {
    moe_offsets(F);
    const unsigned char* Hb = F.ws + WS_H; unsigned char* HS = F.ws + WS_HS;
    const int gw = F.vcu * NWAVES + F.wave, NGW = F.G * NWAVES;
    for (int mb = gw * 16; mb < T; mb += NGW * 16) {
        unsigned d1 = 0u, d2 = 0u;
        if (F.lane < 16) { v2u pp = ((const v2u*)(F.ws + WS_RTPOS))[mb + F.lane];
            const unsigned e1 = pp.x >> 20, e2 = pp.y >> 20; d1 = F.MISC[12 + e1] * 256u + (pp.x & 0xfffffu); d2 = F.MISC[12 + e2] * 256u + (pp.y & 0xfffffu);
            pp.x = d1; pp.y = d2; ((v2u*)(F.ws + WS_RTPOS))[mb + F.lane] = pp; }
#pragma unroll 1
        for (int i = 0; i < 16; i += 8) {
            v4u a[8];
#pragma unroll
            for (int k = 0; k < 8; ++k) a[k] = ((const v4u*)(Hb + (size_t)(mb + i + k) * D))[F.lane];
#pragma unroll
            for (int k = 0; k < 8; ++k) { const unsigned p1 = (unsigned)__shfl((int)d1, i + k), p2 = (unsigned)__shfl((int)d2, i + k);
                ((v4u*)(HS + (size_t)p1 * D))[F.lane] = a[k]; ((v4u*)(HS + (size_t)p2 * D))[F.lane] = a[k]; }
        }
    }
    int k = 0;
    for (int e = 0; e < NE; ++e) { const unsigned c = __hip_atomic_load(F.ctl + CW_CNT + 64 * e, RLX_AGENT); const unsigned r0 = F.MISC[12 + e] * 256u + c, r1 = F.MISC[13 + e] * 256u;
        for (unsigned r = r0; r < r1; ++r, ++k) if ((k % NGW) == gw) { const v4u z = (v4u){0u, 0u, 0u, 0u}; ((v4u*)(HS + (size_t)r * D))[F.lane] = z; } }
}
__device__ __forceinline__ void final_phase(Frame& F, const In& I, float* xio) {
    const bf16* YS = (const bf16*)(F.ws + WS_YS);
    f32x4 gp[4]; load_row_f32(I.norm_g + (size_t)(1 * 4 + 3) * D, F.lane, gp);
    for (int tile = F.vcu; tile < T / 128; tile += F.G) {
        const int mb = tile * 128 + F.wave * 16;
        v2u pp = (v2u){0u, 0u}; f32x2 gg = (f32x2){0.f, 0.f};
        if (F.lane < 16) { pp = ((const v2u*)(F.ws + WS_RTPOS))[mb + F.lane]; gg = ((const f32x2*)(F.ws + WS_RTG))[mb + F.lane]; }
        f32x4 anA[4], bnA[4], xnA[4], anB[4], bnB[4], xnB[4];
        load_row_bf16(YS + (size_t)(unsigned)__shfl((int)pp.x, 0) * D, F.lane, anA); load_row_bf16(YS + (size_t)(unsigned)__shfl((int)pp.y, 0) * D, F.lane, bnA); load_row_f32(xio + (size_t)mb * D, F.lane, xnA);
        load_row_bf16(YS + (size_t)(unsigned)__shfl((int)pp.x, 1) * D, F.lane, anB); load_row_bf16(YS + (size_t)(unsigned)__shfl((int)pp.y, 1) * D, F.lane, bnB); load_row_f32(xio + (size_t)(mb + 1) * D, F.lane, xnB);
#pragma unroll 1
        for (int i = 0; i < 16; i += 2) {
            const int m = mb + i;
            f32x4 aA[4], xA[4], aB[4], xB[4];
            const float g1A = __shfl(gg.x, i), g2A = __shfl(gg.y, i), g1B = __shfl(gg.x, i + 1), g2B = __shfl(gg.y, i + 1);
#pragma unroll
            for (int j = 0; j < 4; ++j) { aA[j] = anA[j] * g1A + bnA[j] * g2A; aB[j] = anB[j] * g1B + bnB[j] * g2B; xA[j] = xnA[j]; xB[j] = xnB[j]; }
            if (i + 2 < 16) {
                load_row_bf16(YS + (size_t)(unsigned)__shfl((int)pp.x, i + 2) * D, F.lane, anA); load_row_bf16(YS + (size_t)(unsigned)__shfl((int)pp.y, i + 2) * D, F.lane, bnA); load_row_f32(xio + (size_t)(m + 2) * D, F.lane, xnA);
                load_row_bf16(YS + (size_t)(unsigned)__shfl((int)pp.x, i + 3) * D, F.lane, anB); load_row_bf16(YS + (size_t)(unsigned)__shfl((int)pp.y, i + 3) * D, F.lane, bnB); load_row_f32(xio + (size_t)(m + 3) * D, F.lane, xnB); }
            float rA, rB; row_rstd2(aA, aB, rA, rB);
#pragma unroll
            for (int j = 0; j < 4; ++j) { xA[j] += aA[j] * rA * gp[j]; xB[j] += aB[j] * rB * gp[j]; }
            store_row_f32(xio + (size_t)m * D, F.lane, xA); store_row_f32(xio + (size_t)(m + 1) * D, F.lane, xB);
        }
    }
}
__device__ __forceinline__ void scan_phase(Frame& F, int bh) {
    const int b = bh / NH, h = bh % NH; const float* lf = (const float*)(F.ws + WS_LOGF) + (size_t)b * SEQ * 16 + h; float* ncs = (float*)(F.ws + WS_NCS) + (size_t)bh * SEQ;
    LAS float* part = (LAS float*)(F.lds + RING_OFF);
    float v[16]; float s = 0.f; const int s0 = F.tid * 16;
#pragma unroll
    for (int i = 0; i < 16; ++i) { v[i] = lf[(size_t)(s0 + i) * 16]; s += v[i]; }
    float incl = s;
#pragma unroll
    for (int o = 1; o < 64; o <<= 1) { const float t = __shfl_up(incl, o); if (F.lane >= o) incl += t; }
    if (F.lane == 63) part[F.wave] = incl;
    __syncthreads();
    float base = incl - s;
    for (int w = 0; w < F.wave; ++w) base += part[w];
    float run = base;
#pragma unroll
    for (int i = 0; i < 16; i += 4) { f32x4 o4; run += v[i]; o4.x = -1.4426950408889634f * run; run += v[i + 1]; o4.y = -1.4426950408889634f * run; run += v[i + 2]; o4.z = -1.4426950408889634f * run; run += v[i + 3]; o4.w = -1.4426950408889634f * run;
        *(f32x4*)(ncs + s0 + i) = o4; }
    __syncthreads();
}

__device__ __forceinline__ bool attn_next(int vcu, int G, int i, int& bh, int& qb) {
    if (G == 256) { if (i >= 8) return false; const int s = vcu & 3; bh = vcu >> 2; const int base = 8 * (i >> 1); qb = (i & 1) ? base + 7 - s : base + s; return true; }
    const int u = vcu + i * G; if (u >= 64 * 32) return false; bh = u >> 5; qb = 31 - (u & 31); return true;
}

struct Args { const float* in[14]; float* out; unsigned char* ws; int ph_lo, ph_hi; };
__global__ void __launch_bounds__(NWAVES * 64, 2) trunk_fwd(Args args) {
    extern __shared__ __attribute__((aligned(16))) unsigned char lds[];
    Frame F;
    F.lds = (LAS unsigned char*)lds;
    F.MISC = (volatile LAS unsigned*)(F.lds + MISC_OFF);
    F.tid = threadIdx.x; F.lane = F.tid & 63; F.wave = __builtin_amdgcn_readfirstlane(F.tid >> 6);
    F.G = gridDim.x; { const int bx = blockIdx.x; F.vcu = (F.G % 8 == 0) ? (bx % 8) * (F.G / 8) + bx / 8 : bx; }
    F.ws = args.ws; F.ctl = (gu32*)(args.ws + WS_CTL);
    const __attribute__((address_space(4))) Args* const ka = (const __attribute__((address_space(4))) Args*)__builtin_amdgcn_kernarg_segment_ptr();
#define KA_IN(i) ((const float*)*(const float* const volatile __attribute__((address_space(4)))*)&ka->in[i])
#define LOAD_IN() In I; I.x = KA_IN(0); I.norm_g = KA_IN(1); I.pool_w = KA_IN(2); I.pool_scale = KA_IN(3); I.w_in = KA_IN(4); I.b_f = KA_IN(5); I.w_out = KA_IN(6); \
    I.w_gate = KA_IN(7); I.w_up = KA_IN(8); I.w_down = KA_IN(9); I.w_router = KA_IN(10); I.mw_gate = KA_IN(11); I.mw_up = KA_IN(12); I.mw_down = KA_IN(13); \
    float* const out = (float*)*(float* const volatile __attribute__((address_space(4)))*)&ka->out; (void)out; (void)I; RELAUNDER()
#define RELAUNDER() do { int t_ = threadIdx.x; asm volatile("" : "+v"(t_)); F.tid = t_; F.lane = t_ & 63; } while (0)
    unsigned char* const ws = args.ws;
    for (int u = F.tid; u < (LDS_BYTES - LDSCTL_OFF) / 4; u += NWAVES * 64) ((LAS unsigned*)(F.lds + LDSCTL_OFF))[u] = 0u;
    __syncthreads();
    XcdBarrier bar; bar.bar = (unsigned*)(F.ctl + CW_BAR); bar.x = 0; bar.st = nullptr;
#if !MK_PER_PHASE
    bar = xcd_barrier_post((unsigned*)(F.ctl + CW_BAR), F.MISC + 8);
#endif
    const int lo = args.ph_lo, hi = args.ph_hi;
#define IN(k) (lo <= (k) && (k) < hi)
#ifndef MK_REPEAT
#define MK_REPEAT (-1)
#endif
#define PHASE(k) for (int rep_ = 0; rep_ < ((MK_REPEAT == (k)) ? 2 : 1); ++rep_) if (rep_ ? (xcd_barrier(bar), true) : true) if (IN(k))
#define SEAM(k) do { if (IN(k) && IN((k) + 1)) { xcd_barrier(bar); } } while (0)
    const int cblk = (int)blockIdx.x;

    PHASE(PH_PRO) { LOAD_IN(); p0_prologue(F, I); } SEAM(PH_PRO);

    PHASE(PH_MIX0) { LOAD_IN(); mix0_phase(F, I, out); } SEAM(PH_MIX0);

    PHASE(PH_GU0) {
        pg8::GemmK g{D, D, D};
        pg8::DenseOrder S{T / 256, FF0 / 128, (T / 256) * (FF0 / 128), F.G, cblk, (const char*)(ws + WS_H), (const char*)(ws + WS_WGU0), (size_t)256 * D * 2, 0, (size_t)256 * D * 2};
        pg8::EpiSwiGLU E{(bf16*)(ws + WS_ACT0), FF0};
        pg8::gemm_phase<pg8::EpiSwiGLU, pg8::DenseOrder, true>(F.lds + RING_OFF, g, S, E);
    } SEAM(PH_GU0);

    PHASE(PH_DN0) {
        pg8::GemmK g{FF0, FF0, FF0};
        pg8::DenseOrder S{T / 256, D / 256, (T / 256) * (D / 256), F.G, cblk, (const char*)(ws + WS_ACT0), (const char*)(ws + WS_WD0), (size_t)256 * FF0 * 2, 0, (size_t)256 * FF0 * 2};
        pg8::EpiBf16 E{(bf16*)(ws + WS_YB), D, nullptr, 0, 0, 1.f};
        pg8::gemm_phase<pg8::EpiBf16, pg8::DenseOrder, true>(F.lds + RING_OFF, g, S, E);
    } SEAM(PH_DN0);

    PHASE(PH_THB) { LOAD_IN(); thin_phase<1>(F, I, (const bf16*)(ws + WS_YB), out, out, I.norm_g + 3 * D, I.norm_g + 4 * D); } SEAM(PH_THB);

    PHASE(PH_QKV) {
        RELAUNDER();
        for (int bh = cblk; bh < BATCH * NH; bh += F.G) scan_phase(F, bh);
        pg8::GemmK g{D, D, D};
        pg8::DenseOrder S{T / 256, 12, (T / 256) * 12, F.G, cblk, (const char*)(ws + WS_H), (const char*)(ws + WS_WIN), (size_t)256 * D * 2, 0, (size_t)256 * D * 2};
        pg8::EpiQKV E{(bf16*)(ws + WS_Q), D, (size_t)(WS_K - WS_Q) / 2, attn_body::C2, (unsigned*)(F.ctl + CW_MAXQ), (unsigned*)(F.ctl + CW_MAXK)};
        pg8::gemm_phase<pg8::EpiQKV, pg8::DenseOrder, true>(F.lds + RING_OFF, g, S, E);
    } SEAM(PH_QKV);

    PHASE(PH_ATT) {
        RELAUNDER();
        unsigned nxt = 0u;
        if (F.tid == 0) { nxt = __hip_atomic_fetch_add(F.ctl + CW_AQ + 64 * rep_, 1u, RLX_AGENT); F.MISC[11] = nxt; }
        __syncthreads();
        unsigned cur = (unsigned)__builtin_amdgcn_readfirstlane((int)F.MISC[11]);
        while (cur < (unsigned)(BATCH * NH * 32)) {
            if (F.tid == 0) nxt = __hip_atomic_fetch_add(F.ctl + CW_AQ + 64 * rep_, 1u, RLX_AGENT);
            const int qb = 31 - (int)(cur >> 6), bh = (int)(cur & 63u), q0 = qb * 256, NT = (q0 + 256) / 64;
            const float* ncs = (const float*)(ws + WS_NCS) + (size_t)bh * SEQ;
            const float mq = __uint_as_float(__hip_atomic_load(F.ctl + CW_MAXQ + bh, RLX_AGENT)), mk = __uint_as_float(__hip_atomic_load(F.ctl + CW_MAXK + bh, RLX_AGENT));
            const float theta = 4.08f * mq * mk + 40.f;
            const int j = 2 * F.lane + 1; bool skip = false;
            if (j + 5 <= NT) skip = (ncs[q0] - ncs[64 * j + 63]) >= theta;
            const int tstart = 2 * (int)__popcll(__ballot(skip));
            attn_body::attn_unit<24>(bh / NH, bh % NH, qb, tstart, (const attn_body::bf16*)(ws + WS_Q), (const attn_body::bf16*)(ws + WS_K), (const attn_body::bf16*)(ws + WS_V), (attn_body::bf16*)(ws + WS_H),
                                     (const float*)(ws + WS_NCS), (char*)lds + RING_OFF);
            if (F.tid == 0) F.MISC[11] = nxt;
            __syncthreads();
            cur = (unsigned)__builtin_amdgcn_readfirstlane((int)F.MISC[11]);
        }
    } SEAM(PH_ATT);

    PHASE(PH_WO) {
        pg8::GemmK g{D, D, D};
        pg8::DenseOrder S{T / 256, D / 256, (T / 256) * (D / 256), F.G, cblk, (const char*)(ws + WS_H), (const char*)(ws + WS_WOUT), (size_t)256 * D * 2, 0, (size_t)256 * D * 2};
        pg8::EpiBf16 E{(bf16*)(ws + WS_YATT), D, nullptr, 0, 0, 1.f};
        pg8::gemm_phase<pg8::EpiBf16, pg8::DenseOrder, true>(F.lds + RING_OFF, g, S, E);
    } SEAM(PH_WO);

    PHASE(PH_THC) { LOAD_IN(); thin_phase<2>(F, I, (const bf16*)(ws + WS_YATT), out, out, I.norm_g + 5 * D, I.norm_g + 6 * D); } SEAM(PH_THC);

    PHASE(PH_PERM) { RELAUNDER(); permute_phase(F); } SEAM(PH_PERM);

    if (hi > PH_MOE && lo < PH_FIN) {
        RELAUNDER();
        moe_offsets(F);
        const int nRT = (int)F.MISC[10];
        for (int c = 0; c < MAXCHUNK; ++c) {
            const int rt0 = c * CHUNK_RT; int nM = nRT - rt0; if (c == 0 && nM > CHUNK_RT) nM = CHUNK_RT;
            PHASE(PH_MOE + 2 * c) if (nM > 0) {
                pg8::GemmK g{D / 2, D / 2, D / 2};
                pg8::MoeOrder S{rt0, nM, FFE / 128, nM * (FFE / 128), F.G, cblk, (const char*)(ws + WS_HS), (size_t)256 * D, 0, (const char*)(ws + WS_WGU), (size_t)2 * FFE * D, (size_t)256 * D, 0, (const LAS unsigned*)(F.lds + MISC_OFF + 48)};
                pg8::EpiSwiGLU8 E{ws + WS_ACTC, FFE, 1.0f / WGU_PRESCALE};
                pg8::gemm_phase<pg8::EpiSwiGLU8, pg8::MoeOrder, true, true>(F.lds + RING_OFF, g, S, E);
            }
            SEAM(PH_MOE + 2 * c);
            PHASE(PH_MOE + 2 * c + 1) if (nM > 0) {
                pg8::GemmK g{FFE / 2, FFE / 2, FFE / 2};
                pg8::MoeOrder S{rt0, nM, D / 256, nM * (D / 256), F.G, cblk, (const char*)(ws + WS_ACTC), (size_t)256 * FFE, 1, (const char*)(ws + WS_WD), (size_t)D * FFE, (size_t)256 * FFE, 1, (const LAS unsigned*)(F.lds + MISC_OFF + 48)};
                pg8::EpiBf16 E{(bf16*)(ws + WS_YS), D, nullptr, 0, 0, 1.0f / WD_PRESCALE};
                pg8::gemm_phase<pg8::EpiBf16, pg8::MoeOrder, true, true>(F.lds + RING_OFF, g, S, E);
            }
            SEAM(PH_MOE + 2 * c + 1);
        }
    }

    PHASE(PH_FIN) { LOAD_IN(); final_phase(F, I, out); }
#undef IN
#undef SEAM
}

extern "C" void kernel_launch(void* const* d_in, const int* in_sizes, int n_in, void* d_out, int out_size, void* d_ws, size_t ws_size, hipStream_t stream) {
    static int grid = 0;
    if (grid == 0) {
        if (n_in != 14 || in_sizes[0] != T * D || out_size != T * D || ws_size < WS_END) { fprintf(stderr, "kernel_launch: unexpected shapes (n_in %d, in0 %d, out %d, ws %zu); nothing launched\n", n_in, n_in > 0 ? in_sizes[0] : -1, out_size, ws_size); grid = -1; return; }
        int dev = 0, cus = 0, per_cu = 0;
        if (hipGetDevice(&dev) != hipSuccess || hipDeviceGetAttribute(&cus, hipDeviceAttributeMultiprocessorCount, dev) != hipSuccess) { grid = -1; return; }
        if (hipFuncSetAttribute((const void*)trunk_fwd, hipFuncAttributeMaxDynamicSharedMemorySize, LDS_BYTES) != hipSuccess) { fprintf(stderr, "kernel_launch: hipFuncSetAttribute failed\n"); grid = -1; return; }
        if (hipOccupancyMaxActiveBlocksPerMultiprocessor(&per_cu, (const void*)trunk_fwd, NWAVES * 64, LDS_BYTES) != hipSuccess || per_cu < 1)
            fprintf(stderr, "kernel_launch: note: occupancy query reports %d workgroups per CU\n", per_cu);
        (void)hipGetLastError();
        grid = cus;
    }
    if (grid < 0) return;
    if (hipMemsetAsync((char*)d_ws + WS_CTL, 0, CTL_ZERO_BYTES, stream) != hipSuccess) return;
    Args a{};
    for (int i = 0; i < 14; ++i) a.in[i] = (const float*)d_in[i];
    a.out = (float*)d_out; a.ws = (unsigned char*)d_ws;
#if MK_PER_PHASE
    for (int p = 0; p < MK_LAST_PHASE; ++p) { a.ph_lo = p; a.ph_hi = p + 1; hipLaunchKernelGGL(trunk_fwd, dim3(grid), dim3(NWAVES * 64), LDS_BYTES, stream, a); }
#else
    a.ph_lo = 0; a.ph_hi = MK_LAST_PHASE;
    hipLaunchKernelGGL(trunk_fwd, dim3(grid), dim3(NWAVES * 64), LDS_BYTES, stream, a);
#endif
}
```

```cpp
#include <hip/hip_runtime.h>
#include <hip/hip_bf16.h>
#include <cstdio>
#include <cstdint>
#include <cmath>

#ifndef MK_PER_PHASE
#define MK_PER_PHASE 0
#endif
#ifndef MK_FFN0_DN_FP8
#define MK_FFN0_DN_FP8 1
#endif
#define MK_FFN0_DNF8 (MK_FFN0_FP8 || MK_FFN0_DN_FP8)
#ifndef MK_FFN0_FP8
#define MK_FFN0_FP8 0
#endif
#ifndef MK_LAST_PHASE
#define MK_LAST_PHASE 15
#endif

namespace pg8 {
#define PG8_LAS __attribute__((address_space(3)))
typedef unsigned short bf16_t;
typedef short bf16x8 __attribute__((ext_vector_type(8)));
typedef float f32x4 __attribute__((ext_vector_type(4)));
typedef unsigned u32x4 __attribute__((ext_vector_type(4)));
constexpr int BM = 256, BK = 64, HALF = 128, HTB = HALF * BK * 2, STAGE_BYTES = 8 * HTB, NXCD = 8, WGM = 8;

__host__ __device__ __forceinline__ int lds_byte(int r, int c) { const int st = (r >> 4) * 2 + (c >> 5), rr = r & 15, cc = c & 31, ob = rr * 64 + cc * 2; return st * 1024 + (ob ^ (((ob >> 9) & 1) << 5)); }
__host__ __device__ __forceinline__ void stage_rc(int b, int& R, int& C) { const int st = b / 1024, sb = b % 1024, swz = sb ^ (((sb >> 9) & 1) << 5); R = (st >> 1) * 16 + swz / 64; C = (st & 1) * 32 + (swz % 64) / 2; }
__host__ __device__ __forceinline__ int perm32(int rho) { const int n = rho >> 4, i = rho & 15; return 8 * (i >> 2) + 4 * n + (i & 3); }

struct Unit { int pm, pn; const char* A; const char* B; int arow; };
struct GemmK { int K, lda, ldb; };

__device__ __forceinline__ void tile_of(int wgid_in, int nM, int nN, int& pm, int& pn) {
    const int nwg = nM * nN; int wgid = wgid_in;
    { const int q = nwg / NXCD, r = nwg % NXCD, xcd = wgid % NXCD, off = wgid / NXCD; wgid = (xcd < r ? xcd * (q + 1) : r * (q + 1) + (xcd - r) * q) + off; }
    const int nig = WGM * nN, gid = wgid / nig, fm = gid * WGM, gsz = (nM - fm) < WGM ? (nM - fm) : WGM;
    pm = fm + ((wgid % nig) % gsz); pn = (wgid % nig) / gsz;
}
struct DenseOrder {
    int nM, nN, nwg, G, c; const char* A; const char* B; size_t a_tile, a_pn, b_tile;
    __device__ __forceinline__ bool next(int i, Unit& u) const {
        const int L = i * G + c; if (L >= nwg) return false;
        int pm, pn; tile_of(L, nM, nN, pm, pn);
        u.pm = pm; u.pn = pn; u.A = A + (size_t)pm * a_tile + (size_t)pn * a_pn; u.B = B + (size_t)pn * b_tile; u.arow = 0; return true;
    }
};
template <int NN, size_t A_TILE, int A_LOCAL, size_t B_EXP, size_t B_TILE, int PM_GLOBAL>
struct MoeOrder {
    int rt0, nM, G, c; const char* A; const char* B; const PG8_LAS unsigned* toff;
    __device__ __forceinline__ bool next(int i, Unit& u) const {
        const int L = i * G + c; if (L >= nM * NN) return false;
        int pm, pn; tile_of(L, nM, NN, pm, pn);
        const int rt = rt0 + pm; int e = 0;
#pragma unroll
        for (int j = 1; j < 8; ++j) e += ((unsigned)rt >= toff[j]) ? 1 : 0;
        e = __builtin_amdgcn_readfirstlane(e);
        u.pm = PM_GLOBAL ? rt : pm; u.pn = pn; u.A = A + (size_t)(A_LOCAL ? pm : rt) * A_TILE; u.B = B + (size_t)e * B_EXP + (size_t)pn * B_TILE; u.arow = __builtin_amdgcn_readfirstlane(e * 32768 + (rt - (int)toff[e]) * 256); return true;
    }
};

__device__ __forceinline__ unsigned cvt_pk_bf16(float lo, float hi) { unsigned r; asm volatile("v_cvt_pk_bf16_f32 %0, %1, %2" : "=v"(r) : "v"(lo), "v"(hi)); return r; }

struct EpiBf16 {
    static constexpr bool PERM = true;
    bf16_t* O; int ldc; const float* cscale; int split_cols; size_t split_stride; float scale0;
    __device__ __forceinline__ void operator()(const f32x4 (&acc)[2][2][4][2], const Unit& u, int wr, int wc, int fr, int fq) const {
        const int row0 = u.pm * BM + wr * 64 + fr; int colt = u.pn * BM; bf16_t* base = O;
        float sc = split_cols ? 1.f : scale0; if (split_cols) { const int t = colt / split_cols; base += (size_t)t * split_stride; colt -= t * split_cols; if (t == 0) sc = scale0; }
        const int col0 = colt + wc * 32 + 8 * fq, scol0 = u.pn * BM + wc * 32 + 8 * fq;
        f32x4 sv[2][2];
#pragma unroll
        for (int bj = 0; bj < 2; ++bj)
#pragma unroll
            for (int n = 0; n < 2; ++n) { sv[bj][n] = cscale ? *(const f32x4*)(cscale + scol0 + bj * HALF + 4 * n) : (f32x4){1.f, 1.f, 1.f, 1.f}; sv[bj][n] = sv[bj][n] * sc; }
#pragma unroll
        for (int ai = 0; ai < 2; ++ai)
#pragma unroll
            for (int m = 0; m < 4; ++m) { bf16_t* rowp = base + (size_t)(row0 + ai * HALF + m * 16) * ldc + col0;
#pragma unroll
                for (int bj = 0; bj < 2; ++bj) { const f32x4 v0 = acc[ai][bj][m][0] * sv[bj][0], v1 = acc[ai][bj][m][1] * sv[bj][1];
                    u32x4 w; w.x = cvt_pk_bf16(v0[0], v0[1]); w.y = cvt_pk_bf16(v0[2], v0[3]); w.z = cvt_pk_bf16(v1[0], v1[1]); w.w = cvt_pk_bf16(v1[2], v1[3]);
                    *(u32x4*)(rowp + bj * HALF) = w; } }
    }
};
struct EpiQKV {
    static constexpr bool PERM = true;
    bf16_t* O; int ldc; size_t split_stride; float scale0; float* maxq; float* maxk; float* kbar;
    __device__ __forceinline__ void operator()(const f32x4 (&acc)[2][2][4][2], const Unit& u, int wr, int wc, int fr, int fq) const {
        const int row0 = u.pm * BM + wr * 64 + fr; int colt = u.pn * BM; const int t = colt >> 10; bf16_t* base = O + (size_t)t * split_stride; colt -= t << 10;
        const float sc = (t == 0) ? scale0 : 1.f;
        const int col0 = colt + wc * 32 + 8 * fq;
        float nm0 = 0.f, nm1 = 0.f;
#pragma unroll
        for (int ai = 0; ai < 2; ++ai)
#pragma unroll
            for (int m = 0; m < 4; ++m) { bf16_t* rowp = base + (size_t)(row0 + ai * HALF + m * 16) * ldc + col0;
#pragma unroll
                for (int bj = 0; bj < 2; ++bj) { const f32x4 v0 = acc[ai][bj][m][0] * sc, v1 = acc[ai][bj][m][1] * sc;
                    u32x4 w; w.x = cvt_pk_bf16(v0[0], v0[1]); w.y = cvt_pk_bf16(v0[2], v0[3]); w.z = cvt_pk_bf16(v1[0], v1[1]); w.w = cvt_pk_bf16(v1[2], v1[3]);
                    *(u32x4*)(rowp + bj * HALF) = w;
                    if (t < 2) { float s = (v0[0] * v0[0] + v0[1] * v0[1]) + (v0[2] * v0[2] + v0[3] * v0[3]) + (v1[0] * v1[0] + v1[1] * v1[1]) + (v1[2] * v1[2] + v1[3] * v1[3]);
                        s += __shfl_xor(s, 16); s += __shfl_xor(s, 32); if (bj == 0) nm0 = fmaxf(nm0, s); else nm1 = fmaxf(nm1, s); } } }
        if (t < 2) {
#pragma unroll
            for (int o = 1; o < 16; o <<= 1) { nm0 = fmaxf(nm0, __shfl_xor(nm0, o)); nm1 = fmaxf(nm1, __shfl_xor(nm1, o)); }
            if ((threadIdx.x & 63) == 0) { float* dst = (t == 0 ? maxq : maxk) + (size_t)(u.pm * 2 + wr) * 32 + (4 * (u.pn & 3) + (wc >> 1)) * 2 + (wc & 1);
                dst[0] = sqrtf(nm0); dst[4] = sqrtf(nm1); }
        }
        if (t == 1) {
            const int ln = threadIdx.x & 63;
#pragma unroll
            for (int ai = 0; ai < 2; ++ai)
#pragma unroll
                for (int bj = 0; bj < 2; ++bj) {
                    float c[8];
#pragma unroll
                    for (int e = 0; e < 4; ++e) { c[e] = (acc[ai][bj][0][0][e] + acc[ai][bj][1][0][e]) + (acc[ai][bj][2][0][e] + acc[ai][bj][3][0][e]);
                                                  c[4 + e] = (acc[ai][bj][0][1][e] + acc[ai][bj][1][1][e]) + (acc[ai][bj][2][1][e] + acc[ai][bj][3][1][e]); }
                    { const bool up = (ln & 8) != 0;
#pragma unroll
                      for (int i = 0; i < 4; ++i) { const float send = up ? c[i] : c[i + 4], keep = up ? c[i + 4] : c[i]; c[i] = keep + __shfl_xor(send, 8); } }
                    { const bool up = (ln & 4) != 0;
#pragma unroll
                      for (int i = 0; i < 2; ++i) { const float send = up ? c[i] : c[i + 2], keep = up ? c[i + 2] : c[i]; c[i] = keep + __shfl_xor(send, 4); } }
                    { const bool up = (ln & 2) != 0; const float send = up ? c[0] : c[1], keep = up ? c[1] : c[0]; c[0] = keep + __shfl_xor(send, 2); }
                    float cs = c[0]; cs += __shfl_xor(cs, 1);
                    float q2 = cs * cs;
#pragma unroll
                    for (int o = 1; o < 64; o <<= 1) q2 += __shfl_xor(q2, o);
                    if (ln == 0) kbar[((size_t)(u.pm * 4 + wr + 2 * ai) * 16 + (4 * (u.pn & 3) + (wc >> 1) + 2 * bj)) * 2 + (wc & 1)] = q2 * (0.5f / 4096.f);
                }
        }
    }
};
__device__ __forceinline__ float silu_mul(float g, float u) { const float e = __builtin_amdgcn_exp2f(g * -1.4426950408889634f); return g * __builtin_amdgcn_rcpf(1.0f + e) * u; }
struct EpiSwiGLU {
    static constexpr bool PERM = true;
    bf16_t* O; int ldc;
    __device__ __forceinline__ void operator()(const f32x4 (&acc)[2][2][4][2], const Unit& u, int wr, int wc, int fr, int fq) const {
        const int row0 = u.pm * BM + wr * 64 + fr, col0 = u.pn * HALF + wc * 32 + 8 * fq;
#pragma unroll
        for (int ai = 0; ai < 2; ++ai)
#pragma unroll
            for (int m = 0; m < 4; ++m) { bf16_t* rowp = O + (size_t)(row0 + ai * HALF + m * 16) * ldc + col0;
                const f32x4 g0 = acc[ai][0][m][0], g1 = acc[ai][0][m][1], u0 = acc[ai][1][m][0], u1 = acc[ai][1][m][1];
                u32x4 w; w.x = cvt_pk_bf16(silu_mul(g0[0], u0[0]), silu_mul(g0[1], u0[1])); w.y = cvt_pk_bf16(silu_mul(g0[2], u0[2]), silu_mul(g0[3], u0[3]));
                w.z = cvt_pk_bf16(silu_mul(g1[0], u1[0]), silu_mul(g1[1], u1[1])); w.w = cvt_pk_bf16(silu_mul(g1[2], u1[2]), silu_mul(g1[3], u1[3]));
                *(u32x4*)rowp = w; }
    }
};

__device__ __forceinline__ unsigned pk4_fp8(float a, float b, float c, float d) { int w = 0; w = __builtin_amdgcn_cvt_pk_fp8_f32(a, b, w, false); w = __builtin_amdgcn_cvt_pk_fp8_f32(c, d, w, true); return (unsigned)w; }
template <int INV_ASCALE>
struct EpiSwiGLU8 {
    static constexpr bool PERM = true;
    static constexpr float ascale = 1.0f / (float)INV_ASCALE;
    unsigned char* O; int ldc;
    __device__ __forceinline__ void operator()(const f32x4 (&acc)[2][2][4][2], const Unit& u, int wr, int wc, int fr, int fq) const {
        const int row0 = u.pm * BM + wr * 64 + fr, col0 = u.pn * HALF + wc * 32 + 8 * fq;
        unsigned char* Ob = O; asm volatile("" : "+s"(Ob));
#pragma unroll
        for (int ai = 0; ai < 2; ++ai)
#pragma unroll
            for (int m = 0; m < 4; ++m) { unsigned char* rowp = Ob + (size_t)(row0 + ai * HALF + m * 16) * ldc + col0;
                const f32x4 g0 = acc[ai][0][m][0], g1 = acc[ai][0][m][1], u0 = acc[ai][1][m][0], u1 = acc[ai][1][m][1];
                constexpr float c1 = -1.4426950408889634f * ascale, ia2 = 1.0f / (ascale * ascale);
#define SM8(G, U) (((G) * (U)) * __builtin_amdgcn_rcpf(__builtin_fmaf(__builtin_amdgcn_exp2f((G) * c1), ia2, ia2)))
                typedef unsigned u32x2 __attribute__((ext_vector_type(2)));
                u32x2 w; w.x = pk4_fp8(SM8(g0[0], u0[0]), SM8(g0[1], u0[1]), SM8(g0[2], u0[2]), SM8(g0[3], u0[3]));
                w.y = pk4_fp8(SM8(g1[0], u1[0]), SM8(g1[1], u1[1]), SM8(g1[2], u1[2]), SM8(g1[3], u1[3]));
#undef SM8
                *(__attribute__((address_space(1))) u32x2*)rowp = w; }
    }
};

struct EpiFp8 {
    static constexpr bool PERM = true;
    unsigned char* O; int ldc; float scale;
    __device__ __forceinline__ void operator()(const f32x4 (&acc)[2][2][4][2], const Unit& u, int wr, int wc, int fr, int fq) const {
        const int row0 = u.pm * BM + wr * 64 + fr, col0 = u.pn * BM + wc * 32 + 8 * fq;
        typedef unsigned u32x2 __attribute__((ext_vector_type(2)));
#pragma unroll
        for (int ai = 0; ai < 2; ++ai)
#pragma unroll
            for (int m = 0; m < 4; ++m) { unsigned char* rowp = O + (size_t)(row0 + ai * HALF + m * 16) * ldc + col0;
#pragma unroll
                for (int bj = 0; bj < 2; ++bj) { const f32x4 v0 = acc[ai][bj][m][0] * scale, v1 = acc[ai][bj][m][1] * scale;
                    u32x2 w; w.x = pk4_fp8(v0[0], v0[1], v0[2], v0[3]); w.y = pk4_fp8(v1[0], v1[1], v1[2], v1[3]); *(u32x2*)(rowp + bj * HALF) = w; } }
    }
};

typedef int v4i_t __attribute__((ext_vector_type(4)));
typedef int v8i_t __attribute__((ext_vector_type(8)));
__device__ __forceinline__ v8i_t cat8(bf16x8 lo, bf16x8 hi) { const v4i_t a = __builtin_bit_cast(v4i_t, lo), b = __builtin_bit_cast(v4i_t, hi); return __builtin_shufflevector(a, b, 0, 1, 2, 3, 4, 5, 6, 7); }
constexpr int GATHER_IDX_OFF = 133120;
template <class Epi, class Sched, bool ALIGN_EPI, bool F8 = false, bool GATHER = false>
__device__ __forceinline__ void gemm_phase(PG8_LAS unsigned char* lds, const GemmK g, const Sched& S, const Epi& E, const long ridx_delta = 0) {
    int tid_ = threadIdx.x; asm volatile("" : "+v"(tid_));
    const int tid = tid_, wid = __builtin_amdgcn_readfirstlane(tid >> 6), lane = tid & 63, wr = wid >> 2, wc = wid & 3, fr = lane & 15, fq = lane >> 4;
    const int K = g.K, nt = K / BK;
    unsigned voffA[2], voffB[2];
#pragma unroll
    for (int i = 0; i < 2; ++i) { int R, C; stage_rc(tid * 16 + i * 8192, R, C); const int Rb = Epi::PERM ? ((R & ~31) + perm32(R & 31)) : R;
        voffA[i] = (unsigned)(R * g.lda + C) * 2u; voffB[i] = (unsigned)(Rb * g.ldb + C) * 2u; }
    const size_t kstep = (size_t)(BK * 2);
    const size_t hstepA = (size_t)HALF * g.lda * 2, hstepB = (size_t)HALF * g.ldb * 2;
    const unsigned ldsw = (unsigned)wid * 1024u;
    const unsigned ldswb = (unsigned)__builtin_amdgcn_readfirstlane((int)(unsigned)(uintptr_t)lds) + ldsw;
    const int aoff = lds_byte(wr * 64 + fr, fq * 8), boff = lds_byte(wc * 32 + fr, fq * 8);
#define PG8_SA(b, h) (((b) * 2 + (h)) * HTB)
#define PG8_SB(b, h) ((4 + (b) * 2 + (h)) * HTB)
#define PG8_STAGE1(bufoff, gbase, voff, I_) do { unsigned keep_; \
        asm volatile("s_mov_b32 %0, m0\n\ts_add_u32 m0, %3, %4\n\ts_nop 2\n\tglobal_load_lds_dwordx4 %1, %2\n\ts_mov_b32 m0, %0" \
            : "=&s"(keep_) : "v"((voff)[I_]), "s"((const char*)(gbase)), "s"(ldswb), "i"((bufoff) + (I_) * 8192) : "memory", "scc"); } while (0)
#define PG8_STAGE(bufoff, gbase, voff) do { PG8_STAGE1(bufoff, gbase, voff, 0); PG8_STAGE1(bufoff, gbase, voff, 1); } while (0)
    unsigned pkA[2] = {0u, 0u};
#define PG8_GVOFF(tv_, SH) do { _Pragma("unroll") for (int i_ = 0; i_ < 2; ++i_) tv_[i_] = ((pkA[i_] >> (SH)) & 0xffffu) * (unsigned)(g.lda * 2) + (voffB[i_] & (unsigned)(g.ldb * 2 - 1)); } while (0)
#define PG8_STA0(bufoff, gbase) do { if constexpr (GATHER) { unsigned tv_[2]; PG8_GVOFF(tv_, 0); PG8_STAGE(bufoff, gbase, tv_); } else PG8_STAGE(bufoff, gbase, voffA); } while (0)
#define PG8_STA1(bufoff, gbase) do { if constexpr (GATHER) { unsigned tv_[2]; PG8_GVOFF(tv_, 16); PG8_STAGE(bufoff, gbase, tv_); } else PG8_STAGE(bufoff, (gbase) + hstepA, voffA); } while (0)
#define PG8_GATHER_SET(SRC) do { int tg_ = threadIdx.x; asm volatile("" : "+v"(tg_)); _Pragma("unroll") for (int i = 0; i < 2; ++i) { int R, C; stage_rc(tg_ * 16 + i * 8192, R, C); \
        const unsigned r0_ = (SRC)[R], r1_ = (SRC)[128 + R]; pkA[i] = (r0_ & 0xffffu) | (r1_ << 16); } } while (0)
#define PG8_LDA(dst, b, h) do { _Pragma("unroll") for (int m = 0; m < 4; ++m) _Pragma("unroll") for (int k = 0; k < 2; ++k) dst[m][k] = *(const PG8_LAS bf16x8*)(lds + PG8_SA(b, h) + aoff + m * 2048 + k * 1024); } while (0)
#define PG8_LDB(dst, b, h) do { _Pragma("unroll") for (int n = 0; n < 2; ++n) _Pragma("unroll") for (int k = 0; k < 2; ++k) dst[n][k] = *(const PG8_LAS bf16x8*)(lds + PG8_SB(b, h) + boff + n * 2048 + k * 1024); } while (0)
#define PG8_MMA(ai, bj, At, Bt) do { __builtin_amdgcn_s_setprio(1); if constexpr (F8) { _Pragma("unroll") for (int m = 0; m < 4; ++m) _Pragma("unroll") for (int n = 0; n < 2; ++n) \
        acc[ai][bj][m][n] = __builtin_amdgcn_mfma_scale_f32_16x16x128_f8f6f4(cat8(Bt[n][0], Bt[n][1]), cat8(At[m][0], At[m][1]), acc[ai][bj][m][n], 0, 0, 0, 0, 0, 0); } \
        else { _Pragma("unroll") for (int m = 0; m < 4; ++m) _Pragma("unroll") for (int n = 0; n < 2; ++n) _Pragma("unroll") for (int k = 0; k < 2; ++k) \
        acc[ai][bj][m][n] = __builtin_amdgcn_mfma_f32_16x16x32_bf16(Bt[n][k], At[m][k], acc[ai][bj][m][n], 0, 0, 0); } __builtin_amdgcn_s_setprio(0); } while (0)
#define PG8_WAIT_V(n) asm volatile("s_waitcnt vmcnt(" #n ")" ::: "memory")
#define PG8_WAIT_L(n) asm volatile("s_waitcnt lgkmcnt(" #n ")" ::: "memory")
#define PG8_BAR __builtin_amdgcn_s_barrier()
#define PG8_SCHED __builtin_amdgcn_sched_barrier(0)
    Unit cur, nxt; int ui = 0;
    if (!S.next(0, cur)) return;
    f32x4 acc[2][2][4][2];
#define PG8_ZERO_ACC() do { _Pragma("unroll") for (int a = 0; a < 2; ++a) _Pragma("unroll") for (int b = 0; b < 2; ++b) _Pragma("unroll") for (int m = 0; m < 4; ++m) _Pragma("unroll") for (int n = 0; n < 2; ++n) { \
        f32x2z lo_, hi_; asm volatile("v_mov_b64 %0, 0" : "=v"(lo_)); asm volatile("v_mov_b64 %0, 0" : "=v"(hi_)); acc[a][b][m][n] = (f32x4){lo_[0], lo_[1], hi_[0], hi_[1]}; } } while (0)
    typedef float f32x2z __attribute__((ext_vector_type(2)));
    PG8_ZERO_ACC();
    bf16x8 At[4][2], B0[2][2], B1[2][2];
    const char* cA = cur.A; const char* cB = cur.B;
    if constexpr (GATHER) { const unsigned* src_ = (const unsigned*)(cA + ridx_delta) + cur.arow; PG8_GATHER_SET(src_); }
    PG8_STAGE(PG8_SB(0, 0), cB, voffB); PG8_STAGE(PG8_SB(0, 1), cB + hstepB, voffB); PG8_STA0(PG8_SA(0, 0), cA); PG8_STA1(PG8_SA(0, 1), cA);
    if (wr == 1) PG8_BAR;
    PG8_WAIT_V(2); PG8_BAR;
    PG8_STAGE(PG8_SB(1, 0), cB + kstep, voffB); PG8_STA0(PG8_SA(1, 0), cA + kstep); PG8_STAGE(PG8_SB(1, 1), cB + hstepB + kstep, voffB);
    PG8_WAIT_V(6); PG8_BAR;
    for (;;) {
        const bool has_next = S.next(ui + 1, nxt);
        const char* nA = has_next ? nxt.A : cA; const char* nB = has_next ? nxt.B : cB;
        if constexpr (GATHER) { if (has_next && wid < 4) { unsigned keep_; int tl_ = threadIdx.x; asm volatile("" : "+v"(tl_)); const unsigned vo_ = (unsigned)tl_ * 4u;
            asm volatile("s_mov_b32 %0, m0\n\ts_mov_b32 m0, %3\n\ts_nop 2\n\tglobal_load_lds_dword %1, %2\n\ts_mov_b32 m0, %0"
                : "=&s"(keep_) : "v"(vo_), "s"((const char*)((const unsigned*)(nA + ridx_delta) + nxt.arow)), "s"(ldswb - (unsigned)wid * 768u + (unsigned)GATHER_IDX_OFF) : "memory"); } }
#pragma unroll 1
        for (int t = 0; t < nt; t += 2) {
            const bool last = (t == nt - 2);
            const char* a1 = cA + (size_t)(t + 1) * kstep;
            const char* a2 = last ? nA : cA + (size_t)(t + 2) * kstep; const char* b2 = last ? nB : cB + (size_t)(t + 2) * kstep;
            const char* a3 = a2 + kstep; const char* b3 = b2 + kstep;
            PG8_LDB(B0, 0, 0); PG8_LDB(B1, 0, 1); PG8_SCHED; PG8_LDA(At, 0, 0); PG8_STA1(PG8_SA(1, 1), a1);
            PG8_WAIT_V(8); PG8_WAIT_L(0); PG8_BAR; PG8_MMA(0, 0, At, B0); PG8_MMA(0, 1, At, B1); PG8_BAR; PG8_SCHED;
            if constexpr (GATHER) { if (last) { const PG8_LAS unsigned* li_ = (const PG8_LAS unsigned*)(lds + GATHER_IDX_OFF); PG8_GATHER_SET(li_); } }
            PG8_LDA(At, 0, 1); PG8_STAGE(PG8_SB(0, 0), b2, voffB); PG8_STAGE(PG8_SB(0, 1), b2 + hstepB, voffB); PG8_STA0(PG8_SA(0, 0), a2);
            PG8_WAIT_V(8); PG8_WAIT_L(0); PG8_BAR; PG8_MMA(1, 0, At, B0); PG8_MMA(1, 1, At, B1); PG8_BAR; PG8_SCHED;
            PG8_LDB(B0, 1, 0); PG8_LDB(B1, 1, 1); PG8_SCHED; PG8_LDA(At, 1, 0); PG8_STA1(PG8_SA(0, 1), a2);
            PG8_WAIT_V(8); PG8_WAIT_L(0); PG8_BAR; PG8_MMA(0, 0, At, B0); PG8_MMA(0, 1, At, B1); PG8_BAR; PG8_SCHED;
            PG8_LDA(At, 1, 1); PG8_STAGE(PG8_SB(1, 0), b3, voffB); PG8_STAGE(PG8_SB(1, 1), b3 + hstepB, voffB); PG8_STA0(PG8_SA(1, 0), a3);
            PG8_WAIT_V(8); PG8_WAIT_L(0); PG8_BAR; PG8_MMA(1, 0, At, B0); PG8_MMA(1, 1, At, B1); PG8_BAR; PG8_SCHED;
        }
        if constexpr (ALIGN_EPI) { if (wr == 0) PG8_BAR; }
        { int te_ = threadIdx.x; asm volatile("" : "+v"(te_));
          E(acc, cur, wr, wc, te_ & 15, (te_ >> 4) & 3); }
        if (!has_next) break;
        PG8_ZERO_ACC();
        cur = nxt; cA = nA; cB = nB; ++ui;
        if constexpr (ALIGN_EPI) { if (wr == 1) PG8_BAR; }
    }
    PG8_WAIT_V(0);
    if constexpr (!ALIGN_EPI) { if (wr == 0) PG8_BAR; }
    PG8_BAR;
#undef PG8_SA
#undef PG8_SB
#undef PG8_STAGE
#undef PG8_STAGE1
#undef PG8_STA0
#undef PG8_STA1
#undef PG8_GATHER_SET
#undef PG8_GVOFF
#undef PG8_LDA
#undef PG8_LDB
#undef PG8_MMA
#undef PG8_ZERO_ACC
#undef PG8_WAIT_V
#undef PG8_WAIT_L
#undef PG8_BAR
#undef PG8_SCHED
}
}

namespace attn_body {
using bf16=__hip_bfloat16;
using bf16x8=__attribute__((ext_vector_type(8)))short;
using s16x4=__attribute__((ext_vector_type(4)))short;
using f32x16=__attribute__((ext_vector_type(16)))float;
using f32x4v=__attribute__((ext_vector_type(4)))float;
using u32x4=__attribute__((ext_vector_type(4)))unsigned;
constexpr int BATCH=4,NHEAD=16,SEQ=8192,D=64,DM=NHEAD*D;
constexpr int NW=8,QBLK=32,QB=QBLK*NW,KVBLK=64,NQB=SEQ/QB;
__device__ __forceinline__ int crow(int r,int hi){return (r&3)+8*(r>>2)+4*hi;}
#define SBAR() __builtin_amdgcn_sched_barrier(0)
__device__ __forceinline__ void cmask(f32x16&p0,f32x16&p1,int jb,int qrel,int hi){
  const float NEG=-INFINITY; int kb=64*jb+4*hi;
  #pragma unroll
  for(int r=0;r<16;++r){int kv=kb+(r&3)+8*(r>>2); if(kv>qrel)p0[r]=NEG; if(kv+32>qrel)p1[r]=NEG;}
}
constexpr int NSLOT=3, SLOTB=8192;
constexpr int LDS_K=0, LDS_V=NSLOT*SLOTB, LDS_WS=2*NSLOT*SLOTB, LDS_OST=LDS_WS+NW*64*4, LDS_CS=LDS_OST+NW*4096, LDS_BYTES=LDS_CS+SEQ*4;
constexpr float C2=0.125f*1.4426950408889634f;
__device__ __forceinline__ void glds16(const void*gsrc,unsigned lds_dst){unsigned keep;
  asm volatile("s_mov_b32 %0, m0\n\ts_mov_b32 m0, %2\n\ts_nop 0\n\tglobal_load_lds_dwordx4 %1, off\n\ts_mov_b32 m0, %0":"=&s"(keep):"v"(gsrc),"s"(lds_dst):"memory");}
__device__ __forceinline__ float max3f(float a,float b,float c){float r;asm("v_max3_f32 %0, %1, %2, %3":"=v"(r):"v"(a),"v"(b),"v"(c));return r;}
__device__ __forceinline__ float max2f(float a,float b){float r;asm("v_max_f32_e32 %0, %1, %2":"=v"(r):"v"(a),"v"(b));return r;}
__device__ __forceinline__ float fadd_s(float a,float b){float r;asm("v_add_f32_e32 %0, %1, %2":"=v"(r):"v"(a),"v"(b));return r;}
__device__ __forceinline__ float fsub_s(float a,float b){float r;asm("v_sub_f32_e32 %0, %1, %2":"=v"(r):"v"(a),"v"(b));return r;}
typedef float f32x2_t __attribute__((ext_vector_type(2))); typedef __bf16 bf16x2_t __attribute__((ext_vector_type(2)));
__device__ __forceinline__ unsigned cvtpk_s(float lo,float hi){f32x2_t v={lo,hi};bf16x2_t b=__builtin_convertvector(v,bf16x2_t);return __builtin_bit_cast(unsigned,b);}
#define WAIT_BAR(N) asm volatile("s_waitcnt vmcnt(" #N ") lgkmcnt(0)\n\ts_barrier":::"memory")
typedef __attribute__((address_space(3))) const char* lds_cptr;
typedef short v4i16_t __attribute__((ext_vector_type(4)));
__device__ __forceinline__ void ldbias(f32x16&c0,f32x16&c1,lds_cptr csp,float negm){
  #pragma unroll
  for(int g=0;g<4;++g){ const f32x4v a=*(const __attribute__((address_space(3))) f32x4v*)(csp+g*32); const f32x4v b=*(const __attribute__((address_space(3))) f32x4v*)(csp+128+g*32);
    c0[4*g]=a[0]+negm;c0[4*g+1]=a[1]+negm;c0[4*g+2]=a[2]+negm;c0[4*g+3]=a[3]+negm; c1[4*g]=b[0]+negm;c1[4*g+1]=b[1]+negm;c1[4*g+2]=b[2]+negm;c1[4*g+3]=b[3]+negm; }
}
__device__ __forceinline__ void qkt(f32x16&p0,f32x16&p1,const char*Kslot,const bf16x8*qr,int r32,int hi){
  const char*kb=Kslot+hi*1024+r32*16;
  #pragma unroll
  for(int d0=0;d0<4;++d0){
    const bf16x8 b0=*reinterpret_cast<const bf16x8*>(kb+d0*2048);
    const bf16x8 b1=*reinterpret_cast<const bf16x8*>(kb+d0*2048+512);
    p0=__builtin_amdgcn_mfma_f32_32x32x16_bf16(b0,qr[d0],p0,0,0,0);p1=__builtin_amdgcn_mfma_f32_32x32x16_bf16(b1,qr[d0],p1,0,0,0);}
}
__device__ __forceinline__ void kload8(bf16x8*kf,lds_cptr kp){
  kf[0]=*(const __attribute__((address_space(3))) bf16x8*)(kp);      kf[1]=*(const __attribute__((address_space(3))) bf16x8*)(kp+512);
  kf[2]=*(const __attribute__((address_space(3))) bf16x8*)(kp+2048); kf[3]=*(const __attribute__((address_space(3))) bf16x8*)(kp+2560);
  kf[4]=*(const __attribute__((address_space(3))) bf16x8*)(kp+4096); kf[5]=*(const __attribute__((address_space(3))) bf16x8*)(kp+4608);
  kf[6]=*(const __attribute__((address_space(3))) bf16x8*)(kp+6144); kf[7]=*(const __attribute__((address_space(3))) bf16x8*)(kp+6656);
}
__device__ __forceinline__ void kload2(bf16x8*kf,lds_cptr kp,int j){ kf[2*j]=*(const __attribute__((address_space(3))) bf16x8*)(kp+j*2048); kf[2*j+1]=*(const __attribute__((address_space(3))) bf16x8*)(kp+j*2048+512); }
__device__ __forceinline__ s16x4 vtr(lds_cptr p){ return __builtin_bit_cast(s16x4,__builtin_amdgcn_ds_read_tr16_b64_v4i16((__attribute__((address_space(3))) v4i16_t*)p)); }
__device__ __forceinline__ float rowmax(const f32x16&p0,const f32x16&p1){
  float a=max3f(p0[0],p0[1],p1[0]),b=max3f(p0[2],p0[3],p1[1]);a=max3f(a,p1[2],p1[3]);
  #pragma unroll
  for(int r=4;r<16;r+=4){a=max3f(a,p0[r],p0[r+1]);b=max3f(b,p0[r+2],p0[r+3]);a=max3f(a,p1[r],p1[r+1]);b=max3f(b,p1[r+2],p1[r+3]);}
  const float m=max2f(a,b);
  auto rr=__builtin_amdgcn_permlane32_swap(__float_as_uint(m),__float_as_uint(m),false,false);
  return max2f(__uint_as_float(rr[0]),__uint_as_float(rr[1]));
}
__device__ __forceinline__ void pv(f32x16*o,int vb,bf16x8 pa0,bf16x8 pa1,bf16x8 pa2,bf16x8 pa3){
  #pragma unroll
  for(int d0=0;d0<2;++d0){s16x4 lo[4],hi[4];
    #pragma unroll
    for(int ks=0;ks<4;++ks){
      asm volatile("ds_read_b64_tr_b16 %0,%1 offset:%c2":"=&v"(lo[ks]):"v"(vb),"i"(d0*4096+ks*1024):"memory");
      asm volatile("ds_read_b64_tr_b16 %0,%1 offset:%c2":"=&v"(hi[ks]):"v"(vb),"i"(d0*4096+ks*1024+512):"memory");}
    asm volatile("s_waitcnt lgkmcnt(0)":::"memory");SBAR();
    #define PK(k) (bf16x8){lo[k][0],lo[k][1],lo[k][2],lo[k][3],hi[k][0],hi[k][1],hi[k][2],hi[k][3]}
    o[d0]=__builtin_amdgcn_mfma_f32_32x32x16_bf16(pa0,PK(0),o[d0],0,0,0);
    o[d0]=__builtin_amdgcn_mfma_f32_32x32x16_bf16(pa1,PK(1),o[d0],0,0,0);
    o[d0]=__builtin_amdgcn_mfma_f32_32x32x16_bf16(pa2,PK(2),o[d0],0,0,0);
    o[d0]=__builtin_amdgcn_mfma_f32_32x32x16_bf16(pa3,PK(3),o[d0],0,0,0);
    #undef PK
  }
}
#define ATTN_STORE16(p,v) (*(u32x4*)(p)=(v))
template<int THRL> __device__ __forceinline__ void attn_unit(int b,int h,int qb,int tstart,const bf16*Q,const bf16*__restrict__ K,const bf16*__restrict__ V,bf16*O,const float*NCS,const float*QOFF,char*shm){
  int tid_=threadIdx.x; asm volatile("":"+v"(tid_));
  const int tid=tid_,lane=tid&63,r32=lane&31,hi=lane>>5; const int wid=__builtin_amdgcn_readfirstlane(tid>>6);
  const long rowbase=(long)b*SEQ; const int q0=qb*QB;
  const bf16*Qw=Q+(rowbase+q0+wid*QBLK)*DM+h*D;
  const bf16*Kh=K+(rowbase+(long)tstart*KVBLK)*DM+h*D,*Vh=V+(rowbase+(long)tstart*KVBLK)*DM+h*D;
  const unsigned lds0=(unsigned)(uintptr_t)shm;
  float*wsf=(float*)(shm+LDS_WS)+wid*64;
  const lds_cptr shm3=(lds_cptr)shm;
  { const float*ncs=NCS+(size_t)(b*NHEAD+h)*SEQ+tstart*KVBLK; const int n4=(q0+QB-tstart*KVBLK)>>2;
    const float o1=QOFF[0],o2=o1+QOFF[1],o3=o2+QOFF[2];
    for(int i=tid;i<n4;i+=NW*64){ f32x4v v=*(const f32x4v*)(ncs+4*i); const int qn=(tstart*KVBLK+4*i)>>11; const float of=qn==0?0.f:(qn==1?o1:(qn==2?o2:o3)); v=v+of;
      *(__attribute__((address_space(3))) f32x4v*)((__attribute__((address_space(3))) char*)shm3+LDS_CS+16*i)=v; } }
  const bf16*ksrc=Kh+(long)lane*DM+wid*8;
  const bf16*vsrc=Vh+(long)(16*(wid&3)+(lane>>2))*DM+(wid>>2)*32+(lane&3)*8;
  const unsigned kdst=lds0+LDS_K+wid*1024, vdst=lds0+LDS_V+wid*1024;
  #define DMA_K(t,slot) glds16(ksrc+(long)(t)*KVBLK*DM,(unsigned)__builtin_amdgcn_readfirstlane(kdst+(slot)))
  #define DMA_V(t,slot) glds16(vsrc+(long)(t)*KVBLK*DM,(unsigned)__builtin_amdgcn_readfirstlane(vdst+(slot)))
  const int vb0=(int)(lds0+LDS_V)+((lane>>4)&1)*32+(lane&3)*8+(4*hi+((lane&15)>>2))*64;
  const char*Kbase=shm+LDS_K; bf16x8 kf[8];
  const lds_cptr kp0=shm3+LDS_K+hi*1024+r32*16; const lds_cptr vp0=shm3+LDS_V+((lane>>4)&1)*32+(lane&3)*8+(4*hi+((lane&15)>>2))*64;
  const lds_cptr csp0=shm3+LDS_CS+hi*16;
  const int NT=(q0+QB)/KVBLK-tstart;
  DMA_K(0,0);DMA_V(0,0);DMA_K(1,SLOTB);
  bf16x8 qr[4];
  #pragma unroll
  for(int d0=0;d0<4;++d0)qr[d0]=*reinterpret_cast<const bf16x8*>(&Qw[(long)r32*DM+d0*16+hi*8]);
  float mhat=0.f,l_reg=0.f,negm1=0.f;f32x16 o[2];o[0]=f32x16{};o[1]=f32x16{};
  const int qrel=wid*QBLK+r32;
  #define CMASK(P0,P1,t) do{int jb_=(t)-(NT-4); if(jb_>=0)cmask(P0,P1,jb_,qrel,hi);}while(0)
  bool resc=false;
  #define START(P0,P1) do{ const float rm=rowmax(P0,P1); resc=false; \
    { const float dl=rm; mhat=fadd_s(mhat,dl); \
      _Pragma("unroll") for(int r=0;r<16;++r){P0[r]=fsub_s(P0[r],dl);P1[r]=fsub_s(P1[r],dl);} \
      negm1=-mhat; } \
    _Pragma("unroll") for(int r=0;r<16;++r)P0[r]=__builtin_amdgcn_exp2f(P0[r]); }while(0)
  #define RESC() do{ if(resc){ asm volatile("s_waitcnt lgkmcnt(0)":::"memory"); \
      _Pragma("unroll") for(int d_=0;d_<2;++d_) _Pragma("unroll") for(int r=0;r<16;++r)o[d_][r]*=wsf[crow(r,hi)]; } }while(0)
  f32x16 pA0,pA1,pB0,pB1;
  int sl_prev=0,sl_cur=0,sl_next=SLOTB;
  #define ROT() do{sl_prev=sl_cur;sl_cur=sl_next;sl_next=(sl_next==(NSLOT-1)*SLOTB)?0:sl_next+SLOTB;}while(0)
  DMA_K(2,2*SLOTB);
  WAIT_BAR(3);
  ldbias(pA0,pA1,csp0,0.f);
  qkt(pA0,pA1,Kbase,qr,r32,hi);asm volatile("s_nop 15\n\ts_nop 7":"+v"(pA0),"+v"(pA1));CMASK(pA0,pA1,0);
  START(pA0,pA1);
  _Pragma("unroll") for(int r=0;r<16;++r)pA1[r]=__builtin_amdgcn_exp2f(pA1[r]);
  WAIT_BAR(0);
  DMA_K(3,0);DMA_V(1,SLOTB);
  ROT();
  kload8(kf,kp0+sl_cur);
  WAIT_BAR(2);
  s16x4 vlo[8],vhi[8]; u32x4 pw0,pw1,pw2,pw3;
  #define PKW(P,B) cvtpk_s(P[B],P[B+1])
  #define PAF(k) __builtin_bit_cast(bf16x8,pw##k)
  #define VFR(i) (bf16x8){vlo[i][0],vlo[i][1],vlo[i][2],vlo[i][3],vhi[i][0],vhi[i][1],vhi[i][2],vhi[i][3]}
  #define PIN(x) asm volatile("":"+v"(x))
  #define MX3(a,b,c) __builtin_fmaxf(__builtin_fmaxf((a),(b)),(c))
  #define GAPA(MF,A0,A1,A2,A3,W0,W1,PW) do{ MF; sacc+=A0; sacc+=A1; sacc+=A2; sacc+=A3; PIN(sacc); W0; W1; PIN(PW); SBAR(); }while(0)
  #define EX(v) __builtin_amdgcn_exp2f(v)
  #define GAPB(MF,X,B) do{ MF; X[B]=EX(X[B]); X[B+1]=EX(X[B+1]); X[B+2]=EX(X[B+2]); X[B+3]=EX(X[B+3]); PIN(X); SBAR(); }while(0)
  #define VRD(i) do{ vlo[i]=vtr(vp_+(((i)>>2)*4096+((i)&3)*1024)); vhi[i]=vtr(vp_+(((i)>>2)*4096+((i)&3)*1024+512)); }while(0)
  #define KRD(G,j) do{ if(G){ kload2(kf,kp0+sl_next,j); SBAR(); } }while(0)
  #define STEP(C0,C1,P0,P1,t,GK,GV,GL) do{ SBAR(); \
    const lds_cptr vp_=vp0+sl_prev; \
    ldbias(C0,C1,csp0+(t)*256,negm1); PIN(C0); PIN(C1); SBAR(); \
    VRD(0); SBAR(); float sacc=(P0[0]+P0[1]); \
    GAPA(C0=__builtin_amdgcn_mfma_f32_32x32x16_bf16(kf[0],qr[0],C0,0,0,0), P0[2],P0[3],P0[4],P0[5],     pw0[0]=PKW(P0,0), pw0[1]=PKW(P0,2), pw0); \
    VRD(4); SBAR(); GAPA(C1=__builtin_amdgcn_mfma_f32_32x32x16_bf16(kf[1],qr[0],C1,0,0,0), P0[6],P0[7],P0[8],P0[9],     pw0[2]=PKW(P0,4), pw0[3]=PKW(P0,6), pw0); \
    VRD(1); SBAR(); GAPA(C0=__builtin_amdgcn_mfma_f32_32x32x16_bf16(kf[2],qr[1],C0,0,0,0),   P0[10],P0[11],P0[12],P0[13], pw1[0]=PKW(P0,8), pw1[1]=PKW(P0,10), pw1); \
    VRD(5); SBAR(); GAPA(C1=__builtin_amdgcn_mfma_f32_32x32x16_bf16(kf[3],qr[1],C1,0,0,0),   P0[14],P0[15],P1[0],P1[1],   pw1[2]=PKW(P0,12),pw1[3]=PKW(P0,14), pw1); \
    VRD(2); SBAR(); GAPA(C0=__builtin_amdgcn_mfma_f32_32x32x16_bf16(kf[4],qr[2],C0,0,0,0),   P1[2],P1[3],P1[4],P1[5],     pw2[0]=PKW(P1,0), pw2[1]=PKW(P1,2), pw2); \
    VRD(6); SBAR(); GAPA(C1=__builtin_amdgcn_mfma_f32_32x32x16_bf16(kf[5],qr[2],C1,0,0,0),   P1[6],P1[7],P1[8],P1[9],     pw2[2]=PKW(P1,4), pw2[3]=PKW(P1,6), pw2); \
    VRD(3); SBAR(); GAPA(C0=__builtin_amdgcn_mfma_f32_32x32x16_bf16(kf[6],qr[3],C0,0,0,0),   P1[10],P1[11],P1[12],P1[13], pw3[0]=PKW(P1,8), pw3[1]=PKW(P1,10), pw3); \
    VRD(7); SBAR(); GAPA(C1=__builtin_amdgcn_mfma_f32_32x32x16_bf16(kf[7],qr[3],C1,0,0,0),   P1[14],P1[15],0.f,0.f,       pw3[2]=PKW(P1,12),pw3[3]=PKW(P1,14), pw3); \
    l_reg+=sacc; \
    if(GK){DMA_K((t)+3,sl_cur);} if(GV){DMA_V((t)+1,sl_next);} \
    CMASK(C0,C1,t); \
    { float a=MX3(C0[0],C0[1],C1[0]),b=MX3(C0[2],C0[3],C1[1]); a=MX3(a,C1[2],C1[3]); \
      _Pragma("unroll") for(int r=4;r<16;r+=4){a=MX3(a,C0[r],C0[r+1]);b=MX3(b,C0[r+2],C0[r+3]);a=MX3(a,C1[r],C1[r+1]);b=MX3(b,C1[r+2],C1[r+3]);} \
      float rm=__builtin_fmaxf(a,b); { auto rr=__builtin_amdgcn_permlane32_swap(__float_as_uint(rm),__float_as_uint(rm),false,false); rm=__builtin_fmaxf(__uint_as_float(rr[0]),__uint_as_float(rr[1])); } \
      resc=false; \
      if(__builtin_expect(__any(rm>(float)THRL),0)){ const float dl=__builtin_fmaxf(rm,0.f); mhat+=dl; \
        _Pragma("unroll") for(int r=0;r<16;++r){C0[r]-=dl;C1[r]-=dl;} \
        negm1=-mhat; \
        const float f=__builtin_amdgcn_exp2f(-dl); l_reg*=f; if(hi==0)wsf[r32]=f; resc=true; } } \
    SBAR(); \
    GAPB(o[0]=__builtin_amdgcn_mfma_f32_32x32x16_bf16(PAF(0),VFR(0),o[0],0,0,0), C0,0); \
    GAPB(o[1]=__builtin_amdgcn_mfma_f32_32x32x16_bf16(PAF(0),VFR(4),o[1],0,0,0), C0,4); \
    KRD(GL,0); GAPB(o[0]=__builtin_amdgcn_mfma_f32_32x32x16_bf16(PAF(1),VFR(1),o[0],0,0,0), C0,8); \
    KRD(GL,1); GAPB(o[1]=__builtin_amdgcn_mfma_f32_32x32x16_bf16(PAF(1),VFR(5),o[1],0,0,0), C0,12); \
    KRD(GL,2); GAPB(o[0]=__builtin_amdgcn_mfma_f32_32x32x16_bf16(PAF(2),VFR(2),o[0],0,0,0), C1,0); \
    KRD(GL,3); GAPB(o[1]=__builtin_amdgcn_mfma_f32_32x32x16_bf16(PAF(2),VFR(6),o[1],0,0,0), C1,4); \
    GAPB(o[0]=__builtin_amdgcn_mfma_f32_32x32x16_bf16(PAF(3),VFR(3),o[0],0,0,0), C1,8); \
    GAPB(o[1]=__builtin_amdgcn_mfma_f32_32x32x16_bf16(PAF(3),VFR(7),o[1],0,0,0), C1,12); \
    }while(0)
  int t=1;
  #undef CMASK
  #define CMASK(P0,P1,t) do{}while(0)
  for(;t+5<NT;t+=2){
    STEP(pB0,pB1,pA0,pA1,t,true,true,true);     WAIT_BAR(2); RESC(); ROT();
    STEP(pA0,pA1,pB0,pB1,t+1,true,true,true);   WAIT_BAR(2); RESC(); ROT();
  }
  #undef CMASK
  #define CMASK(P0,P1,t) do{int jb_=(t)-(NT-4); if(jb_>=0)cmask(P0,P1,jb_,qrel,hi);}while(0)
  #define ENDW(tt) do{ if((tt)+3<NT){WAIT_BAR(2);} else if((tt)+2<NT){WAIT_BAR(1);} else {WAIT_BAR(0);} }while(0)
  const int wq_=wid>>1;
  #define AQ(tt) (((tt)-(NT-4))<=wq_)
  #define DRAINP(P0,P1,VB) do{ float sacc=P0[0]+P0[1]; _Pragma("unroll") for(int r=2;r<16;++r)sacc+=P0[r]; _Pragma("unroll") for(int r=0;r<16;++r)sacc+=P1[r]; l_reg+=sacc; \
    pw0=(u32x4){PKW(P0,0),PKW(P0,2),PKW(P0,4),PKW(P0,6)};pw1=(u32x4){PKW(P0,8),PKW(P0,10),PKW(P0,12),PKW(P0,14)};pw2=(u32x4){PKW(P1,0),PKW(P1,2),PKW(P1,4),PKW(P1,6)};pw3=(u32x4){PKW(P1,8),PKW(P1,10),PKW(P1,12),PKW(P1,14)}; \
    SBAR(); pv(o,(VB),PAF(0),PAF(1),PAF(2),PAF(3)); }while(0)
  #define TAILSTEP(P0,P1,t,GK,GV) do{ SBAR(); if(GK){DMA_K((t)+3,sl_cur);} if(GV){DMA_V((t)+1,sl_next);} resc=false; if(AQ((t)-1)){ DRAINP(P0,P1,vb0+sl_prev); } SBAR(); }while(0)
  for(;t+1<NT;t+=2){
    STEP(pB0,pB1,pA0,pA1,t,(t+3<NT),(t+1<NT),(t+1<NT));       ENDW(t);   RESC(); ROT();
    STEP(pA0,pA1,pB0,pB1,t+1,(t+4<NT),(t+2<NT),(t+2<NT));     ENDW(t+1); RESC(); ROT();
  }
  if(AQ(NT-1)){ STEP(pB0,pB1,pA0,pA1,NT-1,false,false,false); RESC(); DRAINP(pB0,pB1,vb0+sl_cur); }
  else { TAILSTEP(pA0,pA1,NT-1,false,false); }
  #undef AQ
  #undef DRAINP
  #undef TAILSTEP
  #undef PKW
  #undef PAF
  #undef VFR
  #undef PIN
  #undef MX3
  #undef GAPA
  #undef GAPB
  #undef EX
  #undef VRD
  #undef KRD
  #undef STEP
  #undef ENDW
  {auto rr=__builtin_amdgcn_permlane32_swap(__float_as_uint(l_reg),__float_as_uint(l_reg),false,false);l_reg=__uint_as_float(rr[0])+__uint_as_float(rr[1]);}
  if(hi==0)wsf[32+r32]=l_reg;asm volatile("s_waitcnt lgkmcnt(0)":::"memory");
  float rli[16];
  #pragma unroll
  for(int r=0;r<16;++r)rli[r]=__builtin_amdgcn_rcpf(wsf[32+crow(r,hi)]);
  bf16*Ow=O+(rowbase+q0+wid*QBLK)*DM+h*D;
  { bf16*stg=(bf16*)(shm+LDS_OST)+wid*2048;
    #pragma unroll
    for(int r=0;r<16;++r){const int orow=crow(r,hi);
      #pragma unroll
      for(int d0=0;d0<2;++d0)stg[orow*64+d0*32+r32]=__float2bfloat16(o[d0][r]*rli[r]);}
    asm volatile("s_waitcnt lgkmcnt(0)":::"memory");
    #pragma unroll
    for(int i=0;i<4;++i){const int row=i*8+(lane>>3),ch=lane&7; const u32x4 v=*(const u32x4*)(stg+row*64+ch*8); ATTN_STORE16(Ow+(long)row*DM+ch*8,v);} }
  asm volatile("s_waitcnt lgkmcnt(0)\n\ts_barrier":::"memory");
  #undef DMA_K
  #undef DMA_V
  #undef CMASK
  #undef START
  #undef RESC
  #undef ROT
}
constexpr int ATTN_LDS_BYTES=LDS_BYTES;
#undef SBAR
#undef WAIT_BAR
}

constexpr int NWAVES = 8;
constexpr int BATCH = 4, SEQ = 8192, D = 1024, NH = 16, HD = 64, FF0 = 2816, FFE = 3584, NE = 8;
constexpr int T = BATCH * SEQ;
constexpr int NWIN = 3 * D + NH;
constexpr float RMS_EPS = 1e-6f;
constexpr int MAXRT = 264, MAXROWS = MAXRT * 256;
constexpr int CHUNK_RT = 128;
constexpr int MAXCHUNK = 2;
constexpr float WGU_PRESCALE = 32.f, WD_PRESCALE = 64.f;
constexpr int PH_PRO = 0, PH_MIX0 = 1, PH_GU0 = 2, PH_DN0 = 3, PH_THB = 4, PH_QKV = 5, PH_ATT = 6, PH_WO = 7, PH_THC = 8, PH_PERM = 9, PH_MOE = 10, PH_FIN = PH_MOE + 2 * MAXCHUNK, N_PH = PH_FIN + 1;
static_assert(N_PH == 15, "phase count");

constexpr size_t MiB = 1u << 20;
constexpr size_t WS_CTL = 0, CTL_ZERO_BYTES = 1 * MiB;
constexpr size_t WS_WPOOL = 1 * MiB;
constexpr size_t WS_WFT = WS_WPOOL + 512 * 1024;
constexpr size_t WS_WRT = WS_WFT + 64 * 1024;
constexpr size_t WS_RTPOS = 2 * MiB;
constexpr size_t WS_RTG = WS_RTPOS + 256 * 1024;
constexpr size_t WS_LOGF = 3 * MiB;
constexpr size_t WS_NCS = 5 * MiB;
constexpr size_t WS_QTOT = 7 * MiB;
constexpr size_t WS_NRM = 7 * MiB + 4096;
constexpr size_t WS_KBAR = 7 * MiB + 128 * 1024;
constexpr size_t WS_WIN = 8 * MiB;
constexpr size_t WS_WOUT = 14 * MiB;
constexpr size_t WS_WGU0 = 16 * MiB;
constexpr size_t WS_WD0 = 27 * MiB;
constexpr size_t WS_WGU = 34 * MiB;
constexpr size_t WS_WD = 90 * MiB;
constexpr size_t WS_H = 118 * MiB;
constexpr size_t WS_R = 182 * MiB;
constexpr size_t WS_YB = WS_R, WS_ACT0 = WS_R + 64 * MiB;
constexpr size_t WS_Q = WS_R, WS_K = WS_R + 64 * MiB, WS_V = WS_R + 128 * MiB, WS_YATT = WS_K;
constexpr size_t WS_RIDX = WS_R;
constexpr size_t WS_HS = WS_R;
constexpr size_t WS_YS = WS_R + 66 * MiB;
constexpr size_t WS_ACTC = WS_YS + 66 * MiB;
constexpr size_t WS_XR = WS_R + 254 * MiB;
constexpr size_t WS_END = WS_XR + 64 * MiB;
static_assert(WS_WD0 + (size_t)D * FF0 * 2 <= WS_WGU && WS_WGU + (size_t)NE * 2 * FFE * D <= WS_WD && WS_WD + (size_t)NE * D * FFE <= WS_H && WS_ACT0 + (size_t)T * FF0 * 2 <= WS_XR &&
              WS_HS + (size_t)MAXROWS * D <= WS_YS && WS_YS + (size_t)MAXROWS * D <= WS_ACTC && WS_ACTC + (size_t)(MAXRT - CHUNK_RT) * 256 * FFE <= WS_XR && WS_END <= 512 * MiB, "ws map");
constexpr int CW_TMO = 0, CW_CODE = 1, CW_BAR = 4096, CW_CNT = 16384, CW_AQ = 20480, CW_MAXQ = 24576, CW_MAXK = 24576 + 64, CW_PRO = 28672;

constexpr int RING_OFF = 0, RING_BYTES = 131072;
constexpr int LDSCTL_OFF = RING_BYTES, MISC_OFF = LDSCTL_OFF + 320;
constexpr int LDS_BYTES = 147456;
static_assert(MISC_OFF + 128 <= LDS_BYTES && attn_body::ATTN_LDS_BYTES <= RING_BYTES, "LDS map");

#define GAS __attribute__((address_space(1)))
#define LAS __attribute__((address_space(3)))
typedef unsigned short bf16;
typedef unsigned v4u __attribute__((ext_vector_type(4)));
typedef unsigned v2u __attribute__((ext_vector_type(2)));
typedef float f32x4 __attribute__((ext_vector_type(4)));
typedef float f32x2 __attribute__((ext_vector_type(2)));
typedef GAS unsigned gu32;
#define RLX_AGENT __ATOMIC_RELAXED, __HIP_MEMORY_SCOPE_AGENT
#define LDS_WAIT() asm volatile("s_waitcnt lgkmcnt(0)" ::: "memory")
#define VM_WAIT() asm volatile("s_waitcnt vmcnt(0)" ::: "memory")
__device__ __forceinline__ unsigned f2bf(float f) { unsigned u = __builtin_bit_cast(unsigned, f); return (u + 0x7fffu + ((u >> 16) & 1u)) >> 16; }
typedef float f32x2c_t __attribute__((ext_vector_type(2))); typedef __bf16 bf16x2c_t __attribute__((ext_vector_type(2)));
__device__ __forceinline__ unsigned pk2(float lo, float hi) { const f32x2c_t v = {lo, hi}; const bf16x2c_t b = __builtin_convertvector(v, bf16x2c_t); return __builtin_bit_cast(unsigned, b); }
typedef __bf16 bf16x2d_t __attribute__((ext_vector_type(2)));
__device__ __forceinline__ float dot2bf(unsigned a, unsigned b, float c) { return __builtin_amdgcn_fdot2_f32_bf16(__builtin_bit_cast(bf16x2d_t, a), __builtin_bit_cast(bf16x2d_t, b), c, false); }
__device__ __forceinline__ float bf_lo(unsigned w) { return __builtin_bit_cast(float, w << 16); }
__device__ __forceinline__ float bf_hi(unsigned w) { return __builtin_bit_cast(float, w & 0xffff0000u); }

#define XB_TMO      128
#define XB_XCNT(j)  (256  + 64 * (j))
#define XB_XSUB(j)  (1280 + 64 * (j))
#define XB_XGEN(j)  (2304 + 64 * (j))
#define XB_TOP      3328
#define XB_TOPGEN   3392
#define XCD_BAR_WORDS 3456
#define XB_SPIN_CAP (1u << 18)
__device__ __forceinline__ unsigned xb_ld(unsigned* p)              { return __hip_atomic_load(p, __ATOMIC_RELAXED, __HIP_MEMORY_SCOPE_AGENT); }
__device__ __forceinline__ unsigned xb_add(unsigned* p, unsigned v) { return __hip_atomic_fetch_add(p, v, __ATOMIC_RELAXED, __HIP_MEMORY_SCOPE_AGENT); }
__device__ __forceinline__ unsigned xb_xcc_id() { return (unsigned)__builtin_amdgcn_s_getreg((3 << 11) | 20) & 0xFu; }
#define XB_SPIN(cond, bar) do { unsigned _sp = 0; while (cond) { __builtin_amdgcn_s_sleep(1); \
    if ((++_sp & 255u) == 0u) { if (xb_ld(&(bar)[XB_TMO])) break; if (_sp > XB_SPIN_CAP) { atomicAdd(&(bar)[XB_TMO], 1u); break; } } } } while (0)
struct XcdBarrier { unsigned* bar; unsigned x; volatile LAS unsigned* st; };
__device__ __forceinline__ XcdBarrier xcd_barrier_post(unsigned* bar, volatile LAS unsigned* st) {
    XcdBarrier b; b.bar = bar; b.x = xb_xcc_id(); b.st = st;
    if (threadIdx.x == 0) (void)xb_add(&bar[XB_XCNT(b.x)], 1u);
    return b;
}
__device__ __forceinline__ void xcd_barrier_complete(unsigned* bar, unsigned x, unsigned& nloc, unsigned& nx) {
    const unsigned G = gridDim.x * gridDim.y * gridDim.z;
    unsigned sum, cnt, mine, sp = 0u;
    for (;;) {
        sum = 0u; cnt = 0u; mine = 0u;
#pragma unroll
        for (unsigned j = 0; j < 16; ++j) { const unsigned c = xb_ld(&bar[XB_XCNT(j)]); sum += c; cnt += (c > 0u) ? 1u : 0u; mine = (j == x) ? c : mine; }
        if (sum == G) break;
        __builtin_amdgcn_s_sleep(1);
        if ((++sp & 255u) == 0u) { if (xb_ld(&bar[XB_TMO])) break; if (sp > XB_SPIN_CAP) { atomicAdd(&bar[XB_TMO], 1u); break; } }
    }
    nloc = mine > 0u ? mine : 1u; nx = cnt > 0u ? cnt : 1u;
}
__device__ __forceinline__ void xcd_barrier(const XcdBarrier& b) {
    asm volatile("s_waitcnt vmcnt(0)" ::: "memory");
    __syncthreads();
    if (threadIdx.x == 0) {
        unsigned* bar = b.bar;
        __builtin_amdgcn_s_waitcnt(0);
        unsigned nloc = b.st[0], nx = b.st[1];
        if (nloc == 0u) { xcd_barrier_complete(bar, b.x, nloc, nx); b.st[0] = nloc; b.st[1] = nx; }
        const unsigned old = xb_add(&bar[XB_XSUB(b.x)], 1u);
        const unsigned gen = old / nloc;
        if (old + 1u == (gen + 1u) * nloc) {
            __builtin_amdgcn_fence(__ATOMIC_RELEASE, "agent");
            asm volatile("s_waitcnt vmcnt(0)" ::: "memory");
            const unsigned og = xb_add(&bar[XB_TOP], 1u);
            const unsigned tg = og / nx;
            if (og + 1u == (tg + 1u) * nx) xb_add(&bar[XB_TOPGEN], 1u);
            else XB_SPIN(xb_ld(&bar[XB_TOPGEN]) == tg, bar);
            __builtin_amdgcn_fence(__ATOMIC_ACQUIRE, "agent");
            xb_add(&bar[XB_XGEN(b.x)], 1u);
            asm volatile("s_waitcnt vmcnt(0)" ::: "memory");
        } else {
            XB_SPIN(xb_ld(&bar[XB_XGEN(b.x)]) == gen, bar);
            __builtin_amdgcn_fence(__ATOMIC_ACQUIRE, "agent");
            asm volatile("s_waitcnt vmcnt(0)" ::: "memory");
        }
    }
    __syncthreads();
}

struct Frame {
    LAS unsigned char* lds;
    volatile LAS unsigned* MISC;
    gu32* ctl;
    int tid, lane, wave;
    int vcu, G;
    unsigned char* ws;
};
__device__ __forceinline__ float wave_sum(float v) {
#pragma unroll
    for (int o = 1; o < 64; o <<= 1) v += __shfl_xor(v, o);
    return v;
}
__device__ __forceinline__ void load_row_f32(const float* p, int lane, f32x4 (&v)[4]) {
#pragma unroll
    for (int j = 0; j < 4; ++j) v[j] = ((const f32x4*)p)[64 * j + lane];
}
__device__ __forceinline__ void store_row_f32(float* p, int lane, const f32x4 (&v)[4]) {
#pragma unroll
    for (int j = 0; j < 4; ++j) ((f32x4*)p)[64 * j + lane] = v[j];
}
__device__ __forceinline__ void load_row_bf16(const bf16* p, int lane, f32x4 (&v)[4]) {
#pragma unroll
    for (int j = 0; j < 4; ++j) { const v2u w = ((const v2u*)p)[64 * j + lane]; v[j] = (f32x4){bf_lo(w.x), bf_hi(w.x), bf_lo(w.y), bf_hi(w.y)}; }
}
__device__ __forceinline__ void load_row_bf16_nt(const bf16* p, int lane, f32x4 (&v)[4]) {
#pragma unroll
    for (int j = 0; j < 4; ++j) { const v2u w = __builtin_nontemporal_load((const v2u*)p + 64 * j + lane); v[j] = (f32x4){bf_lo(w.x), bf_hi(w.x), bf_lo(w.y), bf_hi(w.y)}; }
}
__device__ __forceinline__ void store_row_bf16(bf16* p, int lane, const f32x4 (&v)[4]) {
#pragma unroll
    for (int j = 0; j < 4; ++j) { v2u w; w.x = pk2(v[j].x, v[j].y); w.y = pk2(v[j].z, v[j].w); ((v2u*)p)[64 * j + lane] = w; }
}
__device__ __forceinline__ float row_rstd(const f32x4 (&v)[4]) {
    float s = 0.f;
#pragma unroll
    for (int j = 0; j < 4; ++j) s += (v[j].x * v[j].x + v[j].y * v[j].y) + (v[j].z * v[j].z + v[j].w * v[j].w);
    s = wave_sum(s);
    return 1.0f / sqrtf(s * (1.0f / D) + RMS_EPS);
}

__device__ __forceinline__ void p0_transpose_item(const float* W, int ldw, int k0, int n0, bf16* dst, int dK, int drow0, LAS unsigned* scr, int lane) {
    const int nq = lane & 15, kr = lane >> 4;
#pragma unroll 4
    for (int it = 0; it < 8; ++it) { const int kp = it * 4 + kr;
        const f32x4 a = __builtin_nontemporal_load((const f32x4*)(W + (size_t)(k0 + 2 * kp) * ldw + n0 + 4 * nq)), b = __builtin_nontemporal_load((const f32x4*)(W + (size_t)(k0 + 2 * kp + 1) * ldw + n0 + 4 * nq));
        scr[(4 * nq + 0) * 33 + kp] = pk2(a.x, b.x); scr[(4 * nq + 1) * 33 + kp] = pk2(a.y, b.y); scr[(4 * nq + 2) * 33 + kp] = pk2(a.z, b.z); scr[(4 * nq + 3) * 33 + kp] = pk2(a.w, b.w); }
    LDS_WAIT(); asm volatile("" ::: "memory");
    const int c = lane & 7;
#pragma unroll
    for (int ps = 0; ps < 8; ++ps) { const int n = (lane >> 3) + 8 * ps; const LAS unsigned* s = scr + n * 33 + 4 * c;
        v4u o; o.x = s[0]; o.y = s[1]; o.z = s[2]; o.w = s[3];
        *(v4u*)(dst + (size_t)(drow0 + n) * dK + k0 + 8 * c) = o; }
    LDS_WAIT(); asm volatile("" ::: "memory");
}
__device__ __forceinline__ void p0_transpose_item8(const float* W, int ldw, int k0, int n0, unsigned char* dst, int dK, int drow0, float scale, LAS unsigned* scr, int lane) {
    const int nq = lane & 15, kr = lane >> 4;
#pragma unroll 4
    for (int it = 0; it < 8; ++it) { const int k4 = it * 4 + kr; const float* p = W + (size_t)(k0 + 4 * k4) * ldw + n0 + 4 * nq;
        const f32x4 a = __builtin_nontemporal_load((const f32x4*)p) * scale, b = __builtin_nontemporal_load((const f32x4*)(p + ldw)) * scale, c = __builtin_nontemporal_load((const f32x4*)(p + 2 * (size_t)ldw)) * scale, d = __builtin_nontemporal_load((const f32x4*)(p + 3 * (size_t)ldw)) * scale;
        scr[(4 * nq + 0) * 33 + k4] = pg8::pk4_fp8(a.x, b.x, c.x, d.x); scr[(4 * nq + 1) * 33 + k4] = pg8::pk4_fp8(a.y, b.y, c.y, d.y);
        scr[(4 * nq + 2) * 33 + k4] = pg8::pk4_fp8(a.z, b.z, c.z, d.z); scr[(4 * nq + 3) * 33 + k4] = pg8::pk4_fp8(a.w, b.w, c.w, d.w); }
    LDS_WAIT(); asm volatile("" ::: "memory");
    const int c = lane & 7;
#pragma unroll
    for (int ps = 0; ps < 8; ++ps) { const int n = (lane >> 3) + 8 * ps; const LAS unsigned* s = scr + n * 33 + 4 * c;
        v4u o; o.x = s[0]; o.y = s[1]; o.z = s[2]; o.w = s[3];
        *(v4u*)(dst + (size_t)(drow0 + n) * dK + k0 + 16 * c) = o; }
    LDS_WAIT(); asm volatile("" ::: "memory");
}
struct In { const float *x, *norm_g, *pool_w, *pool_scale, *w_in, *b_f, *w_out, *w_gate, *w_up, *w_down, *w_router, *mw_gate, *mw_up, *mw_down; };

__device__ __forceinline__ void moe_conv_share(Frame& F, const In& I) {
    LAS unsigned* scr = (LAS unsigned*)(F.lds + RING_OFF + F.wave * 16384);
    unsigned char* const wgu = F.ws + WS_WGU; unsigned char* const wd = F.ws + WS_WD;
    const int gw = F.vcu * NWAVES + F.wave, NGW = F.G * NWAVES;
#pragma unroll 1
    for (int it = gw; it < NE * 1344; it += NGW) {
        int r = it; const int e = r / 1344; r -= e * 1344;
        if (r < 896) { const int up = r >= 448; if (up) r -= 448; const int kb = r / 56, nb = r % 56, n0 = 64 * nb;
            p0_transpose_item8((up ? I.mw_up : I.mw_gate) + (size_t)e * D * FFE, FFE, 128 * kb, n0, wgu + (size_t)e * 2 * FFE * D, D, ((n0 >> 7) << 8) + (n0 & 127) + (up ? 128 : 0), WGU_PRESCALE, scr, F.lane); }
        else { r -= 896; const int kb = r / 16, nb = r % 16; p0_transpose_item8(I.mw_down + (size_t)e * FFE * D, D, 128 * kb, 64 * nb, wd + (size_t)e * D * FFE, FFE, 64 * nb, WD_PRESCALE, scr, F.lane); }
    }
}
template <int PART>
__device__ __forceinline__ void p0_prologue(Frame& F, const In& I) {
    LAS unsigned* scr = (LAS unsigned*)(F.lds + RING_OFF + F.wave * 16384);
    const int gw = F.vcu * NWAVES + F.wave, NGW = F.G * NWAVES;
    constexpr int I_POOL = 4 * 4 * 4, I_WIN = 16 * 48, I_WOUT = 16 * 16, I_G0 = MK_FFN0_FP8 ? 8 * 44 : 16 * 44, I_D0 = MK_FFN0_DNF8 ? 22 * 16 : 44 * 16, I_GE = 8 * 56, I_DE = 28 * 16;
    constexpr int NITEMS = I_POOL + I_WIN + I_WOUT + 2 * I_G0 + I_D0;
    bf16* const wpool = (bf16*)(F.ws + WS_WPOOL); bf16* const win = (bf16*)(F.ws + WS_WIN); bf16* const wout = (bf16*)(F.ws + WS_WOUT);
    bf16* const wgu0 = (bf16*)(F.ws + WS_WGU0); bf16* const wd0 = (bf16*)(F.ws + WS_WD0);
    for (int it = (PART == 0 ? NITEMS : I_POOL) + gw; it < NITEMS; it += NGW) {
        int r = it;
        if (r < I_POOL) { const int g = r >> 4, q = r & 15, kb = q >> 2, nb = q & 3; p0_transpose_item(I.pool_w + (size_t)g * 65536, 256, 64 * kb, 64 * nb, wpool + (size_t)g * 65536, 256, 64 * nb, scr, F.lane); continue; } r -= I_POOL;
        if (r < I_WIN) { const int kb = r / 48, nb = r % 48; p0_transpose_item(I.w_in, NWIN, 64 * kb, 64 * nb, win, D, 64 * nb, scr, F.lane); continue; } r -= I_WIN;
        if (r < I_WOUT) { const int kb = r / 16, nb = r % 16; p0_transpose_item(I.w_out, D, 64 * kb, 64 * nb, wout, D, 64 * nb, scr, F.lane); continue; } r -= I_WOUT;
        if (r < 2 * I_G0) { const int up = r >= I_G0; if (up) r -= I_G0; const int kb = r / 44, nb = r % 44, n0 = 64 * nb;
            if (MK_FFN0_FP8) p0_transpose_item8(up ? I.w_up : I.w_gate, FF0, 128 * kb, n0, (unsigned char*)wgu0, D, ((n0 >> 7) << 8) + (n0 & 127) + (up ? 128 : 0), WGU_PRESCALE, scr, F.lane);
            else p0_transpose_item(up ? I.w_up : I.w_gate, FF0, 64 * kb, n0, wgu0, D, ((n0 >> 7) << 8) + (n0 & 127) + (up ? 128 : 0), scr, F.lane); continue; } r -= 2 * I_G0;
        if (r < I_D0) { const int kb = r / 16, nb = r % 16;
            if (MK_FFN0_DNF8) p0_transpose_item8(I.w_down, D, 128 * kb, 64 * nb, (unsigned char*)wd0, FF0, 64 * nb, WD_PRESCALE, scr, F.lane);
            else p0_transpose_item(I.w_down, D, 64 * kb, 64 * nb, wd0, FF0, 64 * nb, scr, F.lane); continue; } r -= I_D0;
        (void)I_GE; (void)I_DE;
    }
    if (PART == 0) { const int gt = F.vcu * (NWAVES * 64) + F.tid, NGT = F.G * NWAVES * 64;
      for (int f = gt; f < 4 * 2 * 8 * 8 * 64; f += NGT) { const int ln = f & 63, nb = (f >> 6) & 7, ks = (f >> 9) & 7, half = (f >> 12) & 1, g = f >> 13, c16 = ln & 15, kq = ln >> 4;
          const float* src = I.pool_w + (size_t)g * 65536 + (size_t)(32 * ks + 8 * kq) * 256 + 128 * half + 16 * nb + c16;
          v4u w; w.x = pk2(src[0], src[256]); w.y = pk2(src[512], src[768]); w.z = pk2(src[1024], src[1280]); w.w = pk2(src[1536], src[1792]);
          ((v4u*)wpool)[f] = w; } }
    if (PART == 0) { float* wft = (float*)(F.ws + WS_WFT); float* wrt = (float*)(F.ws + WS_WRT); const int gt = F.vcu * (NWAVES * 64) + F.tid, NGT = F.G * NWAVES * 64;
      for (int i = gt; i < 16 * D; i += NGT) { const int j = i / D, c = i % D; ((bf16*)wft)[i] = (bf16)f2bf(I.w_in[(size_t)c * NWIN + 3 * D + j]); }
      for (int i = gt; i < NE * D; i += NGT) { const int e = i / D, c = i % D; wrt[i] = I.w_router[(size_t)c * NE + e]; } }
}

__device__ __forceinline__ void row_rstd2(const f32x4 (&a)[4], const f32x4 (&b)[4], float& ra, float& rb) {
    float s = 0.f, t = 0.f;
#pragma unroll
    for (int j = 0; j < 4; ++j) { s += (a[j].x * a[j].x + a[j].y * a[j].y) + (a[j].z * a[j].z + a[j].w * a[j].w); t += (b[j].x * b[j].x + b[j].y * b[j].y) + (b[j].z * b[j].z + b[j].w * b[j].w); }
#pragma unroll
    for (int o = 1; o < 64; o <<= 1) { s += __shfl_xor(s, o); t += __shfl_xor(t, o); }
    ra = 1.0f / sqrtf(s * (1.0f / D) + RMS_EPS); rb = 1.0f / sqrtf(t * (1.0f / D) + RMS_EPS);
}
template <int H, int BIT, int N>
__device__ __forceinline__ void halve_step(float (&v)[N], int lane) {
    const bool up = (lane & BIT) != 0;
#pragma unroll
    for (int i = 0; i < H; ++i) { const float send = up ? v[i] : v[i + H], keep = up ? v[i + H] : v[i]; v[i] = keep + __shfl_xor(send, BIT); }
}
__device__ __forceinline__ float halve_reduce16(float (&v)[16], int lane) {
    halve_step<8, 32>(v, lane); halve_step<4, 16>(v, lane); halve_step<2, 8>(v, lane); halve_step<1, 4>(v, lane);
    float r = v[0]; r += __shfl_xor(r, 2); r += __shfl_xor(r, 1); return r;
}
__device__ __forceinline__ float halve_reduce8(float (&v)[8], int lane) {
    halve_step<4, 32>(v, lane); halve_step<2, 16>(v, lane); halve_step<1, 8>(v, lane);
    float r = v[0]; r += __shfl_xor(r, 4); r += __shfl_xor(r, 2); r += __shfl_xor(r, 1); return r;
}
template <int MODE>
__device__ __forceinline__ void thin_phase(Frame& F, const In& I, const bf16* Y, bf16* xr, const float* gpost_p, const float* gpre_p) {
    bf16* const Hb = (bf16*)(F.ws + WS_H);
    LAS float* wl = (LAS float*)(F.lds + RING_OFF);
    LAS unsigned* rte = (LAS unsigned*)(F.lds + RING_OFF + 65536);
    LAS float* rtg = (LAS float*)(F.lds + RING_OFF + 65536 + 512);
    LAS unsigned* wtot = (LAS unsigned*)(F.lds + RING_OFF + 65536 + 2048);
    if (MODE == 1) { const f32x4* src = (const f32x4*)(F.ws + WS_WFT); for (int i = F.tid; i < 16 * D / 8; i += NWAVES * 64) ((LAS f32x4*)wl)[i] = src[i]; }
    if (MODE == 2) { const f32x4* src = (const f32x4*)(F.ws + WS_WRT); for (int i = F.tid; i < NE * D / 4; i += NWAVES * 64) ((LAS f32x4*)wl)[i] = src[i]; }
    f32x4 gpost[4], gpre[4];
    load_row_f32(gpost_p, F.lane, gpost); load_row_f32(gpre_p, F.lane, gpre);
    float bfq = 0.f; if (MODE == 1) bfq = I.b_f[(F.lane >> 2) & 15];
    __syncthreads();
    for (int tile = F.vcu; tile < T / 128; tile += F.G) {
        const int mb = tile * 128 + F.wave * 16;
        v2u pY0A[4], pX0A[4], pY0B[4], pX0B[4], pY1A[4], pX1A[4], pY1B[4], pX1B[4];
#define TP_ISSUE(S, mrow) do { _Pragma("unroll") for (int j = 0; j < 4; ++j) { \
            pY##S##A[j] = __builtin_nontemporal_load((const v2u*)(Y + (size_t)(mrow) * D) + 64 * j + F.lane); pX##S##A[j] = ((const v2u*)(xr + (size_t)(mrow) * D))[64 * j + F.lane]; \
            pY##S##B[j] = __builtin_nontemporal_load((const v2u*)(Y + (size_t)((mrow) + 1) * D) + 64 * j + F.lane); pX##S##B[j] = ((const v2u*)(xr + (size_t)((mrow) + 1) * D))[64 * j + F.lane]; } } while (0)
#define TP_UNPK(w) ((f32x4){bf_lo((w).x), bf_hi((w).x), bf_lo((w).y), bf_hi((w).y)})
#define TP_PIN(w) asm volatile("" : "+v"((w).x), "+v"((w).y) :: "memory")
#define TP_UNPACK(S) do { _Pragma("unroll") for (int j = 0; j < 4; ++j) { TP_PIN(pY##S##A[j]); TP_PIN(pX##S##A[j]); TP_PIN(pY##S##B[j]); TP_PIN(pX##S##B[j]); } \
        _Pragma("unroll") for (int j = 0; j < 4; ++j) { yA[j] = TP_UNPK(pY##S##A[j]); xA[j] = TP_UNPK(pX##S##A[j]); yB[j] = TP_UNPK(pY##S##B[j]); xB[j] = TP_UNPK(pX##S##B[j]); } } while (0)
        auto body = [&](f32x4 (&yA)[4], f32x4 (&xA)[4], f32x4 (&yB)[4], f32x4 (&xB)[4], const int m, const int tl) __attribute__((always_inline)) {
            float r1A, r1B; row_rstd2(yA, yB, r1A, r1B);
#pragma unroll
            for (int j = 0; j < 4; ++j) { xA[j] += yA[j] * r1A * gpost[j]; xB[j] += yB[j] * r1B * gpost[j]; }
            store_row_bf16(xr + (size_t)m * D, F.lane, xA); store_row_bf16(xr + (size_t)(m + 1) * D, F.lane, xB);
            float r2A, r2B; row_rstd2(xA, xB, r2A, r2B);
#pragma unroll
            for (int j = 0; j < 4; ++j) { xA[j] = xA[j] * r2A * gpre[j]; xB[j] = xB[j] * r2B * gpre[j]; }
            if (MODE == 2) {
#pragma unroll
                for (int j = 0; j < 4; ++j) { ((unsigned*)((unsigned char*)Hb + (size_t)m * D))[64 * j + F.lane] = pg8::pk4_fp8(xA[j].x, xA[j].y, xA[j].z, xA[j].w);
                                              ((unsigned*)((unsigned char*)Hb + (size_t)(m + 1) * D))[64 * j + F.lane] = pg8::pk4_fp8(xB[j].x, xB[j].y, xB[j].z, xB[j].w); }
            } else if (MODE != 1) { store_row_bf16(Hb + (size_t)m * D, F.lane, xA); store_row_bf16(Hb + (size_t)(m + 1) * D, F.lane, xB); }
            if (MODE == 1) {
                v2u hA[4], hB[4];
#pragma unroll
                for (int j = 0; j < 4; ++j) { hA[j].x = pk2(xA[j].x, xA[j].y); hA[j].y = pk2(xA[j].z, xA[j].w); hB[j].x = pk2(xB[j].x, xB[j].y); hB[j].y = pk2(xB[j].z, xB[j].w);
                    ((v2u*)(Hb + (size_t)m * D))[64 * j + F.lane] = hA[j]; ((v2u*)(Hb + (size_t)(m + 1) * D))[64 * j + F.lane] = hB[j]; }
                float pA[16], pB[16];
#pragma unroll
                for (int q = 0; q < 16; ++q) { float s = 0.f, t = 0.f;
#pragma unroll
                    for (int j = 0; j < 4; ++j) { const v2u wp = ((const LAS v2u*)wl)[q * 256 + 64 * j + F.lane];
                        s = dot2bf(wp.x, hA[j].x, s); s = dot2bf(wp.y, hA[j].y, s); t = dot2bf(wp.x, hB[j].x, t); t = dot2bf(wp.y, hB[j].y, t); }
                    pA[q] = s; pB[q] = t; if ((q & 3) == 3) asm volatile("" ::: "memory"); }
                float zA = halve_reduce16(pA, F.lane), zB = halve_reduce16(pB, F.lane);
                if ((F.lane & 3) == 0) { const int q = F.lane >> 2; const float bf = bfq; zA += bf; zB += bf;
                    ((float*)(F.ws + WS_LOGF))[(size_t)m * 16 + q] = fminf(zA, 0.f) - log1pf(expf(-fabsf(zA)));
                    ((float*)(F.ws + WS_LOGF))[(size_t)(m + 1) * 16 + q] = fminf(zB, 0.f) - log1pf(expf(-fabsf(zB))); }
            }
            if (MODE == 2) {
                float lgA[8], lgB[8];
#pragma unroll
                for (int q = 0; q < 8; ++q) { float s = 0.f, t = 0.f;
#pragma unroll
                    for (int j = 0; j < 4; ++j) { const f32x4 w = ((const LAS f32x4*)wl)[q * 256 + 64 * j + F.lane];
                        s += (xA[j].x * w.x + xA[j].y * w.y) + (xA[j].z * w.z + xA[j].w * w.w); t += (xB[j].x * w.x + xB[j].y * w.y) + (xB[j].z * w.z + xB[j].w * w.w); }
                    lgA[q] = s; lgB[q] = t; if ((q & 1) == 1) asm volatile("" ::: "memory"); }
                { const float rA = halve_reduce8(lgA, F.lane), rB = halve_reduce8(lgB, F.lane);
#pragma unroll
                  for (int q = 0; q < 8; ++q) { lgA[q] = __shfl(rA, 8 * q); lgB[q] = __shfl(rB, 8 * q); } }
#pragma unroll
                for (int rr = 0; rr < 2; ++rr) {
                    int e1 = 0; float v1 = rr ? lgB[0] : lgA[0];
#pragma unroll
                    for (int q = 1; q < 8; ++q) { const float v = rr ? lgB[q] : lgA[q]; if (v > v1) { v1 = v; e1 = q; } }
                    int e2 = -1; float v2 = -INFINITY;
#pragma unroll
                    for (int q = 0; q < 8; ++q) { const float v = rr ? lgB[q] : lgA[q]; if (q != e1 && v > v2) { v2 = v; e2 = q; } }
                    const float ex = expf(v2 - v1), g1 = 1.0f / (1.0f + ex), g2 = ex * g1;
                    if (F.lane == 0) { rte[tl + rr] = (unsigned)e1 | ((unsigned)e2 << 8); rtg[2 * (tl + rr)] = g1; rtg[2 * (tl + rr) + 1] = g2; }
                }
            }
        };
        TP_ISSUE(0, mb); TP_ISSUE(1, mb + 2);
#pragma unroll 1
        for (int i = 0; i < 16; i += 4) {
            { const int m = mb + i, tl = F.wave * 16 + i; f32x4 yA[4], xA[4], yB[4], xB[4]; TP_UNPACK(0); if (i + 4 < 16) TP_ISSUE(0, m + 4); body(yA, xA, yB, xB, m, tl); }
            { const int m = mb + i + 2, tl = F.wave * 16 + i + 2; f32x4 yA[4], xA[4], yB[4], xB[4]; TP_UNPACK(1); if (i + 6 < 16) TP_ISSUE(1, m + 4); body(yA, xA, yB, xB, m, tl); }
        }
        if (MODE == 2) {
            __syncthreads();
            unsigned e1 = 0, e2 = 0, r1 = 0, r2 = 0; const int tl = F.tid;
            if (F.wave < 2) { const unsigned w = rte[tl]; e1 = w & 255u; e2 = w >> 8;
                const unsigned long long lt = (1ull << F.lane) - 1ull;
#pragma unroll
                for (unsigned e = 0; e < 8; ++e) { const unsigned long long m1 = __ballot(e1 == e), m2 = __ballot(e2 == e);
                    if (e1 == e) r1 = (unsigned)__popcll(m1 & lt); if (e2 == e) r2 = (unsigned)(__popcll(m1) + __popcll(m2 & lt));
                    if (F.lane == 0) wtot[F.wave * 8 + e] = (unsigned)(__popcll(m1) + __popcll(m2)); } }
            __syncthreads();
            if (F.tid < 8) { const unsigned n = wtot[F.tid] + wtot[8 + F.tid]; wtot[16 + F.tid] = __hip_atomic_fetch_add(F.ctl + CW_CNT + 64 * F.tid, n, RLX_AGENT); }
            __syncthreads();
            if (F.wave < 2) { const int m = tile * 128 + tl;
                const unsigned p1 = wtot[16 + e1] + (F.wave ? wtot[e1] : 0u) + r1, p2 = wtot[16 + e2] + (F.wave ? wtot[e2] : 0u) + r2;
                v2u pp; pp.x = (e1 << 20) | p1; pp.y = (e2 << 20) | p2; ((v2u*)(F.ws + WS_RTPOS))[m] = pp;
                ((unsigned*)(F.ws + WS_RIDX))[e1 * T + p1] = (unsigned)m; ((unsigned*)(F.ws + WS_RIDX))[e2 * T + p2] = (unsigned)m;
                ((f32x2*)(F.ws + WS_RTG))[m] = (f32x2){rtg[2 * tl], rtg[2 * tl + 1]}; }
            __syncthreads();
        }
    }
}

#undef TP_ISSUE
#undef TP_UNPK
#undef TP_PIN
#undef TP_UNPACK
__device__ __forceinline__ f32x4 unpk4(v2u w) { return (f32x4){bf_lo(w.x), bf_hi(w.x), bf_lo(w.y), bf_hi(w.y)}; }
template <int W>
__device__ __forceinline__ void pool_rows(LAS unsigned char* P, LAS unsigned char* HALO, int seg, int c4, int tb0) {
    f32x4 ring[W]; f32x4 S = (f32x4){0.f, 0.f, 0.f, 0.f};
#pragma unroll
    for (int k = 0; k < W; ++k) { const int row = 32 - W + k;
        const v2u w = seg ? *(const LAS v2u*)(P + row * 2048 + ((((c4 >> 1) ^ (row & 15))) << 4) + (c4 & 1) * 8) : *(const LAS v2u*)(HALO + (W - 2) * 512 + k * 512 + 8 * (c4 & 63));
        ring[k] = unpk4(w); S += ring[k]; }
    __syncthreads();
    const int tbb = tb0 + 32 * seg;
#pragma unroll
    for (int i = 0; i < 32; ++i) { const int row = 32 * seg + i; LAS v2u* p = (LAS v2u*)(P + row * 2048 + ((((c4 >> 1) ^ (row & 15))) << 4) + (c4 & 1) * 8);
        const f32x4 hv = unpk4(*p); S += hv - ring[i % W]; ring[i % W] = hv;
        const int tb = tbb + i; const float inv = 1.0f / (float)((tb + 1 < W) ? (tb + 1) : W);
        const f32x4 pv_ = S * inv - hv; v2u o; o.x = pk2(pv_.x, pv_.y); o.y = pk2(pv_.z, pv_.w); *p = o; }
}
__device__ __forceinline__ void pro_publish(Frame& F) {
    asm volatile("s_waitcnt vmcnt(0)" ::: "memory");
    __syncthreads();
    if (threadIdx.x == 0) { __builtin_amdgcn_fence(__ATOMIC_RELEASE, "agent"); asm volatile("s_waitcnt vmcnt(0)" ::: "memory"); (void)xb_add((unsigned*)(F.ctl + CW_PRO), 1u); }
}
__device__ __forceinline__ void pro_wait(Frame& F) {
    if (threadIdx.x == 0) { unsigned* const bar = (unsigned*)(F.ctl + CW_BAR); unsigned* const c = (unsigned*)(F.ctl + CW_PRO); const unsigned G = (unsigned)F.G;
        XB_SPIN(xb_ld(c) < G, bar); __builtin_amdgcn_fence(__ATOMIC_ACQUIRE, "agent"); asm volatile("s_waitcnt vmcnt(0)" ::: "memory"); }
    __syncthreads();
}
__device__ __forceinline__ void mix0_phase(Frame& F, const In& I, bf16* xr) {
    typedef short bf16x8_t __attribute__((ext_vector_type(8)));
    LAS unsigned char* const P = F.lds + RING_OFF;
    LAS unsigned char* const HALO = F.lds + MISC_OFF + 128;
    const bf16* const WP = (const bf16*)(F.ws + WS_WPOOL);
    bf16* const Hb = (bf16*)(F.ws + WS_H);
    const int lane = F.lane, wave = F.wave, c16 = lane & 15, kq = lane >> 4;
    bool first = true;
    for (int tile = F.vcu; tile < T / 64; tile += F.G) {
        const int t0 = tile * 64, tb0 = t0 & (SEQ - 1);
        { f32x4 g0[4]; load_row_f32(I.norm_g, lane, g0);
#pragma unroll 1
          for (int bt = 0; bt < 2; ++bt) {
              f32x4 a[5][4]; float sq[5];
#pragma unroll
              for (int k = 0; k < 5; ++k) { const int rr = t0 - 16 + wave + 8 * (5 * bt + k); load_row_f32(I.x + (size_t)(rr < 0 ? 0 : rr) * D, lane, a[k]); }
#pragma unroll
              for (int k = 0; k < 5; ++k) { float q = 0.f;
#pragma unroll
                  for (int j = 0; j < 4; ++j) q += (a[k][j].x * a[k][j].x + a[k][j].y * a[k][j].y) + (a[k][j].z * a[k][j].z + a[k][j].w * a[k][j].w);
                  sq[k] = q; }
#pragma unroll
              for (int o = 1; o < 64; o <<= 1) {
#pragma unroll
                  for (int k = 0; k < 5; ++k) sq[k] += __shfl_xor(sq[k], o); }
#pragma unroll
              for (int k = 0; k < 5; ++k) { const int row = -16 + wave + 8 * (5 * bt + k);
                  const float rstd = (tb0 + row >= 0) ? 1.0f / sqrtf(sq[k] * (1.0f / D) + RMS_EPS) : 0.f;
#pragma unroll
                  for (int j = 0; j < 4; ++j) { const f32x4 hv = a[k][j] * (g0[j] * rstd); v2u o; o.x = pk2(hv.x, hv.y); o.y = pk2(hv.z, hv.w);
                      if (row >= 0) *(LAS v2u*)(P + row * 2048 + ((((32 * j + (lane >> 1)) ^ (row & 15))) << 4) + (lane & 1) * 8) = o;
                      else { const int wj = 2 << j; if (row >= -wj) *(LAS v2u*)(HALO + (wj - 2) * 512 + (row + wj) * 512 + 8 * lane) = o; } } }
          } }
        __syncthreads();
        { int tid_ = threadIdx.x; asm volatile("" : "+v"(tid_));
          const int seg = tid_ >> 8, c4 = tid_ & 255;
          switch ((c4 >> 6) & 3) { case 0: pool_rows<2>(P, HALO, seg, c4, tb0); break; case 1: pool_rows<4>(P, HALO, seg, c4, tb0); break; case 2: pool_rows<8>(P, HALO, seg, c4, tb0); break; default: pool_rows<16>(P, HALO, seg, c4, tb0); break; } }
        __syncthreads();
        f32x4 acc[4][8];
#pragma unroll
        for (int m = 0; m < 4; ++m)
#pragma unroll
            for (int nb = 0; nb < 8; ++nb) acc[m][nb] = (f32x4){0.f, 0.f, 0.f, 0.f};
        if (first) { pro_wait(F); first = false; }
        { const int gI = wave >> 1;
          const char* const wpb = (const char*)WP;
          const unsigned boff = (unsigned)((gI * 2 + (wave & 1)) * (8 * 8 * 64) + lane) * 16u;
          bf16x8_t bnx[8];
          { unsigned bo = boff; asm volatile("" : "+v"(bo));
#pragma unroll
            for (int nb = 0; nb < 8; ++nb) bnx[nb] = *(const bf16x8_t*)(wpb + (size_t)(bo + (unsigned)nb * 1024u)); }
#pragma unroll 1
          for (int ks = 0; ks < 8; ++ks) {
              bf16x8_t bfr[8], afr[4];
#pragma unroll
              for (int nb = 0; nb < 8; ++nb) bfr[nb] = bnx[nb];
              if (ks + 1 < 8) { unsigned bo = boff + (unsigned)(ks + 1) * 8192u; asm volatile("" : "+v"(bo));
#pragma unroll
                  for (int nb = 0; nb < 8; ++nb) bnx[nb] = *(const bf16x8_t*)(wpb + (size_t)(bo + (unsigned)nb * 1024u)); }
#pragma unroll
              for (int m = 0; m < 4; ++m) afr[m] = *(const LAS bf16x8_t*)(P + (16 * m + c16) * 2048 + (((32 * gI + 4 * ks + kq) ^ c16) << 4));
#pragma unroll
              for (int m = 0; m < 4; ++m)
#pragma unroll
                  for (int nb = 0; nb < 8; ++nb) acc[m][nb] = __builtin_amdgcn_mfma_f32_16x16x32_bf16(bfr[nb], afr[m], acc[m][nb], 0, 0, 0);
          } }
        __syncthreads();
#pragma unroll
        for (int nb = 0; nb < 8; ++nb) { const int col = 128 * wave + 16 * nb + 4 * kq; const f32x4 sc = *(const f32x4*)(I.pool_scale + col);
#pragma unroll
            for (int m = 0; m < 4; ++m) { const f32x4 v = acc[m][nb] * sc; v2u o; o.x = pk2(v.x, v.y); o.y = pk2(v.z, v.w);
                const int row = 16 * m + c16;
                *(LAS v2u*)(P + row * 2048 + ((((col >> 3) ^ c16)) << 4) + (kq & 1) * 8) = o; } }
        __syncthreads();
        { const int rb0 = wave * 8; int lane_ = threadIdx.x & 63; asm volatile("" : "+v"(lane_)); const int lane = lane_;
          f32x4 gpost[4], gpre[4];
          load_row_f32(I.norm_g + 1 * D, lane, gpost); load_row_f32(I.norm_g + 2 * D, lane, gpre);
#pragma unroll 1
          for (int i = 0; i < 8; i += 4) {
              f32x4 y[4][4], x[4][4]; float sq[4];
#pragma unroll
              for (int q = 0; q < 4; ++q) load_row_f32(I.x + (size_t)(t0 + rb0 + i + q) * D, lane, x[q]);
#pragma unroll
              for (int q = 0; q < 4; ++q) { const int r = rb0 + i + q;
#pragma unroll
                  for (int j = 0; j < 4; ++j) {
                      const v2u wv = *(const LAS v2u*)(P + r * 2048 + ((((32 * j + (lane >> 1)) ^ (r & 15))) << 4) + (lane & 1) * 8);
                      y[q][j] = (f32x4){bf_lo(wv.x), bf_hi(wv.x), bf_lo(wv.y), bf_hi(wv.y)}; } }
#pragma unroll
              for (int q = 0; q < 4; ++q) { float t = 0.f;
#pragma unroll
                  for (int j = 0; j < 4; ++j) t += (y[q][j].x * y[q][j].x + y[q][j].y * y[q][j].y) + (y[q][j].z * y[q][j].z + y[q][j].w * y[q][j].w);
                  sq[q] = t; }
#pragma unroll
              for (int o = 1; o < 64; o <<= 1) {
#pragma unroll
                  for (int q = 0; q < 4; ++q) sq[q] += __shfl_xor(sq[q], o); }
#pragma unroll
              for (int q = 0; q < 4; ++q) { const float r1 = 1.0f / sqrtf(sq[q] * (1.0f / D) + RMS_EPS); float t = 0.f;
#pragma unroll
                  for (int j = 0; j < 4; ++j) { x[q][j] += y[q][j] * r1 * gpost[j]; t += (x[q][j].x * x[q][j].x + x[q][j].y * x[q][j].y) + (x[q][j].z * x[q][j].z + x[q][j].w * x[q][j].w); }
                  store_row_bf16(xr + (size_t)(t0 + rb0 + i + q) * D, lane, x[q]); sq[q] = t; }
#pragma unroll
              for (int o = 1; o < 64; o <<= 1) {
#pragma unroll
                  for (int q = 0; q < 4; ++q) sq[q] += __shfl_xor(sq[q], o); }
#pragma unroll
              for (int q = 0; q < 4; ++q) { const float r2 = 1.0f / sqrtf(sq[q] * (1.0f / D) + RMS_EPS);
#pragma unroll
                  for (int j = 0; j < 4; ++j) x[q][j] = x[q][j] * r2 * gpre[j];
                  if (MK_FFN0_FP8) {
#pragma unroll
                      for (int j = 0; j < 4; ++j) ((unsigned*)((unsigned char*)Hb + (size_t)(t0 + rb0 + i + q) * D))[64 * j + lane] = pg8::pk4_fp8(x[q][j].x, x[q][j].y, x[q][j].z, x[q][j].w);
                  } else store_row_bf16(Hb + (size_t)(t0 + rb0 + i + q) * D, lane, x[q]); }
          } }
        __syncthreads();
    }
}

__device__ __forceinline__ void moe_offsets(Frame& F) {
    if (F.tid < 64) {
        const unsigned c = F.tid < NE ? __hip_atomic_load(F.ctl + CW_CNT + 64 * (F.tid & 7), RLX_AGENT) : 0u; unsigned incl = (c + 255u) >> 8;
#pragma unroll
        for (int o = 1; o < 8; o <<= 1) { const unsigned t = (unsigned)__shfl_up((int)incl, o); if (F.lane >= o) incl += t; }
        if (F.tid < NE) F.MISC[12 + F.tid] = incl - ((c + 255u) >> 8);
        if (F.tid == NE - 1) { F.MISC[12 + NE] = incl; F.MISC[10] = incl; } }
    __syncthreads();
}
__device__ __forceinline__ void permute_phase(Frame& F) {
    moe_offsets(F);
    unsigned* const ridx = (unsigned*)(F.ws + WS_RIDX);
    const int gt = F.vcu * (NWAVES * 64) + F.tid, NGT = F.G * NWAVES * 64;
    for (int m = gt; m < T; m += NGT) { v2u pp = ((const v2u*)(F.ws + WS_RTPOS))[m];
        const unsigned e1 = pp.x >> 20, e2 = pp.y >> 20, d1 = F.MISC[12 + e1] * 256u + (pp.x & 0xfffffu), d2 = F.MISC[12 + e2] * 256u + (pp.y & 0xfffffu);
        pp.x = d1; pp.y = d2; ((v2u*)(F.ws + WS_RTPOS))[m] = pp; ridx[d1] = (unsigned)m; ridx[d2] = (unsigned)m; }
    for (int e = 0; e < NE; ++e) { const unsigned c = __hip_atomic_load(F.ctl + CW_CNT + 64 * e, RLX_AGENT); const unsigned r0 = F.MISC[12 + e] * 256u + c, r1 = F.MISC[13 + e] * 256u;
        for (unsigned r = r0 + (unsigned)gt; r < r1; r += (unsigned)NGT) ridx[r] = 0u; }
}
__device__ __forceinline__ void load_row_fp8(const unsigned char* p, int lane, f32x4 (&v)[4]) {
#pragma unroll
    for (int j = 0; j < 4; ++j) { const int w = __builtin_nontemporal_load((const int*)p + 64 * j + lane); const f32x2 lo = __builtin_amdgcn_cvt_pk_f32_fp8(w, false), hi = __builtin_amdgcn_cvt_pk_f32_fp8(w, true); v[j] = (f32x4){lo.x, lo.y, hi.x, hi.y}; }
}
__device__ __forceinline__ void final_phase(Frame& F, const In& I, float* xout) {
    const unsigned char* YS = F.ws + WS_YS; const bf16* xr = (const bf16*)(F.ws + WS_XR);
    f32x4 gp[4]; load_row_f32(I.norm_g + (size_t)(1 * 4 + 3) * D, F.lane, gp);
    for (int tile = F.vcu; tile < T / 128; tile += F.G) {
        const int mb = tile * 128 + F.wave * 16;
        v2u pp = (v2u){0u, 0u}; f32x2 gg = (f32x2){0.f, 0.f};
        if (F.lane < 16) { pp = ((const v2u*)(F.ws + WS_RTPOS))[mb + F.lane]; gg = ((const f32x2*)(F.ws + WS_RTG))[mb + F.lane];
            pp.x = F.MISC[12 + (pp.x >> 20)] * 256u + (pp.x & 0xfffffu); pp.y = F.MISC[12 + (pp.y >> 20)] * 256u + (pp.y & 0xfffffu); }
        f32x4 anA[4], bnA[4], xnA[4], anB[4], bnB[4], xnB[4];
        load_row_fp8(YS + (size_t)(unsigned)__shfl((int)pp.x, 0) * D, F.lane, anA); load_row_fp8(YS + (size_t)(unsigned)__shfl((int)pp.y, 0) * D, F.lane, bnA); load_row_bf16_nt(xr + (size_t)mb * D, F.lane, xnA);
        load_row_fp8(YS + (size_t)(unsigned)__shfl((int)pp.x, 1) * D, F.lane, anB); load_row_fp8(YS + (size_t)(unsigned)__shfl((int)pp.y, 1) * D, F.lane, bnB); load_row_bf16_nt(xr + (size_t)(mb + 1) * D, F.lane, xnB);
#pragma unroll 1
        for (int i = 0; i < 16; i += 2) {
            const int m = mb + i;
            f32x4 aA[4], xA[4], aB[4], xB[4];
            const float g1A = __shfl(gg.x, i), g2A = __shfl(gg.y, i), g1B = __shfl(gg.x, i + 1), g2B = __shfl(gg.y, i + 1);
#pragma unroll
            for (int j = 0; j < 4; ++j) { aA[j] = anA[j] * g1A + bnA[j] * g2A; aB[j] = anB[j] * g1B + bnB[j] * g2B; xA[j] = xnA[j]; xB[j] = xnB[j]; }
            if (i + 2 < 16) {
                load_row_fp8(YS + (size_t)(unsigned)__shfl((int)pp.x, i + 2) * D, F.lane, anA); load_row_fp8(YS + (size_t)(unsigned)__shfl((int)pp.y, i + 2) * D, F.lane, bnA); load_row_bf16_nt(xr + (size_t)(m + 2) * D, F.lane, xnA);
                load_row_fp8(YS + (size_t)(unsigned)__shfl((int)pp.x, i + 3) * D, F.lane, anB); load_row_fp8(YS + (size_t)(unsigned)__shfl((int)pp.y, i + 3) * D, F.lane, bnB); load_row_bf16_nt(xr + (size_t)(m + 3) * D, F.lane, xnB); }
            float rA, rB; row_rstd2(aA, aB, rA, rB);
#pragma unroll
            for (int j = 0; j < 4; ++j) { xA[j] += aA[j] * rA * gp[j]; xB[j] += aB[j] * rB * gp[j]; }
            store_row_f32(xout + (size_t)m * D, F.lane, xA); store_row_f32(xout + (size_t)(m + 1) * D, F.lane, xB);
        }
    }
}
__device__ __forceinline__ void scan_phase(Frame& F, int unit) {
    const int bh = unit >> 2, qn = unit & 3, b = bh / NH, h = bh % NH; const float* lf = (const float*)(F.ws + WS_LOGF) + ((size_t)b * SEQ + 2048 * qn) * 16 + h;
    float* ncs = (float*)(F.ws + WS_NCS) + (size_t)bh * SEQ + 2048 * qn;
    LAS float* part = (LAS float*)(F.lds + RING_OFF);
    float v[4]; float s = 0.f; const int s0 = F.tid * 4;
#pragma unroll
    for (int i = 0; i < 4; ++i) { v[i] = lf[(size_t)(s0 + i) * 16]; s += v[i]; }
    float incl = s;
#pragma unroll
    for (int o = 1; o < 64; o <<= 1) { const float t = __shfl_up(incl, o); if (F.lane >= o) incl += t; }
    if (F.lane == 63) part[F.wave] = incl;
    __syncthreads();
    float base = incl - s, tot = 0.f;
    for (int w = 0; w < NWAVES; ++w) { const float p = part[w]; if (w < F.wave) base += p; tot += p; }
    float run = base; f32x4 o4; run += v[0]; o4.x = -1.4426950408889634f * run; run += v[1]; o4.y = -1.4426950408889634f * run; run += v[2]; o4.z = -1.4426950408889634f * run; run += v[3]; o4.w = -1.4426950408889634f * run;
    *(f32x4*)(ncs + s0) = o4;
    if (F.tid == 0) ((float*)(F.ws + WS_QTOT))[unit] = -1.4426950408889634f * tot;
    __syncthreads();
}

__device__ __forceinline__ bool attn_next(int vcu, int G, int i, int& bh, int& qb) {
    if (G == 256) { if (i >= 8) return false; const int s = vcu & 3; bh = vcu >> 2; const int base = 8 * (i >> 1); qb = (i & 1) ? base + 7 - s : base + s; return true; }
    const int u = vcu + i * G; if (u >= 64 * 32) return false; bh = u >> 5; qb = 31 - (u & 31); return true;
}

struct Args { const float* in[14]; float* out; unsigned char* ws; int ph_lo, ph_hi; };
__global__ void __launch_bounds__(NWAVES * 64, 2) trunk_fwd(Args args) {
    extern __shared__ __attribute__((aligned(16))) unsigned char lds[];
    Frame F;
    F.lds = (LAS unsigned char*)lds;
    F.MISC = (volatile LAS unsigned*)(F.lds + MISC_OFF);
    F.tid = threadIdx.x; F.lane = F.tid & 63; F.wave = __builtin_amdgcn_readfirstlane(F.tid >> 6);
    F.G = gridDim.x; { const int bx = blockIdx.x; F.vcu = (F.G % 8 == 0) ? (bx % 8) * (F.G / 8) + bx / 8 : bx; }
    F.ws = args.ws; F.ctl = (gu32*)(args.ws + WS_CTL);
    const __attribute__((address_space(4))) Args* const ka = (const __attribute__((address_space(4))) Args*)__builtin_amdgcn_kernarg_segment_ptr();
#define KA_IN(i) ((const float*)*(const float* const volatile __attribute__((address_space(4)))*)&ka->in[i])
#define LOAD_IN() In I; I.x = KA_IN(0); I.norm_g = KA_IN(1); I.pool_w = KA_IN(2); I.pool_scale = KA_IN(3); I.w_in = KA_IN(4); I.b_f = KA_IN(5); I.w_out = KA_IN(6); \
    I.w_gate = KA_IN(7); I.w_up = KA_IN(8); I.w_down = KA_IN(9); I.w_router = KA_IN(10); I.mw_gate = KA_IN(11); I.mw_up = KA_IN(12); I.mw_down = KA_IN(13); \
    float* const out = (float*)*(float* const volatile __attribute__((address_space(4)))*)&ka->out; (void)out; (void)I; RELAUNDER()
#define RELAUNDER() do { int t_ = threadIdx.x; asm volatile("" : "+v"(t_)); F.tid = t_; F.lane = t_ & 63; } while (0)
    unsigned char* const ws = args.ws;
    for (int u = F.tid; u < (LDS_BYTES - LDSCTL_OFF) / 4; u += NWAVES * 64) ((LAS unsigned*)(F.lds + LDSCTL_OFF))[u] = 0u;
    __syncthreads();
    XcdBarrier bar; bar.bar = (unsigned*)(F.ctl + CW_BAR); bar.x = 0; bar.st = nullptr;
#if !MK_PER_PHASE
    bar = xcd_barrier_post((unsigned*)(F.ctl + CW_BAR), F.MISC + 8);
#endif
    const int lo = args.ph_lo, hi = args.ph_hi;
#define IN(k) (lo <= (k) && (k) < hi)
#ifndef MK_REPEAT
#define MK_REPEAT (-1)
#endif
#define PHASE(k) for (int rep_ = 0; rep_ < ((MK_REPEAT == (k)) ? 2 : 1); ++rep_) if (rep_ ? (xcd_barrier(bar), true) : true) if (IN(k))
#ifndef MK_TPROBE
#define MK_TPROBE (-1)
#endif
    unsigned long long tp0_ = (MK_TPROBE >= 0) ? __builtin_amdgcn_s_memrealtime() : 0ull, tp1_ = tp0_;
#define SEAM(k) do { if (IN(k) && IN((k) + 1)) { xcd_barrier(bar); } if (MK_TPROBE >= 0) { if ((k) == MK_TPROBE - 1) tp0_ = __builtin_amdgcn_s_memrealtime(); if ((k) == MK_TPROBE) tp1_ = __builtin_amdgcn_s_memrealtime(); } } while (0)
    const int cblk = (int)blockIdx.x;


    PHASE(PH_MIX0) { LOAD_IN();
        p0_prologue<0>(F, I); pro_publish(F);
        if (cblk & 1) { p0_prologue<1>(F, I); __syncthreads(); }
        mix0_phase(F, I, (bf16*)(ws + WS_XR));
        RELAUNDER();
        if (!(cblk & 1)) p0_prologue<1>(F, I); } SEAM(PH_MIX0);

    PHASE(PH_GU0) {
      LOAD_IN();
      for (int pass = 0; pass < 2; ++pass) {
        if ((pass == 0) == ((cblk & 1) == 0)) { moe_conv_share(F, I); __syncthreads(); continue; }
#if MK_FFN0_FP8
        pg8::GemmK g{D / 2, D / 2, D / 2};
        pg8::DenseOrder S{T / 256, FF0 / 128, (T / 256) * (FF0 / 128), F.G, cblk, (const char*)(ws + WS_H), (const char*)(ws + WS_WGU0), (size_t)256 * D, 0, (size_t)256 * D};
        typedef pg8::EpiSwiGLU8<(int)WGU_PRESCALE> EpiGU8;
        EpiGU8 E{ws + WS_ACT0, FF0};
        pg8::gemm_phase<EpiGU8, pg8::DenseOrder, true, true>(F.lds + RING_OFF, g, S, E);
#else
        pg8::GemmK g{D, D, D};
        pg8::DenseOrder S{T / 256, FF0 / 128, (T / 256) * (FF0 / 128), F.G, cblk, (const char*)(ws + WS_H), (const char*)(ws + WS_WGU0), (size_t)256 * D * 2, 0, (size_t)256 * D * 2};
#if MK_FFN0_DN_FP8
        typedef pg8::EpiSwiGLU8<1> EpiGUf8;
        EpiGUf8 E{ws + WS_ACT0, FF0};
        pg8::gemm_phase<EpiGUf8, pg8::DenseOrder, true>(F.lds + RING_OFF, g, S, E);
#else
        pg8::EpiSwiGLU E{(bf16*)(ws + WS_ACT0), FF0};
        pg8::gemm_phase<pg8::EpiSwiGLU, pg8::DenseOrder, true>(F.lds + RING_OFF, g, S, E);
#endif
#endif
        __syncthreads();
      }
    } SEAM(PH_GU0);

    PHASE(PH_DN0) {
#if MK_FFN0_DNF8
        pg8::GemmK g{FF0 / 2, FF0 / 2, FF0 / 2};
        pg8::DenseOrder S{T / 256, D / 256, (T / 256) * (D / 256), F.G, cblk, (const char*)(ws + WS_ACT0), (const char*)(ws + WS_WD0), (size_t)256 * FF0, 0, (size_t)256 * FF0};
        pg8::EpiBf16 E{(bf16*)(ws + WS_YB), D, nullptr, 0, 0, 1.0f / WD_PRESCALE};
        pg8::gemm_phase<pg8::EpiBf16, pg8::DenseOrder, true, true>(F.lds + RING_OFF, g, S, E);
#else
        pg8::GemmK g{FF0, FF0, FF0};
        pg8::DenseOrder S{T / 256, D / 256, (T / 256) * (D / 256), F.G, cblk, (const char*)(ws + WS_ACT0), (const char*)(ws + WS_WD0), (size_t)256 * FF0 * 2, 0, (size_t)256 * FF0 * 2};
        pg8::EpiBf16 E{(bf16*)(ws + WS_YB), D, nullptr, 0, 0, 1.f};
        pg8::gemm_phase<pg8::EpiBf16, pg8::DenseOrder, true>(F.lds + RING_OFF, g, S, E);
#endif
    } SEAM(PH_DN0);

    PHASE(PH_THB) { LOAD_IN(); thin_phase<1>(F, I, (const bf16*)(ws + WS_YB), (bf16*)(ws + WS_XR), I.norm_g + 3 * D, I.norm_g + 4 * D); } SEAM(PH_THB);

    PHASE(PH_QKV) {
        RELAUNDER();
        for (int un = cblk; un < BATCH * NH * 4; un += F.G) scan_phase(F, un);
        pg8::GemmK g{D, D, D};
        pg8::DenseOrder S{T / 256, 12, (T / 256) * 12, F.G, cblk, (const char*)(ws + WS_H), (const char*)(ws + WS_WIN), (size_t)256 * D * 2, 0, (size_t)256 * D * 2};
        pg8::EpiQKV E{(bf16*)(ws + WS_Q), D, (size_t)(WS_K - WS_Q) / 2, attn_body::C2, (float*)(ws + WS_NRM), (float*)(ws + WS_NRM) + 256 * 32, (float*)(ws + WS_KBAR)};
        pg8::gemm_phase<pg8::EpiQKV, pg8::DenseOrder, true>(F.lds + RING_OFF, g, S, E);
    } SEAM(PH_QKV);

    PHASE(PH_ATT) {
        RELAUNDER();
        unsigned nxt = 0u;
        if (F.tid == 0) { nxt = __hip_atomic_fetch_add(F.ctl + CW_AQ + 64 * rep_, 1u, RLX_AGENT); F.MISC[11] = nxt; }
        __syncthreads();
        unsigned cur = (unsigned)__builtin_amdgcn_readfirstlane((int)F.MISC[11]);
        while (cur < (unsigned)(BATCH * NH * 32)) {
            if (F.tid == 0) nxt = __hip_atomic_fetch_add(F.ctl + CW_AQ + 64 * rep_, 1u, RLX_AGENT);
            const int qb = 31 - (int)(cur >> 6), bh = (int)(cur & 63u), q0 = qb * 256, NT = (q0 + 256) / 64;
            const float* ncs = (const float*)(ws + WS_NCS) + (size_t)bh * SEQ;
            const bool hasq = qb > 0; const int j = 2 * F.lane + 1; const bool inr = (j + 5 <= NT); const int jc = inr ? j : 1;
            const float* nqp = (const float*)(ws + WS_NRM) + (size_t)((bh >> 4) * 64 + (F.lane >> 1)) * 32 + (bh & 15) * 2 + (F.lane & 1);
            const float l_mk0 = nqp[256 * 32], l_mk1 = nqp[256 * 32 + 32 * 32];
            const float l_mq = ((const float*)(ws + WS_NRM))[(size_t)(((bh >> 4) * 32 + qb) * 2 + ((F.lane >> 1) & 1)) * 32 + (bh & 15) * 2 + (F.lane & 1)];
            const float* kbp = (const float*)(ws + WS_KBAR) + ((size_t)((bh >> 4) * 128 + (hasq ? qb * 4 - 1 : 0)) * 16 + (bh & 15)) * 2; const float l_kb0 = kbp[0], l_kb1 = kbp[1];
            const float l_ms = ncs[(hasq ? q0 - 64 : 0) + F.lane], l_nq = ncs[q0], l_nk = ncs[64 * jc + 63], l_ne = ncs[64 * jc - 1];
            const float* qt = (const float*)(ws + WS_QTOT) + bh * 4; const float qo1 = qt[0], qo2 = qo1 + qt[1], qo3 = qo2 + qt[2];
            float mq = l_mq, mk = fmaxf(l_mk0, l_mk1), ms = l_ms;
#pragma unroll
            for (int o = 1; o < 64; o <<= 1) { mq = fmaxf(mq, __shfl_xor(mq, o)); mk = fmaxf(mk, __shfl_xor(mk, o)); ms += __shfl_xor(ms, o); }
            const float theta = 4.08f * mq * mk + 40.f, theta1 = 2.04f * mq * mk + 40.f;
            float dm = -INFINITY;
            if (hasq) { const int sq = (q0 - 64) >> 11; dm = 6.f + ms * (1.f / 64.f) + (sq == 0 ? 0.f : (sq == 1 ? qo1 : (sq == 2 ? qo2 : qo3))) - 1.02f * 1.41422f * mq * (sqrtf(l_kb0 + l_kb1) + 0.01f * 1.41422f * mk); }
            bool skip = false; float wj = 0.f, nqv = 0.f;
            { const int sq = q0 >> 11, sk = (64 * jc + 63) >> 11, se = (64 * jc - 1) >> 11;
              const float nq = l_nq + (sq == 0 ? 0.f : (sq == 1 ? qo1 : (sq == 2 ? qo2 : qo3))), nk = l_nk + (sk == 0 ? 0.f : (sk == 1 ? qo1 : (sk == 2 ? qo2 : qo3)));
              const float ne = l_ne + (se == 0 ? 0.f : (se == 1 ? qo1 : (se == 2 ? qo2 : qo3)));
              if (inr) { skip = (nq - nk) >= theta || (dm - nk) >= theta1; wj = exp2f(nk - nq) + exp2f(ne - nq); nqv = nq; } }
            { float P = wj;
#pragma unroll
              for (int o = 1; o < 64; o <<= 1) { const float t = __shfl_up(P, o); if (F.lane >= o) P += t; }
              if (inr) skip = skip || (dm - nqv - log2f(P)) >= (theta1 - 7.f); }
            const int tstart = 2 * (int)__popcll(__ballot(skip));
            attn_body::attn_unit<24>(bh / NH, bh % NH, qb, tstart, (const attn_body::bf16*)(ws + WS_Q), (const attn_body::bf16*)(ws + WS_K), (const attn_body::bf16*)(ws + WS_V), (attn_body::bf16*)(ws + WS_H),
                                     (const float*)(ws + WS_NCS), (const float*)(ws + WS_QTOT) + bh * 4, (char*)lds + RING_OFF);
            if (F.tid == 0) F.MISC[11] = nxt;
            __syncthreads();
            cur = (unsigned)__builtin_amdgcn_readfirstlane((int)F.MISC[11]);
        }
    } SEAM(PH_ATT);

    PHASE(PH_WO) {
        pg8::GemmK g{D, D, D};
        pg8::DenseOrder S{T / 256, D / 256, (T / 256) * (D / 256), F.G, cblk, (const char*)(ws + WS_H), (const char*)(ws + WS_WOUT), (size_t)256 * D * 2, 0, (size_t)256 * D * 2};
        pg8::EpiBf16 E{(bf16*)(ws + WS_YATT), D, nullptr, 0, 0, 1.f};
        pg8::gemm_phase<pg8::EpiBf16, pg8::DenseOrder, true>(F.lds + RING_OFF, g, S, E);
    } SEAM(PH_WO);

    PHASE(PH_THC) { LOAD_IN(); thin_phase<2>(F, I, (const bf16*)(ws + WS_YATT), (bf16*)(ws + WS_XR), I.norm_g + 5 * D, I.norm_g + 6 * D); } SEAM(PH_THC);


    if (hi > PH_MOE && lo < PH_FIN) {
        RELAUNDER();
        moe_offsets(F);
        const int nRT = __builtin_amdgcn_readfirstlane((int)F.MISC[10]);
        for (int c = 0; c < MAXCHUNK; ++c) {
            const int rt0 = c * CHUNK_RT; int nM = nRT - rt0; if (c == 0 && nM > CHUNK_RT) nM = CHUNK_RT;
            PHASE(PH_MOE + 2 * c) if (nM > 0) {
                pg8::GemmK g{D / 2, D / 2, D / 2};
                typedef pg8::MoeOrder<FFE / 128, 0, 0, (size_t)2 * FFE * D, (size_t)256 * D, 0> OrdGU;
                OrdGU S{rt0, nM, F.G, cblk, (const char*)(ws + WS_H), (const char*)(ws + WS_WGU), (const LAS unsigned*)(F.lds + MISC_OFF + 48)};
                typedef pg8::EpiSwiGLU8<(int)WGU_PRESCALE> EpiGU8;
                EpiGU8 E{ws + WS_ACTC, FFE};
                pg8::gemm_phase<EpiGU8, OrdGU, true, true, true>(F.lds + RING_OFF, g, S, E, (long)WS_RIDX - (long)WS_H);
            }
            SEAM(PH_MOE + 2 * c);
            PHASE(PH_MOE + 2 * c + 1) if (nM > 0) {
                pg8::GemmK g{FFE / 2, FFE / 2, FFE / 2};
                typedef pg8::MoeOrder<D / 256, (size_t)256 * FFE, 1, (size_t)D * FFE, (size_t)256 * FFE, 1> OrdDN;
                OrdDN S{rt0, nM, F.G, cblk, (const char*)(ws + WS_ACTC), (const char*)(ws + WS_WD), (const LAS unsigned*)(F.lds + MISC_OFF + 48)};
                pg8::EpiFp8 E{ws + WS_YS, D, 1.0f / WD_PRESCALE};
                pg8::gemm_phase<pg8::EpiFp8, OrdDN, true, true>(F.lds + RING_OFF, g, S, E);
            }
            SEAM(PH_MOE + 2 * c + 1);
        }
    }

    PHASE(PH_FIN) { LOAD_IN(); final_phase(F, I, out); }
    if (MK_TPROBE >= 0) { if (MK_TPROBE == PH_FIN) { asm volatile("s_waitcnt vmcnt(0)" ::: "memory"); tp1_ = __builtin_amdgcn_s_memrealtime(); }
        if (blockIdx.x == 0) { const unsigned long long t_ = __builtin_amdgcn_s_memrealtime(), d_ = 4ull * (tp1_ - tp0_); while (__builtin_amdgcn_s_memrealtime() - t_ < d_) __builtin_amdgcn_s_sleep(8); } }
#undef IN
#undef SEAM
}

extern "C" void kernel_launch(void* const* d_in, const int* in_sizes, int n_in, void* d_out, int out_size, void* d_ws, size_t ws_size, hipStream_t stream) {
    static int grid = 0;
    if (grid == 0) {
        if (n_in != 14 || in_sizes[0] != T * D || out_size != T * D || ws_size < WS_END) { fprintf(stderr, "kernel_launch: unexpected shapes (n_in %d, in0 %d, out %d, ws %zu); nothing launched\n", n_in, n_in > 0 ? in_sizes[0] : -1, out_size, ws_size); grid = -1; return; }
        int dev = 0, cus = 0, per_cu = 0;
        if (hipGetDevice(&dev) != hipSuccess || hipDeviceGetAttribute(&cus, hipDeviceAttributeMultiprocessorCount, dev) != hipSuccess) { grid = -1; return; }
        if (hipFuncSetAttribute((const void*)trunk_fwd, hipFuncAttributeMaxDynamicSharedMemorySize, LDS_BYTES) != hipSuccess) { fprintf(stderr, "kernel_launch: hipFuncSetAttribute failed\n"); grid = -1; return; }
        if (hipOccupancyMaxActiveBlocksPerMultiprocessor(&per_cu, (const void*)trunk_fwd, NWAVES * 64, LDS_BYTES) != hipSuccess || per_cu < 1)
            fprintf(stderr, "kernel_launch: note: occupancy query reports %d workgroups per CU\n", per_cu);
        (void)hipGetLastError();
        grid = cus;
    }
    if (grid < 0) return;
    if (hipMemsetAsync((char*)d_ws + WS_CTL, 0, CTL_ZERO_BYTES, stream) != hipSuccess) return;
    Args a{};
    for (int i = 0; i < 14; ++i) a.in[i] = (const float*)d_in[i];
    a.out = (float*)d_out; a.ws = (unsigned char*)d_ws;
#if MK_PER_PHASE
    for (int p = 0; p < MK_LAST_PHASE; ++p) { a.ph_lo = p; a.ph_hi = p + 1; hipLaunchKernelGGL(trunk_fwd, dim3(grid), dim3(NWAVES * 64), LDS_BYTES, stream, a); }
#else
    a.ph_lo = 0; a.ph_hi = MK_LAST_PHASE;
    hipLaunchKernelGGL(trunk_fwd, dim3(grid), dim3(NWAVES * 64), LDS_BYTES, stream, a);
#endif
}
```

```cpp
#include <hip/hip_runtime.h>
#include <hip/hip_bf16.h>
#include <cstdio>
#include <cstdint>
#include <cmath>

#ifndef MK_PER_PHASE
#define MK_PER_PHASE 0
#endif
#ifndef MK_FFN0_DN_FP8
#define MK_FFN0_DN_FP8 1
#endif
#define MK_FFN0_DNF8 (MK_FFN0_FP8 || MK_FFN0_DN_FP8)
#ifndef MK_FFN0_FP8
#define MK_FFN0_FP8 0
#endif
#ifndef MK_LAST_PHASE
#define MK_LAST_PHASE 15
#endif

namespace pg8 {
#define PG8_LAS __attribute__((address_space(3)))
typedef unsigned short bf16_t;
typedef short bf16x8 __attribute__((ext_vector_type(8)));
typedef float f32x4 __attribute__((ext_vector_type(4)));
typedef unsigned u32x4 __attribute__((ext_vector_type(4)));
constexpr int BM = 256, BK = 64, HALF = 128, HTB = HALF * BK * 2, STAGE_BYTES = 8 * HTB, NXCD = 8, WGM = 8;

__host__ __device__ __forceinline__ int lds_byte(int r, int c) { const int st = (r >> 4) * 2 + (c >> 5), rr = r & 15, cc = c & 31, ob = rr * 64 + cc * 2; return st * 1024 + (ob ^ (((ob >> 9) & 1) << 5)); }
__host__ __device__ __forceinline__ void stage_rc(int b, int& R, int& C) { const int st = b / 1024, sb = b % 1024, swz = sb ^ (((sb >> 9) & 1) << 5); R = (st >> 1) * 16 + swz / 64; C = (st & 1) * 32 + (swz % 64) / 2; }
__host__ __device__ __forceinline__ int perm32(int rho) { const int n = rho >> 4, i = rho & 15; return 8 * (i >> 2) + 4 * n + (i & 3); }

struct Unit { int pm, pn; const char* A; const char* B; int arow; };
struct GemmK { int K, lda, ldb; };

__device__ __forceinline__ void tile_of(int wgid_in, int nM, int nN, int& pm, int& pn) {
    const int nwg = nM * nN; int wgid = wgid_in;
    { const int q = nwg / NXCD, r = nwg % NXCD, xcd = wgid % NXCD, off = wgid / NXCD; wgid = (xcd < r ? xcd * (q + 1) : r * (q + 1) + (xcd - r) * q) + off; }
    const int nig = WGM * nN, gid = wgid / nig, fm = gid * WGM, gsz = (nM - fm) < WGM ? (nM - fm) : WGM;
    pm = fm + ((wgid % nig) % gsz); pn = (wgid % nig) / gsz;
}
struct DenseOrder {
    int nM, nN, nwg, G, c; const char* A; const char* B; size_t a_tile, a_pn, b_tile;
    __device__ __forceinline__ bool next(int i, Unit& u) const {
        const int L = i * G + c; if (L >= nwg) return false;
        int pm, pn; tile_of(L, nM, nN, pm, pn);
        u.pm = pm; u.pn = pn; u.A = A + (size_t)pm * a_tile + (size_t)pn * a_pn; u.B = B + (size_t)pn * b_tile; u.arow = 0; return true;
    }
};
template <int NN, size_t A_TILE, int A_LOCAL, size_t B_EXP, size_t B_TILE, int PM_GLOBAL>
struct MoeOrder {
    int rt0, nM, G, c; const char* A; const char* B; const PG8_LAS unsigned* toff;
    __device__ __forceinline__ bool next(int i, Unit& u) const {
        const int L = i * G + c; if (L >= nM * NN) return false;
        int pm, pn; tile_of(L, nM, NN, pm, pn);
        const int rt = rt0 + pm; int e = 0;
#pragma unroll
        for (int j = 1; j < 8; ++j) e += ((unsigned)rt >= toff[j]) ? 1 : 0;
        e = __builtin_amdgcn_readfirstlane(e);
        u.pm = PM_GLOBAL ? rt : pm; u.pn = pn; u.A = A + (size_t)(A_LOCAL ? pm : rt) * A_TILE; u.B = B + (size_t)e * B_EXP + (size_t)pn * B_TILE; u.arow = __builtin_amdgcn_readfirstlane(e * 32768 + (rt - (int)toff[e]) * 256); return true;
    }
};

__device__ __forceinline__ unsigned cvt_pk_bf16(float lo, float hi) { unsigned r; asm volatile("v_cvt_pk_bf16_f32 %0, %1, %2" : "=v"(r) : "v"(lo), "v"(hi)); return r; }

struct EpiBf16 {
    static constexpr bool PERM = true;
    bf16_t* O; int ldc; const float* cscale; int split_cols; size_t split_stride; float scale0;
    __device__ __forceinline__ void operator()(const f32x4 (&acc)[2][2][4][2], const Unit& u, int wr, int wc, int fr, int fq) const {
        const int row0 = u.pm * BM + wr * 64 + fr; int colt = u.pn * BM; bf16_t* base = O;
        float sc = split_cols ? 1.f : scale0; if (split_cols) { const int t = colt / split_cols; base += (size_t)t * split_stride; colt -= t * split_cols; if (t == 0) sc = scale0; }
        const int col0 = colt + wc * 32 + 8 * fq, scol0 = u.pn * BM + wc * 32 + 8 * fq;
        f32x4 sv[2][2];
#pragma unroll
        for (int bj = 0; bj < 2; ++bj)
#pragma unroll
            for (int n = 0; n < 2; ++n) { sv[bj][n] = cscale ? *(const f32x4*)(cscale + scol0 + bj * HALF + 4 * n) : (f32x4){1.f, 1.f, 1.f, 1.f}; sv[bj][n] = sv[bj][n] * sc; }
#pragma unroll
        for (int ai = 0; ai < 2; ++ai)
#pragma unroll
            for (int m = 0; m < 4; ++m) { bf16_t* rowp = base + (size_t)(row0 + ai * HALF + m * 16) * ldc + col0;
#pragma unroll
                for (int bj = 0; bj < 2; ++bj) { const f32x4 v0 = acc[ai][bj][m][0] * sv[bj][0], v1 = acc[ai][bj][m][1] * sv[bj][1];
                    u32x4 w; w.x = cvt_pk_bf16(v0[0], v0[1]); w.y = cvt_pk_bf16(v0[2], v0[3]); w.z = cvt_pk_bf16(v1[0], v1[1]); w.w = cvt_pk_bf16(v1[2], v1[3]);
                    *(u32x4*)(rowp + bj * HALF) = w; } }
    }
};
struct EpiQKV {
    static constexpr bool PERM = true;
    bf16_t* O; int ldc; size_t split_stride; float scale0; float* maxq; float* maxk; float* kbar;
    __device__ __forceinline__ void operator()(const f32x4 (&acc)[2][2][4][2], const Unit& u, int wr, int wc, int fr, int fq) const {
        const int row0 = u.pm * BM + wr * 64 + fr; int colt = u.pn * BM; const int t = colt >> 10; bf16_t* base = O + (size_t)t * split_stride; colt -= t << 10;
        const float sc = (t == 0) ? scale0 : 1.f;
        const int col0 = colt + wc * 32 + 8 * fq;
        float nm0 = 0.f, nm1 = 0.f;
#pragma unroll
        for (int ai = 0; ai < 2; ++ai)
#pragma unroll
            for (int m = 0; m < 4; ++m) { bf16_t* rowp = base + (size_t)(row0 + ai * HALF + m * 16) * ldc + col0;
#pragma unroll
                for (int bj = 0; bj < 2; ++bj) { const f32x4 v0 = acc[ai][bj][m][0] * sc, v1 = acc[ai][bj][m][1] * sc;
                    u32x4 w; w.x = cvt_pk_bf16(v0[0], v0[1]); w.y = cvt_pk_bf16(v0[2], v0[3]); w.z = cvt_pk_bf16(v1[0], v1[1]); w.w = cvt_pk_bf16(v1[2], v1[3]);
                    *(u32x4*)(rowp + bj * HALF) = w;
                    if (t < 2) { float s = (v0[0] * v0[0] + v0[1] * v0[1]) + (v0[2] * v0[2] + v0[3] * v0[3]) + (v1[0] * v1[0] + v1[1] * v1[1]) + (v1[2] * v1[2] + v1[3] * v1[3]);
                        s += __shfl_xor(s, 16); s += __shfl_xor(s, 32); if (bj == 0) nm0 = fmaxf(nm0, s); else nm1 = fmaxf(nm1, s); } } }
        if (t < 2) {
#pragma unroll
            for (int o = 1; o < 16; o <<= 1) { nm0 = fmaxf(nm0, __shfl_xor(nm0, o)); nm1 = fmaxf(nm1, __shfl_xor(nm1, o)); }
            if ((threadIdx.x & 63) == 0) { float* dst = (t == 0 ? maxq : maxk) + (size_t)(u.pm * 2 + wr) * 32 + (4 * (u.pn & 3) + (wc >> 1)) * 2 + (wc & 1);
                dst[0] = sqrtf(nm0); dst[4] = sqrtf(nm1); }
        }
        if (t == 1) {
            const int ln = threadIdx.x & 63;
#pragma unroll
            for (int ai = 0; ai < 2; ++ai)
#pragma unroll
                for (int bj = 0; bj < 2; ++bj) {
                    float c[8];
#pragma unroll
                    for (int e = 0; e < 4; ++e) { c[e] = (acc[ai][bj][0][0][e] + acc[ai][bj][1][0][e]) + (acc[ai][bj][2][0][e] + acc[ai][bj][3][0][e]);
                                                  c[4 + e] = (acc[ai][bj][0][1][e] + acc[ai][bj][1][1][e]) + (acc[ai][bj][2][1][e] + acc[ai][bj][3][1][e]); }
                    { const bool up = (ln & 8) != 0;
#pragma unroll
                      for (int i = 0; i < 4; ++i) { const float send = up ? c[i] : c[i + 4], keep = up ? c[i + 4] : c[i]; c[i] = keep + __shfl_xor(send, 8); } }
                    { const bool up = (ln & 4) != 0;
#pragma unroll
                      for (int i = 0; i < 2; ++i) { const float send = up ? c[i] : c[i + 2], keep = up ? c[i + 2] : c[i]; c[i] = keep + __shfl_xor(send, 4); } }
                    { const bool up = (ln & 2) != 0; const float send = up ? c[0] : c[1], keep = up ? c[1] : c[0]; c[0] = keep + __shfl_xor(send, 2); }
                    float cs = c[0]; cs += __shfl_xor(cs, 1);
                    float q2 = cs * cs;
#pragma unroll
                    for (int o = 1; o < 64; o <<= 1) q2 += __shfl_xor(q2, o);
                    if (ln == 0) kbar[((size_t)(u.pm * 4 + wr + 2 * ai) * 16 + (4 * (u.pn & 3) + (wc >> 1) + 2 * bj)) * 2 + (wc & 1)] = q2 * (0.5f / 4096.f);
                }
        }
    }
};
__device__ __forceinline__ float silu_mul(float g, float u) { const float e = __builtin_amdgcn_exp2f(g * -1.4426950408889634f); return g * __builtin_amdgcn_rcpf(1.0f + e) * u; }
struct EpiSwiGLU {
    static constexpr bool PERM = true;
    bf16_t* O; int ldc;
    __device__ __forceinline__ void operator()(const f32x4 (&acc)[2][2][4][2], const Unit& u, int wr, int wc, int fr, int fq) const {
        const int row0 = u.pm * BM + wr * 64 + fr, col0 = u.pn * HALF + wc * 32 + 8 * fq;
#pragma unroll
        for (int ai = 0; ai < 2; ++ai)
#pragma unroll
            for (int m = 0; m < 4; ++m) { bf16_t* rowp = O + (size_t)(row0 + ai * HALF + m * 16) * ldc + col0;
                const f32x4 g0 = acc[ai][0][m][0], g1 = acc[ai][0][m][1], u0 = acc[ai][1][m][0], u1 = acc[ai][1][m][1];
                u32x4 w; w.x = cvt_pk_bf16(silu_mul(g0[0], u0[0]), silu_mul(g0[1], u0[1])); w.y = cvt_pk_bf16(silu_mul(g0[2], u0[2]), silu_mul(g0[3], u0[3]));
                w.z = cvt_pk_bf16(silu_mul(g1[0], u1[0]), silu_mul(g1[1], u1[1])); w.w = cvt_pk_bf16(silu_mul(g1[2], u1[2]), silu_mul(g1[3], u1[3]));
                *(u32x4*)rowp = w; }
    }
};

__device__ __forceinline__ unsigned pk4_fp8(float a, float b, float c, float d) { int w = 0; w = __builtin_amdgcn_cvt_pk_fp8_f32(a, b, w, false); w = __builtin_amdgcn_cvt_pk_fp8_f32(c, d, w, true); return (unsigned)w; }
template <int INV_ASCALE>
struct EpiSwiGLU8 {
    static constexpr bool PERM = true;
    static constexpr float ascale = 1.0f / (float)INV_ASCALE;
    unsigned char* O; int ldc;
    __device__ __forceinline__ void operator()(const f32x4 (&acc)[2][2][4][2], const Unit& u, int wr, int wc, int fr, int fq) const {
        const int row0 = u.pm * BM + wr * 64 + fr, col0 = u.pn * HALF + wc * 32 + 8 * fq;
        unsigned char* Ob = O; asm volatile("" : "+s"(Ob));
#pragma unroll
        for (int ai = 0; ai < 2; ++ai)
#pragma unroll
            for (int m = 0; m < 4; ++m) { unsigned char* rowp = Ob + (size_t)(row0 + ai * HALF + m * 16) * ldc + col0;
                const f32x4 g0 = acc[ai][0][m][0], g1 = acc[ai][0][m][1], u0 = acc[ai][1][m][0], u1 = acc[ai][1][m][1];
                constexpr float c1 = -1.4426950408889634f * ascale, ia2 = 1.0f / (ascale * ascale);
#define SM8(G, U) (((G) * (U)) * __builtin_amdgcn_rcpf(__builtin_fmaf(__builtin_amdgcn_exp2f((G) * c1), ia2, ia2)))
                typedef unsigned u32x2 __attribute__((ext_vector_type(2)));
                u32x2 w; w.x = pk4_fp8(SM8(g0[0], u0[0]), SM8(g0[1], u0[1]), SM8(g0[2], u0[2]), SM8(g0[3], u0[3]));
                w.y = pk4_fp8(SM8(g1[0], u1[0]), SM8(g1[1], u1[1]), SM8(g1[2], u1[2]), SM8(g1[3], u1[3]));
#undef SM8
                *(__attribute__((address_space(1))) u32x2*)rowp = w; }
    }
};

struct EpiFp8 {
    static constexpr bool PERM = true;
    unsigned char* O; int ldc; float scale;
    __device__ __forceinline__ void operator()(const f32x4 (&acc)[2][2][4][2], const Unit& u, int wr, int wc, int fr, int fq) const {
        const int row0 = u.pm * BM + wr * 64 + fr, col0 = u.pn * BM + wc * 32 + 8 * fq;
        typedef unsigned u32x2 __attribute__((ext_vector_type(2)));
#pragma unroll
        for (int ai = 0; ai < 2; ++ai)
#pragma unroll
            for (int m = 0; m < 4; ++m) { unsigned char* rowp = O + (size_t)(row0 + ai * HALF + m * 16) * ldc + col0;
#pragma unroll
                for (int bj = 0; bj < 2; ++bj) { const f32x4 v0 = acc[ai][bj][m][0] * scale, v1 = acc[ai][bj][m][1] * scale;
                    u32x2 w; w.x = pk4_fp8(v0[0], v0[1], v0[2], v0[3]); w.y = pk4_fp8(v1[0], v1[1], v1[2], v1[3]); *(u32x2*)(rowp + bj * HALF) = w; } }
    }
};

typedef int v4i_t __attribute__((ext_vector_type(4)));
typedef int v8i_t __attribute__((ext_vector_type(8)));
__device__ __forceinline__ v8i_t cat8(bf16x8 lo, bf16x8 hi) { const v4i_t a = __builtin_bit_cast(v4i_t, lo), b = __builtin_bit_cast(v4i_t, hi); return __builtin_shufflevector(a, b, 0, 1, 2, 3, 4, 5, 6, 7); }
constexpr int GATHER_IDX_OFF = 133120;
template <class Epi, class Sched, bool ALIGN_EPI, bool F8 = false, bool GATHER = false>
__device__ __forceinline__ void gemm_phase(PG8_LAS unsigned char* lds, const GemmK g, const Sched& S, const Epi& E, const long ridx_delta = 0) {
    int tid_ = threadIdx.x; asm volatile("" : "+v"(tid_));
    const int tid = tid_, wid = __builtin_amdgcn_readfirstlane(tid >> 6), lane = tid & 63, wr = wid >> 2, wc = wid & 3, fr = lane & 15, fq = lane >> 4;
    const int K = g.K, nt = K / BK;
    unsigned voffA[2], voffB[2];
#pragma unroll
    for (int i = 0; i < 2; ++i) { int R, C; stage_rc(tid * 16 + i * 8192, R, C); const int Rb = Epi::PERM ? ((R & ~31) + perm32(R & 31)) : R;
        voffA[i] = (unsigned)(R * g.lda + C) * 2u; voffB[i] = (unsigned)(Rb * g.ldb + C) * 2u; }
    const size_t kstep = (size_t)(BK * 2);
    const size_t hstepA = (size_t)HALF * g.lda * 2, hstepB = (size_t)HALF * g.ldb * 2;
    const unsigned ldsw = (unsigned)wid * 1024u;
    const unsigned ldswb = (unsigned)__builtin_amdgcn_readfirstlane((int)(unsigned)(uintptr_t)lds) + ldsw;
    const int aoff = lds_byte(wr * 64 + fr, fq * 8), boff = lds_byte(wc * 32 + fr, fq * 8);
#define PG8_SA(b, h) (((b) * 2 + (h)) * HTB)
#define PG8_SB(b, h) ((4 + (b) * 2 + (h)) * HTB)
#define PG8_STAGE1(bufoff, gbase, voff, I_) do { unsigned keep_; \
        asm volatile("s_mov_b32 %0, m0\n\ts_add_u32 m0, %3, %4\n\ts_nop 2\n\tglobal_load_lds_dwordx4 %1, %2\n\ts_mov_b32 m0, %0" \
            : "=&s"(keep_) : "v"((voff)[I_]), "s"((const char*)(gbase)), "s"(ldswb), "i"((bufoff) + (I_) * 8192) : "memory", "scc"); } while (0)
#define PG8_STAGE(bufoff, gbase, voff) do { PG8_STAGE1(bufoff, gbase, voff, 0); PG8_STAGE1(bufoff, gbase, voff, 1); } while (0)
    unsigned pkA[2] = {0u, 0u};
#define PG8_GVOFF(tv_, SH) do { _Pragma("unroll") for (int i_ = 0; i_ < 2; ++i_) tv_[i_] = ((pkA[i_] >> (SH)) & 0xffffu) * (unsigned)(g.lda * 2) + (voffB[i_] & (unsigned)(g.ldb * 2 - 1)); } while (0)
#define PG8_STA0(bufoff, gbase) do { if constexpr (GATHER) { unsigned tv_[2]; PG8_GVOFF(tv_, 0); PG8_STAGE(bufoff, gbase, tv_); } else PG8_STAGE(bufoff, gbase, voffA); } while (0)
#define PG8_STA1(bufoff, gbase) do { if constexpr (GATHER) { unsigned tv_[2]; PG8_GVOFF(tv_, 16); PG8_STAGE(bufoff, gbase, tv_); } else PG8_STAGE(bufoff, (gbase) + hstepA, voffA); } while (0)
#define PG8_GATHER_SET(SRC) do { int tg_ = threadIdx.x; asm volatile("" : "+v"(tg_)); _Pragma("unroll") for (int i = 0; i < 2; ++i) { int R, C; stage_rc(tg_ * 16 + i * 8192, R, C); \
        const unsigned r0_ = (SRC)[R], r1_ = (SRC)[128 + R]; pkA[i] = (r0_ & 0xffffu) | (r1_ << 16); } } while (0)
#define PG8_LDA(dst, b, h) do { _Pragma("unroll") for (int m = 0; m < 4; ++m) _Pragma("unroll") for (int k = 0; k < 2; ++k) dst[m][k] = *(const PG8_LAS bf16x8*)(lds + PG8_SA(b, h) + aoff + m * 2048 + k * 1024); } while (0)
#define PG8_LDB(dst, b, h) do { _Pragma("unroll") for (int n = 0; n < 2; ++n) _Pragma("unroll") for (int k = 0; k < 2; ++k) dst[n][k] = *(const PG8_LAS bf16x8*)(lds + PG8_SB(b, h) + boff + n * 2048 + k * 1024); } while (0)
#define PG8_MMA(ai, bj, At, Bt) do { __builtin_amdgcn_s_setprio(1); if constexpr (F8) { _Pragma("unroll") for (int m = 0; m < 4; ++m) _Pragma("unroll") for (int n = 0; n < 2; ++n) \
        acc[ai][bj][m][n] = __builtin_amdgcn_mfma_scale_f32_16x16x128_f8f6f4(cat8(Bt[n][0], Bt[n][1]), cat8(At[m][0], At[m][1]), acc[ai][bj][m][n], 0, 0, 0, 0, 0, 0); } \
        else { _Pragma("unroll") for (int m = 0; m < 4; ++m) _Pragma("unroll") for (int n = 0; n < 2; ++n) _Pragma("unroll") for (int k = 0; k < 2; ++k) \
        acc[ai][bj][m][n] = __builtin_amdgcn_mfma_f32_16x16x32_bf16(Bt[n][k], At[m][k], acc[ai][bj][m][n], 0, 0, 0); } __builtin_amdgcn_s_setprio(0); } while (0)
#define PG8_WAIT_V(n) asm volatile("s_waitcnt vmcnt(" #n ")" ::: "memory")
#define PG8_WAIT_L(n) asm volatile("s_waitcnt lgkmcnt(" #n ")" ::: "memory")
#define PG8_BAR __builtin_amdgcn_s_barrier()
#define PG8_SCHED __builtin_amdgcn_sched_barrier(0)
    Unit cur, nxt; int ui = 0;
    if (!S.next(0, cur)) return;
    f32x4 acc[2][2][4][2];
#define PG8_ZERO_ACC() do { _Pragma("unroll") for (int a = 0; a < 2; ++a) _Pragma("unroll") for (int b = 0; b < 2; ++b) _Pragma("unroll") for (int m = 0; m < 4; ++m) _Pragma("unroll") for (int n = 0; n < 2; ++n) { \
        f32x2z lo_, hi_; asm volatile("v_mov_b64 %0, 0" : "=v"(lo_)); asm volatile("v_mov_b64 %0, 0" : "=v"(hi_)); acc[a][b][m][n] = (f32x4){lo_[0], lo_[1], hi_[0], hi_[1]}; } } while (0)
    typedef float f32x2z __attribute__((ext_vector_type(2)));
    PG8_ZERO_ACC();
    bf16x8 At[4][2], B0[2][2], B1[2][2];
    const char* cA = cur.A; const char* cB = cur.B;
    if constexpr (GATHER) { const unsigned* src_ = (const unsigned*)(cA + ridx_delta) + cur.arow; PG8_GATHER_SET(src_); }
    PG8_STAGE(PG8_SB(0, 0), cB, voffB); PG8_STAGE(PG8_SB(0, 1), cB + hstepB, voffB); PG8_STA0(PG8_SA(0, 0), cA); PG8_STA1(PG8_SA(0, 1), cA);
    if (wr == 1) PG8_BAR;
    PG8_WAIT_V(2); PG8_BAR;
    PG8_STAGE(PG8_SB(1, 0), cB + kstep, voffB); PG8_STA0(PG8_SA(1, 0), cA + kstep); PG8_STAGE(PG8_SB(1, 1), cB + hstepB + kstep, voffB);
    PG8_WAIT_V(6); PG8_BAR;
    for (;;) {
        const bool has_next = S.next(ui + 1, nxt);
        const char* nA = has_next ? nxt.A : cA; const char* nB = has_next ? nxt.B : cB;
        if constexpr (GATHER) { if (has_next && wid < 4) { unsigned keep_; int tl_ = threadIdx.x; asm volatile("" : "+v"(tl_)); const unsigned vo_ = (unsigned)tl_ * 4u;
            asm volatile("s_mov_b32 %0, m0\n\ts_mov_b32 m0, %3\n\ts_nop 2\n\tglobal_load_lds_dword %1, %2\n\ts_mov_b32 m0, %0"
                : "=&s"(keep_) : "v"(vo_), "s"((const char*)((const unsigned*)(nA + ridx_delta) + nxt.arow)), "s"(ldswb - (unsigned)wid * 768u + (unsigned)GATHER_IDX_OFF) : "memory"); } }
#pragma unroll 1
        for (int t = 0; t < nt; t += 2) {
            const bool last = (t == nt - 2);
            const char* a1 = cA + (size_t)(t + 1) * kstep;
            const char* a2 = last ? nA : cA + (size_t)(t + 2) * kstep; const char* b2 = last ? nB : cB + (size_t)(t + 2) * kstep;
            const char* a3 = a2 + kstep; const char* b3 = b2 + kstep;
            PG8_LDB(B0, 0, 0); PG8_LDB(B1, 0, 1); PG8_SCHED; PG8_LDA(At, 0, 0); PG8_STA1(PG8_SA(1, 1), a1);
            PG8_WAIT_V(8); PG8_WAIT_L(0); PG8_BAR; PG8_MMA(0, 0, At, B0); PG8_MMA(0, 1, At, B1); PG8_BAR; PG8_SCHED;
            if constexpr (GATHER) { if (last) { const PG8_LAS unsigned* li_ = (const PG8_LAS unsigned*)(lds + GATHER_IDX_OFF); PG8_GATHER_SET(li_); } }
            PG8_LDA(At, 0, 1); PG8_STAGE(PG8_SB(0, 0), b2, voffB); PG8_STAGE(PG8_SB(0, 1), b2 + hstepB, voffB); PG8_STA0(PG8_SA(0, 0), a2);
            PG8_WAIT_V(8); PG8_WAIT_L(0); PG8_BAR; PG8_MMA(1, 0, At, B0); PG8_MMA(1, 1, At, B1); PG8_BAR; PG8_SCHED;
            PG8_LDB(B0, 1, 0); PG8_LDB(B1, 1, 1); PG8_SCHED; PG8_LDA(At, 1, 0); PG8_STA1(PG8_SA(0, 1), a2);
            PG8_WAIT_V(8); PG8_WAIT_L(0); PG8_BAR; PG8_MMA(0, 0, At, B0); PG8_MMA(0, 1, At, B1); PG8_BAR; PG8_SCHED;
            PG8_LDA(At, 1, 1); PG8_STAGE(PG8_SB(1, 0), b3, voffB); PG8_STAGE(PG8_SB(1, 1), b3 + hstepB, voffB); PG8_STA0(PG8_SA(1, 0), a3);
            PG8_WAIT_V(8); PG8_WAIT_L(0); PG8_BAR; PG8_MMA(1, 0, At, B0); PG8_MMA(1, 1, At, B1); PG8_BAR; PG8_SCHED;
        }
        if constexpr (ALIGN_EPI) { if (wr == 0) PG8_BAR; }
        { int te_ = threadIdx.x; asm volatile("" : "+v"(te_));
          E(acc, cur, wr, wc, te_ & 15, (te_ >> 4) & 3); }
        if (!has_next) break;
        PG8_ZERO_ACC();
        cur = nxt; cA = nA; cB = nB; ++ui;
        if constexpr (ALIGN_EPI) { if (wr == 1) PG8_BAR; }
    }
    PG8_WAIT_V(0);
    if constexpr (!ALIGN_EPI) { if (wr == 0) PG8_BAR; }
    PG8_BAR;
#undef PG8_SA
#undef PG8_SB
#undef PG8_STAGE
#undef PG8_STAGE1
#undef PG8_STA0
#undef PG8_STA1
#undef PG8_GATHER_SET
#undef PG8_GVOFF
#undef PG8_LDA
#undef PG8_LDB
#undef PG8_MMA
#undef PG8_ZERO_ACC
#undef PG8_WAIT_V
#undef PG8_WAIT_L
#undef PG8_BAR
#undef PG8_SCHED
}
}

namespace attn_body {
using bf16=__hip_bfloat16;
using bf16x8=__attribute__((ext_vector_type(8)))short;
using s16x4=__attribute__((ext_vector_type(4)))short;
using f32x16=__attribute__((ext_vector_type(16)))float;
using f32x4v=__attribute__((ext_vector_type(4)))float;
using u32x4=__attribute__((ext_vector_type(4)))unsigned;
constexpr int BATCH=4,NHEAD=16,SEQ=8192,D=64,DM=NHEAD*D;
constexpr int NW=8,QBLK=32,QB=QBLK*NW,KVBLK=64,NQB=SEQ/QB;
__device__ __forceinline__ int crow(int r,int hi){return (r&3)+8*(r>>2)+4*hi;}
#define SBAR() __builtin_amdgcn_sched_barrier(0)
__device__ __forceinline__ void cmask(f32x16&p0,f32x16&p1,int jb,int qrel,int hi){
  const float NEG=-INFINITY; int kb=64*jb+4*hi;
  #pragma unroll
  for(int r=0;r<16;++r){int kv=kb+(r&3)+8*(r>>2); if(kv>qrel)p0[r]=NEG; if(kv+32>qrel)p1[r]=NEG;}
}
constexpr int NSLOT=3, SLOTB=8192;
constexpr int LDS_K=0, LDS_V=NSLOT*SLOTB, LDS_WS=2*NSLOT*SLOTB, LDS_OST=LDS_WS+NW*64*4, LDS_CS=LDS_OST+NW*4096, LDS_BYTES=LDS_CS+SEQ*4;
constexpr float C2=0.125f*1.4426950408889634f;
__device__ __forceinline__ void glds16(const void*gsrc,unsigned lds_dst){unsigned keep;
  asm volatile("s_mov_b32 %0, m0\n\ts_mov_b32 m0, %2\n\ts_nop 0\n\tglobal_load_lds_dwordx4 %1, off\n\ts_mov_b32 m0, %0":"=&s"(keep):"v"(gsrc),"s"(lds_dst):"memory");}
__device__ __forceinline__ float max3f(float a,float b,float c){float r;asm("v_max3_f32 %0, %1, %2, %3":"=v"(r):"v"(a),"v"(b),"v"(c));return r;}
__device__ __forceinline__ float max2f(float a,float b){float r;asm("v_max_f32_e32 %0, %1, %2":"=v"(r):"v"(a),"v"(b));return r;}
__device__ __forceinline__ float fadd_s(float a,float b){float r;asm("v_add_f32_e32 %0, %1, %2":"=v"(r):"v"(a),"v"(b));return r;}
__device__ __forceinline__ float fsub_s(float a,float b){float r;asm("v_sub_f32_e32 %0, %1, %2":"=v"(r):"v"(a),"v"(b));return r;}
typedef float f32x2_t __attribute__((ext_vector_type(2))); typedef __bf16 bf16x2_t __attribute__((ext_vector_type(2)));
__device__ __forceinline__ unsigned cvtpk_s(float lo,float hi){f32x2_t v={lo,hi};bf16x2_t b=__builtin_convertvector(v,bf16x2_t);return __builtin_bit_cast(unsigned,b);}
#define WAIT_BAR(N) asm volatile("s_waitcnt vmcnt(" #N ") lgkmcnt(0)\n\ts_barrier":::"memory")
typedef __attribute__((address_space(3))) const char* lds_cptr;
typedef short v4i16_t __attribute__((ext_vector_type(4)));
__device__ __forceinline__ void ldbias(f32x16&c0,f32x16&c1,lds_cptr csp,float negm){
  #pragma unroll
  for(int g=0;g<4;++g){ const f32x4v a=*(const __attribute__((address_space(3))) f32x4v*)(csp+g*32); const f32x4v b=*(const __attribute__((address_space(3))) f32x4v*)(csp+128+g*32);
    c0[4*g]=a[0]+negm;c0[4*g+1]=a[1]+negm;c0[4*g+2]=a[2]+negm;c0[4*g+3]=a[3]+negm; c1[4*g]=b[0]+negm;c1[4*g+1]=b[1]+negm;c1[4*g+2]=b[2]+negm;c1[4*g+3]=b[3]+negm; }
}
__device__ __forceinline__ void qkt(f32x16&p0,f32x16&p1,const char*Kslot,const bf16x8*qr,int r32,int hi){
  const char*kb=Kslot+hi*1024+r32*16;
  #pragma unroll
  for(int d0=0;d0<4;++d0){
    const bf16x8 b0=*reinterpret_cast<const bf16x8*>(kb+d0*2048);
    const bf16x8 b1=*reinterpret_cast<const bf16x8*>(kb+d0*2048+512);
    p0=__builtin_amdgcn_mfma_f32_32x32x16_bf16(b0,qr[d0],p0,0,0,0);p1=__builtin_amdgcn_mfma_f32_32x32x16_bf16(b1,qr[d0],p1,0,0,0);}
}
__device__ __forceinline__ void kload8(bf16x8*kf,lds_cptr kp){
  kf[0]=*(const __attribute__((address_space(3))) bf16x8*)(kp);      kf[1]=*(const __attribute__((address_space(3))) bf16x8*)(kp+512);
  kf[2]=*(const __attribute__((address_space(3))) bf16x8*)(kp+2048); kf[3]=*(const __attribute__((address_space(3))) bf16x8*)(kp+2560);
  kf[4]=*(const __attribute__((address_space(3))) bf16x8*)(kp+4096); kf[5]=*(const __attribute__((address_space(3))) bf16x8*)(kp+4608);
  kf[6]=*(const __attribute__((address_space(3))) bf16x8*)(kp+6144); kf[7]=*(const __attribute__((address_space(3))) bf16x8*)(kp+6656);
}
__device__ __forceinline__ void kload2(bf16x8*kf,lds_cptr kp,int j){ kf[2*j]=*(const __attribute__((address_space(3))) bf16x8*)(kp+j*2048); kf[2*j+1]=*(const __attribute__((address_space(3))) bf16x8*)(kp+j*2048+512); }
__device__ __forceinline__ s16x4 vtr(lds_cptr p){ return __builtin_bit_cast(s16x4,__builtin_amdgcn_ds_read_tr16_b64_v4i16((__attribute__((address_space(3))) v4i16_t*)p)); }
__device__ __forceinline__ float rowmax(const f32x16&p0,const f32x16&p1){
  float a=max3f(p0[0],p0[1],p1[0]),b=max3f(p0[2],p0[3],p1[1]);a=max3f(a,p1[2],p1[3]);
  #pragma unroll
  for(int r=4;r<16;r+=4){a=max3f(a,p0[r],p0[r+1]);b=max3f(b,p0[r+2],p0[r+3]);a=max3f(a,p1[r],p1[r+1]);b=max3f(b,p1[r+2],p1[r+3]);}
  const float m=max2f(a,b);
  auto rr=__builtin_amdgcn_permlane32_swap(__float_as_uint(m),__float_as_uint(m),false,false);
  return max2f(__uint_as_float(rr[0]),__uint_as_float(rr[1]));
}
__device__ __forceinline__ void pv(f32x16*o,int vb,bf16x8 pa0,bf16x8 pa1,bf16x8 pa2,bf16x8 pa3){
  #pragma unroll
  for(int d0=0;d0<2;++d0){s16x4 lo[4],hi[4];
    #pragma unroll
    for(int ks=0;ks<4;++ks){
      asm volatile("ds_read_b64_tr_b16 %0,%1 offset:%c2":"=&v"(lo[ks]):"v"(vb),"i"(d0*4096+ks*1024):"memory");
      asm volatile("ds_read_b64_tr_b16 %0,%1 offset:%c2":"=&v"(hi[ks]):"v"(vb),"i"(d0*4096+ks*1024+512):"memory");}
    asm volatile("s_waitcnt lgkmcnt(0)":::"memory");SBAR();
    #define PK(k) (bf16x8){lo[k][0],lo[k][1],lo[k][2],lo[k][3],hi[k][0],hi[k][1],hi[k][2],hi[k][3]}
    o[d0]=__builtin_amdgcn_mfma_f32_32x32x16_bf16(pa0,PK(0),o[d0],0,0,0);
    o[d0]=__builtin_amdgcn_mfma_f32_32x32x16_bf16(pa1,PK(1),o[d0],0,0,0);
    o[d0]=__builtin_amdgcn_mfma_f32_32x32x16_bf16(pa2,PK(2),o[d0],0,0,0);
    o[d0]=__builtin_amdgcn_mfma_f32_32x32x16_bf16(pa3,PK(3),o[d0],0,0,0);
    #undef PK
  }
}
#define ATTN_STORE16(p,v) (*(u32x4*)(p)=(v))
template<int THRL> __device__ __forceinline__ void attn_unit(int b,int h,int qb,int tstart,const bf16*Q,const bf16*__restrict__ K,const bf16*__restrict__ V,bf16*O,const float*NCS,const float*QOFF,char*shm){
  int tid_=threadIdx.x; asm volatile("":"+v"(tid_));
  const int tid=tid_,lane=tid&63,r32=lane&31,hi=lane>>5; const int wid=__builtin_amdgcn_readfirstlane(tid>>6);
  const long rowbase=(long)b*SEQ; const int q0=qb*QB;
  const bf16*Qw=Q+(rowbase+q0+wid*QBLK)*DM+h*D;
  const bf16*Kh=K+(rowbase+(long)tstart*KVBLK)*DM+h*D,*Vh=V+(rowbase+(long)tstart*KVBLK)*DM+h*D;
  const unsigned lds0=(unsigned)(uintptr_t)shm;
  float*wsf=(float*)(shm+LDS_WS)+wid*64;
  const lds_cptr shm3=(lds_cptr)shm;
  { const float*ncs=NCS+(size_t)(b*NHEAD+h)*SEQ+tstart*KVBLK; const int n4=(q0+QB-tstart*KVBLK)>>2;
    const float o1=QOFF[0],o2=o1+QOFF[1],o3=o2+QOFF[2];
    for(int i=tid;i<n4;i+=NW*64){ f32x4v v=*(const f32x4v*)(ncs+4*i); const int qn=(tstart*KVBLK+4*i)>>11; const float of=qn==0?0.f:(qn==1?o1:(qn==2?o2:o3)); v=v+of;
      *(__attribute__((address_space(3))) f32x4v*)((__attribute__((address_space(3))) char*)shm3+LDS_CS+16*i)=v; } }
  const bf16*ksrc=Kh+(long)lane*DM+wid*8;
  const bf16*vsrc=Vh+(long)(16*(wid&3)+(lane>>2))*DM+(wid>>2)*32+(lane&3)*8;
  const unsigned kdst=lds0+LDS_K+wid*1024, vdst=lds0+LDS_V+wid*1024;
  #define DMA_K(t,slot) glds16(ksrc+(long)(t)*KVBLK*DM,(unsigned)__builtin_amdgcn_readfirstlane(kdst+(slot)))
  #define DMA_V(t,slot) glds16(vsrc+(long)(t)*KVBLK*DM,(unsigned)__builtin_amdgcn_readfirstlane(vdst+(slot)))
  const int vb0=(int)(lds0+LDS_V)+((lane>>4)&1)*32+(lane&3)*8+(4*hi+((lane&15)>>2))*64;
  const char*Kbase=shm+LDS_K; bf16x8 kf[8];
  const lds_cptr kp0=shm3+LDS_K+hi*1024+r32*16; const lds_cptr vp0=shm3+LDS_V+((lane>>4)&1)*32+(lane&3)*8+(4*hi+((lane&15)>>2))*64;
  const lds_cptr csp0=shm3+LDS_CS+hi*16;
  const int NT=(q0+QB)/KVBLK-tstart;
  DMA_K(0,0);DMA_V(0,0);DMA_K(1,SLOTB);
  bf16x8 qr[4];
  #pragma unroll
  for(int d0=0;d0<4;++d0)qr[d0]=*reinterpret_cast<const bf16x8*>(&Qw[(long)r32*DM+d0*16+hi*8]);
  float mhat=0.f,l_reg=0.f,negm1=0.f;f32x16 o[2];o[0]=f32x16{};o[1]=f32x16{};
  const int qrel=wid*QBLK+r32;
  #define CMASK(P0,P1,t) do{int jb_=(t)-(NT-4); if(jb_>=0)cmask(P0,P1,jb_,qrel,hi);}while(0)
  bool resc=false;
  #define START(P0,P1) do{ const float rm=rowmax(P0,P1); resc=false; \
    { const float dl=rm; mhat=fadd_s(mhat,dl); \
      _Pragma("unroll") for(int r=0;r<16;++r){P0[r]=fsub_s(P0[r],dl);P1[r]=fsub_s(P1[r],dl);} \
      negm1=-mhat; } \
    _Pragma("unroll") for(int r=0;r<16;++r)P0[r]=__builtin_amdgcn_exp2f(P0[r]); }while(0)
  #define RESC() do{ if(resc){ asm volatile("s_waitcnt lgkmcnt(0)":::"memory"); \
      _Pragma("unroll") for(int d_=0;d_<2;++d_) _Pragma("unroll") for(int r=0;r<16;++r)o[d_][r]*=wsf[crow(r,hi)]; } }while(0)
  f32x16 pA0,pA1,pB0,pB1;
  int sl_prev=0,sl_cur=0,sl_next=SLOTB;
  #define ROT() do{sl_prev=sl_cur;sl_cur=sl_next;sl_next=(sl_next==(NSLOT-1)*SLOTB)?0:sl_next+SLOTB;}while(0)
  DMA_K(2,2*SLOTB);
  WAIT_BAR(3);
  ldbias(pA0,pA1,csp0,0.f);
  qkt(pA0,pA1,Kbase,qr,r32,hi);asm volatile("s_nop 15\n\ts_nop 7":"+v"(pA0),"+v"(pA1));CMASK(pA0,pA1,0);
  START(pA0,pA1);
  _Pragma("unroll") for(int r=0;r<16;++r)pA1[r]=__builtin_amdgcn_exp2f(pA1[r]);
  WAIT_BAR(0);
  DMA_K(3,0);DMA_V(1,SLOTB);
  ROT();
  kload8(kf,kp0+sl_cur);
  WAIT_BAR(2);
  s16x4 vlo[8],vhi[8]; u32x4 pw0,pw1,pw2,pw3;
  #define PKW(P,B) cvtpk_s(P[B],P[B+1])
  #define PAF(k) __builtin_bit_cast(bf16x8,pw##k)
  #define VFR(i) (bf16x8){vlo[i][0],vlo[i][1],vlo[i][2],vlo[i][3],vhi[i][0],vhi[i][1],vhi[i][2],vhi[i][3]}
  #define PIN(x) asm volatile("":"+v"(x))
  #define MX3(a,b,c) __builtin_fmaxf(__builtin_fmaxf((a),(b)),(c))
  #define GAPA(MF,A0,A1,A2,A3,W0,W1,PW) do{ MF; sacc+=A0; sacc+=A1; sacc+=A2; sacc+=A3; PIN(sacc); W0; W1; PIN(PW); SBAR(); }while(0)
  #define EX(v) __builtin_amdgcn_exp2f(v)
  #define GAPB(MF,X,B) do{ MF; X[B]=EX(X[B]); X[B+1]=EX(X[B+1]); X[B+2]=EX(X[B+2]); X[B+3]=EX(X[B+3]); PIN(X); SBAR(); }while(0)
  #define VRD(i) do{ vlo[i]=vtr(vp_+(((i)>>2)*4096+((i)&3)*1024)); vhi[i]=vtr(vp_+(((i)>>2)*4096+((i)&3)*1024+512)); }while(0)
  #define KRD(G,j) do{ if(G){ kload2(kf,kp0+sl_next,j); SBAR(); } }while(0)
  #define STEP(C0,C1,P0,P1,t,GK,GV,GL) do{ SBAR(); \
    const lds_cptr vp_=vp0+sl_prev; \
    ldbias(C0,C1,csp0+(t)*256,negm1); PIN(C0); PIN(C1); SBAR(); \
    VRD(0); SBAR(); float sacc=(P0[0]+P0[1]); \
    GAPA(C0=__builtin_amdgcn_mfma_f32_32x32x16_bf16(kf[0],qr[0],C0,0,0,0), P0[2],P0[3],P0[4],P0[5],     pw0[0]=PKW(P0,0), pw0[1]=PKW(P0,2), pw0); \
    VRD(4); SBAR(); GAPA(C1=__builtin_amdgcn_mfma_f32_32x32x16_bf16(kf[1],qr[0],C1,0,0,0), P0[6],P0[7],P0[8],P0[9],     pw0[2]=PKW(P0,4), pw0[3]=PKW(P0,6), pw0); \
    VRD(1); SBAR(); GAPA(C0=__builtin_amdgcn_mfma_f32_32x32x16_bf16(kf[2],qr[1],C0,0,0,0),   P0[10],P0[11],P0[12],P0[13], pw1[0]=PKW(P0,8), pw1[1]=PKW(P0,10), pw1); \
    VRD(5); SBAR(); GAPA(C1=__builtin_amdgcn_mfma_f32_32x32x16_bf16(kf[3],qr[1],C1,0,0,0),   P0[14],P0[15],P1[0],P1[1],   pw1[2]=PKW(P0,12),pw1[3]=PKW(P0,14), pw1); \
    VRD(2); SBAR(); GAPA(C0=__builtin_amdgcn_mfma_f32_32x32x16_bf16(kf[4],qr[2],C0,0,0,0),   P1[2],P1[3],P1[4],P1[5],     pw2[0]=PKW(P1,0), pw2[1]=PKW(P1,2), pw2); \
    VRD(6); SBAR(); GAPA(C1=__builtin_amdgcn_mfma_f32_32x32x16_bf16(kf[5],qr[2],C1,0,0,0),   P1[6],P1[7],P1[8],P1[9],     pw2[2]=PKW(P1,4), pw2[3]=PKW(P1,6), pw2); \
    VRD(3); SBAR(); GAPA(C0=__builtin_amdgcn_mfma_f32_32x32x16_bf16(kf[6],qr[3],C0,0,0,0),   P1[10],P1[11],P1[12],P1[13], pw3[0]=PKW(P1,8), pw3[1]=PKW(P1,10), pw3); \
    VRD(7); SBAR(); GAPA(C1=__builtin_amdgcn_mfma_f32_32x32x16_bf16(kf[7],qr[3],C1,0,0,0),   P1[14],P1[15],0.f,0.f,       pw3[2]=PKW(P1,12),pw3[3]=PKW(P1,14), pw3); \
    l_reg+=sacc; \
    if(GK){DMA_K((t)+3,sl_cur);} if(GV){DMA_V((t)+1,sl_next);} \
    CMASK(C0,C1,t); \
    { float a=MX3(C0[0],C0[1],C1[0]),b=MX3(C0[2],C0[3],C1[1]); a=MX3(a,C1[2],C1[3]); \
      _Pragma("unroll") for(int r=4;r<16;r+=4){a=MX3(a,C0[r],C0[r+1]);b=MX3(b,C0[r+2],C0[r+3]);a=MX3(a,C1[r],C1[r+1]);b=MX3(b,C1[r+2],C1[r+3]);} \
      float rm=__builtin_fmaxf(a,b); { auto rr=__builtin_amdgcn_permlane32_swap(__float_as_uint(rm),__float_as_uint(rm),false,false); rm=__builtin_fmaxf(__uint_as_float(rr[0]),__uint_as_float(rr[1])); } \
      resc=false; \
      if(__builtin_expect(__any(rm>(float)THRL),0)){ const float dl=__builtin_fmaxf(rm,0.f); mhat+=dl; \
        _Pragma("unroll") for(int r=0;r<16;++r){C0[r]-=dl;C1[r]-=dl;} \
        negm1=-mhat; \
        const float f=__builtin_amdgcn_exp2f(-dl); l_reg*=f; if(hi==0)wsf[r32]=f; resc=true; } } \
    SBAR(); \
    GAPB(o[0]=__builtin_amdgcn_mfma_f32_32x32x16_bf16(PAF(0),VFR(0),o[0],0,0,0), C0,0); \
    GAPB(o[1]=__builtin_amdgcn_mfma_f32_32x32x16_bf16(PAF(0),VFR(4),o[1],0,0,0), C0,4); \
    KRD(GL,0); GAPB(o[0]=__builtin_amdgcn_mfma_f32_32x32x16_bf16(PAF(1),VFR(1),o[0],0,0,0), C0,8); \
    KRD(GL,1); GAPB(o[1]=__builtin_amdgcn_mfma_f32_32x32x16_bf16(PAF(1),VFR(5),o[1],0,0,0), C0,12); \
    KRD(GL,2); GAPB(o[0]=__builtin_amdgcn_mfma_f32_32x32x16_bf16(PAF(2),VFR(2),o[0],0,0,0), C1,0); \
    KRD(GL,3); GAPB(o[1]=__builtin_amdgcn_mfma_f32_32x32x16_bf16(PAF(2),VFR(6),o[1],0,0,0), C1,4); \
    GAPB(o[0]=__builtin_amdgcn_mfma_f32_32x32x16_bf16(PAF(3),VFR(3),o[0],0,0,0), C1,8); \
    GAPB(o[1]=__builtin_amdgcn_mfma_f32_32x32x16_bf16(PAF(3),VFR(7),o[1],0,0,0), C1,12); \
    }while(0)
  int t=1;
  #undef CMASK
  #define CMASK(P0,P1,t) do{}while(0)
  for(;t+5<NT;t+=2){
    STEP(pB0,pB1,pA0,pA1,t,true,true,true);     WAIT_BAR(2); RESC(); ROT();
    STEP(pA0,pA1,pB0,pB1,t+1,true,true,true);   WAIT_BAR(2); RESC(); ROT();
  }
  #undef CMASK
  #define CMASK(P0,P1,t) do{int jb_=(t)-(NT-4); if(jb_>=0)cmask(P0,P1,jb_,qrel,hi);}while(0)
  #define ENDW(tt) do{ if((tt)+3<NT){WAIT_BAR(2);} else if((tt)+2<NT){WAIT_BAR(1);} else {WAIT_BAR(0);} }while(0)
  const int wq_=wid>>1;
  #define AQ(tt) (((tt)-(NT-4))<=wq_)
  #define DRAINP(P0,P1,VB) do{ float sacc=P0[0]+P0[1]; _Pragma("unroll") for(int r=2;r<16;++r)sacc+=P0[r]; _Pragma("unroll") for(int r=0;r<16;++r)sacc+=P1[r]; l_reg+=sacc; \
    pw0=(u32x4){PKW(P0,0),PKW(P0,2),PKW(P0,4),PKW(P0,6)};pw1=(u32x4){PKW(P0,8),PKW(P0,10),PKW(P0,12),PKW(P0,14)};pw2=(u32x4){PKW(P1,0),PKW(P1,2),PKW(P1,4),PKW(P1,6)};pw3=(u32x4){PKW(P1,8),PKW(P1,10),PKW(P1,12),PKW(P1,14)}; \
    SBAR(); pv(o,(VB),PAF(0),PAF(1),PAF(2),PAF(3)); }while(0)
  #define TAILSTEP(P0,P1,t,GK,GV) do{ SBAR(); if(GK){DMA_K((t)+3,sl_cur);} if(GV){DMA_V((t)+1,sl_next);} resc=false; if(AQ((t)-1)){ DRAINP(P0,P1,vb0+sl_prev); } SBAR(); }while(0)
  for(;t+1<NT;t+=2){
    STEP(pB0,pB1,pA0,pA1,t,(t+3<NT),(t+1<NT),(t+1<NT));       ENDW(t);   RESC(); ROT();
    STEP(pA0,pA1,pB0,pB1,t+1,(t+4<NT),(t+2<NT),(t+2<NT));     ENDW(t+1); RESC(); ROT();
  }
  if(AQ(NT-1)){ STEP(pB0,pB1,pA0,pA1,NT-1,false,false,false); RESC(); DRAINP(pB0,pB1,vb0+sl_cur); }
  else { TAILSTEP(pA0,pA1,NT-1,false,false); }
  #undef AQ
  #undef DRAINP
  #undef TAILSTEP
  #undef PKW
  #undef PAF
  #undef VFR
  #undef PIN
  #undef MX3
  #undef GAPA
  #undef GAPB
  #undef EX
  #undef VRD
  #undef KRD
  #undef STEP
  #undef ENDW
  {auto rr=__builtin_amdgcn_permlane32_swap(__float_as_uint(l_reg),__float_as_uint(l_reg),false,false);l_reg=__uint_as_float(rr[0])+__uint_as_float(rr[1]);}
  if(hi==0)wsf[32+r32]=l_reg;asm volatile("s_waitcnt lgkmcnt(0)":::"memory");
  float rli[16];
  #pragma unroll
  for(int r=0;r<16;++r)rli[r]=__builtin_amdgcn_rcpf(wsf[32+crow(r,hi)]);
  bf16*Ow=O+(rowbase+q0+wid*QBLK)*DM+h*D;
  { bf16*stg=(bf16*)(shm+LDS_OST)+wid*2048;
    #pragma unroll
    for(int r=0;r<16;++r){const int orow=crow(r,hi);
      #pragma unroll
      for(int d0=0;d0<2;++d0)stg[orow*64+d0*32+r32]=__float2bfloat16(o[d0][r]*rli[r]);}
    asm volatile("s_waitcnt lgkmcnt(0)":::"memory");
    #pragma unroll
    for(int i=0;i<4;++i){const int row=i*8+(lane>>3),ch=lane&7; const u32x4 v=*(const u32x4*)(stg+row*64+ch*8); ATTN_STORE16(Ow+(long)row*DM+ch*8,v);} }
  asm volatile("s_waitcnt lgkmcnt(0)\n\ts_barrier":::"memory");
  #undef DMA_K
  #undef DMA_V
  #undef CMASK
  #undef START
  #undef RESC
  #undef ROT
}
constexpr int ATTN_LDS_BYTES=LDS_BYTES;
#undef SBAR
#undef WAIT_BAR
}

constexpr int NWAVES = 8;
constexpr int BATCH = 4, SEQ = 8192, D = 1024, NH = 16, HD = 64, FF0 = 2816, FFE = 3584, NE = 8;
constexpr int T = BATCH * SEQ;
constexpr int NWIN = 3 * D + NH;
constexpr float RMS_EPS = 1e-6f;
constexpr int MAXRT = 264, MAXROWS = MAXRT * 256;
constexpr int CHUNK_RT = 128;
constexpr int MAXCHUNK = 2;
constexpr float WGU_PRESCALE = 32.f, WD_PRESCALE = 64.f;
constexpr int PH_PRO = 0, PH_MIX0 = 1, PH_GU0 = 2, PH_DN0 = 3, PH_THB = 4, PH_QKV = 5, PH_ATT = 6, PH_WO = 7, PH_THC = 8, PH_PERM = 9, PH_MOE = 10, PH_FIN = PH_MOE + 2 * MAXCHUNK, N_PH = PH_FIN + 1;
static_assert(N_PH == 15, "phase count");

constexpr size_t MiB = 1u << 20;
constexpr size_t WS_CTL = 0, CTL_ZERO_BYTES = 1 * MiB;
constexpr size_t WS_WPOOL = 1 * MiB;
constexpr size_t WS_WFT = WS_WPOOL + 512 * 1024;
constexpr size_t WS_WRT = WS_WFT + 64 * 1024;
constexpr size_t WS_RTPOS = 2 * MiB;
constexpr size_t WS_RTG = WS_RTPOS + 256 * 1024;
constexpr size_t WS_LOGF = 3 * MiB;
constexpr size_t WS_NCS = 5 * MiB;
constexpr size_t WS_QTOT = 7 * MiB;
constexpr size_t WS_NRM = 7 * MiB + 4096;
constexpr size_t WS_KBAR = 7 * MiB + 128 * 1024;
constexpr size_t WS_WIN = 8 * MiB;
constexpr size_t WS_WOUT = 14 * MiB;
constexpr size_t WS_WGU0 = 16 * MiB;
constexpr size_t WS_WD0 = 27 * MiB;
constexpr size_t WS_WGU = 34 * MiB;
constexpr size_t WS_WD = 90 * MiB;
constexpr size_t WS_H = 118 * MiB;
constexpr size_t WS_R = 182 * MiB;
constexpr size_t WS_YB = WS_R, WS_ACT0 = WS_R + 64 * MiB;
constexpr size_t WS_Q = WS_R, WS_K = WS_R + 64 * MiB, WS_V = WS_R + 128 * MiB, WS_YATT = WS_K;
constexpr size_t WS_RIDX = WS_R;
constexpr size_t WS_HS = WS_R;
constexpr size_t WS_YS = WS_R + 66 * MiB;
constexpr size_t WS_ACTC = WS_YS + 66 * MiB;
constexpr size_t WS_XR = WS_R + 254 * MiB;
constexpr size_t WS_END = WS_XR + 64 * MiB;
static_assert(WS_WD0 + (size_t)D * FF0 * 2 <= WS_WGU && WS_WGU + (size_t)NE * 2 * FFE * D <= WS_WD && WS_WD + (size_t)NE * D * FFE <= WS_H && WS_ACT0 + (size_t)T * FF0 * 2 <= WS_XR &&
              WS_HS + (size_t)MAXROWS * D <= WS_YS && WS_YS + (size_t)MAXROWS * D <= WS_ACTC && WS_ACTC + (size_t)(MAXRT - CHUNK_RT) * 256 * FFE <= WS_XR && WS_END <= 512 * MiB, "ws map");
constexpr int CW_TMO = 0, CW_CODE = 1, CW_BAR = 4096, CW_CNT = 16384, CW_AQ = 20480, CW_MAXQ = 24576, CW_MAXK = 24576 + 64, CW_PRO = 28672, CW_TS = 32768;

constexpr int RING_OFF = 0, RING_BYTES = 131072;
constexpr int LDSCTL_OFF = RING_BYTES, MISC_OFF = LDSCTL_OFF + 320;
constexpr int LDS_BYTES = 147456;
static_assert(MISC_OFF + 128 <= LDS_BYTES && attn_body::ATTN_LDS_BYTES <= RING_BYTES, "LDS map");

#define GAS __attribute__((address_space(1)))
#define LAS __attribute__((address_space(3)))
typedef unsigned short bf16;
typedef unsigned v4u __attribute__((ext_vector_type(4)));
typedef unsigned v2u __attribute__((ext_vector_type(2)));
typedef float f32x4 __attribute__((ext_vector_type(4)));
typedef float f32x2 __attribute__((ext_vector_type(2)));
typedef GAS unsigned gu32;
#define RLX_AGENT __ATOMIC_RELAXED, __HIP_MEMORY_SCOPE_AGENT
#define LDS_WAIT() asm volatile("s_waitcnt lgkmcnt(0)" ::: "memory")
#define VM_WAIT() asm volatile("s_waitcnt vmcnt(0)" ::: "memory")
__device__ __forceinline__ unsigned f2bf(float f) { unsigned u = __builtin_bit_cast(unsigned, f); return (u + 0x7fffu + ((u >> 16) & 1u)) >> 16; }
typedef float f32x2c_t __attribute__((ext_vector_type(2))); typedef __bf16 bf16x2c_t __attribute__((ext_vector_type(2)));
__device__ __forceinline__ unsigned pk2(float lo, float hi) { const f32x2c_t v = {lo, hi}; const bf16x2c_t b = __builtin_convertvector(v, bf16x2c_t); return __builtin_bit_cast(unsigned, b); }
typedef __bf16 bf16x2d_t __attribute__((ext_vector_type(2)));
__device__ __forceinline__ float dot2bf(unsigned a, unsigned b, float c) { return __builtin_amdgcn_fdot2_f32_bf16(__builtin_bit_cast(bf16x2d_t, a), __builtin_bit_cast(bf16x2d_t, b), c, false); }
__device__ __forceinline__ float bf_lo(unsigned w) { return __builtin_bit_cast(float, w << 16); }
__device__ __forceinline__ float bf_hi(unsigned w) { return __builtin_bit_cast(float, w & 0xffff0000u); }

#define XB_TMO      128
#define XB_XCNT(j)  (256  + 64 * (j))
#define XB_XSUB(j)  (1280 + 64 * (j))
#define XB_XGEN(j)  (2304 + 64 * (j))
#define XB_TOP      3328
#define XB_TOPGEN   3392
#define XCD_BAR_WORDS 3456
#define XB_SPIN_CAP (1u << 18)
__device__ __forceinline__ unsigned xb_ld(unsigned* p)              { return __hip_atomic_load(p, __ATOMIC_RELAXED, __HIP_MEMORY_SCOPE_AGENT); }
__device__ __forceinline__ unsigned xb_add(unsigned* p, unsigned v) { return __hip_atomic_fetch_add(p, v, __ATOMIC_RELAXED, __HIP_MEMORY_SCOPE_AGENT); }
__device__ __forceinline__ unsigned xb_xcc_id() { return (unsigned)__builtin_amdgcn_s_getreg((3 << 11) | 20) & 0xFu; }
#define XB_SPIN(cond, bar) do { unsigned _sp = 0; while (cond) { __builtin_amdgcn_s_sleep(1); \
    if ((++_sp & 255u) == 0u) { if (xb_ld(&(bar)[XB_TMO])) break; if (_sp > XB_SPIN_CAP) { atomicAdd(&(bar)[XB_TMO], 1u); break; } } } } while (0)
struct XcdBarrier { unsigned* bar; unsigned x; volatile LAS unsigned* st; };
__device__ __forceinline__ XcdBarrier xcd_barrier_post(unsigned* bar, volatile LAS unsigned* st) {
    XcdBarrier b; b.bar = bar; b.x = xb_xcc_id(); b.st = st;
    if (threadIdx.x == 0) (void)xb_add(&bar[XB_XCNT(b.x)], 1u);
    return b;
}
__device__ __forceinline__ void xcd_barrier_complete(unsigned* bar, unsigned x, unsigned& nloc, unsigned& nx) {
    const unsigned G = gridDim.x * gridDim.y * gridDim.z;
    unsigned sum, cnt, mine, sp = 0u;
    for (;;) {
        sum = 0u; cnt = 0u; mine = 0u;
#pragma unroll
        for (unsigned j = 0; j < 16; ++j) { const unsigned c = xb_ld(&bar[XB_XCNT(j)]); sum += c; cnt += (c > 0u) ? 1u : 0u; mine = (j == x) ? c : mine; }
        if (sum == G) break;
        __builtin_amdgcn_s_sleep(1);
        if ((++sp & 255u) == 0u) { if (xb_ld(&bar[XB_TMO])) break; if (sp > XB_SPIN_CAP) { atomicAdd(&bar[XB_TMO], 1u); break; } }
    }
    nloc = mine > 0u ? mine : 1u; nx = cnt > 0u ? cnt : 1u;
}
__device__ __forceinline__ void xcd_barrier(const XcdBarrier& b) {
    asm volatile("s_waitcnt vmcnt(0)" ::: "memory");
    __syncthreads();
    if (threadIdx.x == 0) {
        unsigned* bar = b.bar;
        __builtin_amdgcn_s_waitcnt(0);
        unsigned nloc = b.st[0], nx = b.st[1];
        if (nloc == 0u) { xcd_barrier_complete(bar, b.x, nloc, nx); b.st[0] = nloc; b.st[1] = nx; }
        const unsigned old = xb_add(&bar[XB_XSUB(b.x)], 1u);
        const unsigned gen = old / nloc;
        if (old + 1u == (gen + 1u) * nloc) {
            __builtin_amdgcn_fence(__ATOMIC_RELEASE, "agent");
            asm volatile("s_waitcnt vmcnt(0)" ::: "memory");
            const unsigned og = xb_add(&bar[XB_TOP], 1u);
            const unsigned tg = og / nx;
            if (og + 1u == (tg + 1u) * nx) xb_add(&bar[XB_TOPGEN], 1u);
            else XB_SPIN(xb_ld(&bar[XB_TOPGEN]) == tg, bar);
            __builtin_amdgcn_fence(__ATOMIC_ACQUIRE, "agent");
            xb_add(&bar[XB_XGEN(b.x)], 1u);
            asm volatile("s_waitcnt vmcnt(0)" ::: "memory");
        } else {
            XB_SPIN(xb_ld(&bar[XB_XGEN(b.x)]) == gen, bar);
            __builtin_amdgcn_fence(__ATOMIC_ACQUIRE, "agent");
            asm volatile("s_waitcnt vmcnt(0)" ::: "memory");
        }
    }
    __syncthreads();
}

struct Frame {
    LAS unsigned char* lds;
    volatile LAS unsigned* MISC;
    gu32* ctl;
    int tid, lane, wave;
    int vcu, G;
    unsigned char* ws;
};
__device__ __forceinline__ float wave_sum(float v) {
#pragma unroll
    for (int o = 1; o < 64; o <<= 1) v += __shfl_xor(v, o);
    return v;
}
__device__ __forceinline__ void load_row_f32(const float* p, int lane, f32x4 (&v)[4]) {
#pragma unroll
    for (int j = 0; j < 4; ++j) v[j] = ((const f32x4*)p)[64 * j + lane];
}
__device__ __forceinline__ void store_row_f32(float* p, int lane, const f32x4 (&v)[4]) {
#pragma unroll
    for (int j = 0; j < 4; ++j) ((f32x4*)p)[64 * j + lane] = v[j];
}
__device__ __forceinline__ void load_row_bf16(const bf16* p, int lane, f32x4 (&v)[4]) {
#pragma unroll
    for (int j = 0; j < 4; ++j) { const v2u w = ((const v2u*)p)[64 * j + lane]; v[j] = (f32x4){bf_lo(w.x), bf_hi(w.x), bf_lo(w.y), bf_hi(w.y)}; }
}
__device__ __forceinline__ void load_row_bf16_nt(const bf16* p, int lane, f32x4 (&v)[4]) {
#pragma unroll
    for (int j = 0; j < 4; ++j) { const v2u w = __builtin_nontemporal_load((const v2u*)p + 64 * j + lane); v[j] = (f32x4){bf_lo(w.x), bf_hi(w.x), bf_lo(w.y), bf_hi(w.y)}; }
}
__device__ __forceinline__ void store_row_bf16(bf16* p, int lane, const f32x4 (&v)[4]) {
#pragma unroll
    for (int j = 0; j < 4; ++j) { v2u w; w.x = pk2(v[j].x, v[j].y); w.y = pk2(v[j].z, v[j].w); ((v2u*)p)[64 * j + lane] = w; }
}
__device__ __forceinline__ float row_rstd(const f32x4 (&v)[4]) {
    float s = 0.f;
#pragma unroll
    for (int j = 0; j < 4; ++j) s += (v[j].x * v[j].x + v[j].y * v[j].y) + (v[j].z * v[j].z + v[j].w * v[j].w);
    s = wave_sum(s);
    return 1.0f / sqrtf(s * (1.0f / D) + RMS_EPS);
}

__device__ __forceinline__ void p0_transpose_item(const float* W, int ldw, int k0, int n0, bf16* dst, int dK, int drow0, LAS unsigned* scr, int lane) {
    const int nq = lane & 15, kr = lane >> 4;
#pragma unroll 4
    for (int it = 0; it < 8; ++it) { const int kp = it * 4 + kr;
        const f32x4 a = __builtin_nontemporal_load((const f32x4*)(W + (size_t)(k0 + 2 * kp) * ldw + n0 + 4 * nq)), b = __builtin_nontemporal_load((const f32x4*)(W + (size_t)(k0 + 2 * kp + 1) * ldw + n0 + 4 * nq));
        scr[(4 * nq + 0) * 33 + kp] = pk2(a.x, b.x); scr[(4 * nq + 1) * 33 + kp] = pk2(a.y, b.y); scr[(4 * nq + 2) * 33 + kp] = pk2(a.z, b.z); scr[(4 * nq + 3) * 33 + kp] = pk2(a.w, b.w); }
    LDS_WAIT(); asm volatile("" ::: "memory");
    const int c = lane & 7;
#pragma unroll
    for (int ps = 0; ps < 8; ++ps) { const int n = (lane >> 3) + 8 * ps; const LAS unsigned* s = scr + n * 33 + 4 * c;
        v4u o; o.x = s[0]; o.y = s[1]; o.z = s[2]; o.w = s[3];
        *(v4u*)(dst + (size_t)(drow0 + n) * dK + k0 + 8 * c) = o; }
    LDS_WAIT(); asm volatile("" ::: "memory");
}
__device__ __forceinline__ void p0_transpose_item8(const float* W, int ldw, int k0, int n0, unsigned char* dst, int dK, int drow0, float scale, LAS unsigned* scr, int lane) {
    const int nq = lane & 15, kr = lane >> 4;
#pragma unroll 4
    for (int it = 0; it < 8; ++it) { const int k4 = it * 4 + kr; const float* p = W + (size_t)(k0 + 4 * k4) * ldw + n0 + 4 * nq;
        const f32x4 a = __builtin_nontemporal_load((const f32x4*)p) * scale, b = __builtin_nontemporal_load((const f32x4*)(p + ldw)) * scale, c = __builtin_nontemporal_load((const f32x4*)(p + 2 * (size_t)ldw)) * scale, d = __builtin_nontemporal_load((const f32x4*)(p + 3 * (size_t)ldw)) * scale;
        scr[(4 * nq + 0) * 33 + k4] = pg8::pk4_fp8(a.x, b.x, c.x, d.x); scr[(4 * nq + 1) * 33 + k4] = pg8::pk4_fp8(a.y, b.y, c.y, d.y);
        scr[(4 * nq + 2) * 33 + k4] = pg8::pk4_fp8(a.z, b.z, c.z, d.z); scr[(4 * nq + 3) * 33 + k4] = pg8::pk4_fp8(a.w, b.w, c.w, d.w); }
    LDS_WAIT(); asm volatile("" ::: "memory");
    const int c = lane & 7;
#pragma unroll
    for (int ps = 0; ps < 8; ++ps) { const int n = (lane >> 3) + 8 * ps; const LAS unsigned* s = scr + n * 33 + 4 * c;
        v4u o; o.x = s[0]; o.y = s[1]; o.z = s[2]; o.w = s[3];
        *(v4u*)(dst + (size_t)(drow0 + n) * dK + k0 + 16 * c) = o; }
    LDS_WAIT(); asm volatile("" ::: "memory");
}
struct In { const float *x, *norm_g, *pool_w, *pool_scale, *w_in, *b_f, *w_out, *w_gate, *w_up, *w_down, *w_router, *mw_gate, *mw_up, *mw_down; };

__device__ __forceinline__ void moe_conv_share(Frame& F, const In& I) {
    LAS unsigned* scr = (LAS unsigned*)(F.lds + RING_OFF + F.wave * 16384);
    unsigned char* const wgu = F.ws + WS_WGU; unsigned char* const wd = F.ws + WS_WD;
    const int gw = F.vcu * NWAVES + F.wave, NGW = F.G * NWAVES;
#pragma unroll 1
    for (int it = gw; it < NE * 1344; it += NGW) {
        int r = it; const int e = r / 1344; r -= e * 1344;
        if (r < 896) { const int up = r >= 448; if (up) r -= 448; const int kb = r / 56, nb = r % 56, n0 = 64 * nb;
            p0_transpose_item8((up ? I.mw_up : I.mw_gate) + (size_t)e * D * FFE, FFE, 128 * kb, n0, wgu + (size_t)e * 2 * FFE * D, D, ((n0 >> 7) << 8) + (n0 & 127) + (up ? 128 : 0), WGU_PRESCALE, scr, F.lane); }
        else { r -= 896; const int kb = r / 16, nb = r % 16; p0_transpose_item8(I.mw_down + (size_t)e * FFE * D, D, 128 * kb, 64 * nb, wd + (size_t)e * D * FFE, FFE, 64 * nb, WD_PRESCALE, scr, F.lane); }
    }
}
template <int PART>
__device__ __forceinline__ void p0_prologue(Frame& F, const In& I) {
    LAS unsigned* scr = (LAS unsigned*)(F.lds + RING_OFF + F.wave * 16384);
    const int gw = F.vcu * NWAVES + F.wave, NGW = F.G * NWAVES;
    constexpr int I_POOL = 4 * 4 * 4, I_WIN = 16 * 48, I_WOUT = 16 * 16, I_G0 = MK_FFN0_FP8 ? 8 * 44 : 16 * 44, I_D0 = MK_FFN0_DNF8 ? 22 * 16 : 44 * 16, I_GE = 8 * 56, I_DE = 28 * 16;
    constexpr int NITEMS = I_POOL + I_WIN + I_WOUT + 2 * I_G0 + I_D0;
    bf16* const wpool = (bf16*)(F.ws + WS_WPOOL); bf16* const win = (bf16*)(F.ws + WS_WIN); bf16* const wout = (bf16*)(F.ws + WS_WOUT);
    bf16* const wgu0 = (bf16*)(F.ws + WS_WGU0); bf16* const wd0 = (bf16*)(F.ws + WS_WD0);
    for (int it = (PART == 0 ? NITEMS : I_POOL) + gw; it < NITEMS; it += NGW) {
        int r = it;
        if (r < I_POOL) { const int g = r >> 4, q = r & 15, kb = q >> 2, nb = q & 3; p0_transpose_item(I.pool_w + (size_t)g * 65536, 256, 64 * kb, 64 * nb, wpool + (size_t)g * 65536, 256, 64 * nb, scr, F.lane); continue; } r -= I_POOL;
        if (r < I_WIN) { const int kb = r / 48, nb = r % 48; p0_transpose_item(I.w_in, NWIN, 64 * kb, 64 * nb, win, D, 64 * nb, scr, F.lane); continue; } r -= I_WIN;
        if (r < I_WOUT) { const int kb = r / 16, nb = r % 16; p0_transpose_item(I.w_out, D, 64 * kb, 64 * nb, wout, D, 64 * nb, scr, F.lane); continue; } r -= I_WOUT;
        if (r < 2 * I_G0) { const int up = r >= I_G0; if (up) r -= I_G0; const int kb = r / 44, nb = r % 44, n0 = 64 * nb;
            if (MK_FFN0_FP8) p0_transpose_item8(up ? I.w_up : I.w_gate, FF0, 128 * kb, n0, (unsigned char*)wgu0, D, ((n0 >> 7) << 8) + (n0 & 127) + (up ? 128 : 0), WGU_PRESCALE, scr, F.lane);
            else p0_transpose_item(up ? I.w_up : I.w_gate, FF0, 64 * kb, n0, wgu0, D, ((n0 >> 7) << 8) + (n0 & 127) + (up ? 128 : 0), scr, F.lane); continue; } r -= 2 * I_G0;
        if (r < I_D0) { const int kb = r / 16, nb = r % 16;
            if (MK_FFN0_DNF8) p0_transpose_item8(I.w_down, D, 128 * kb, 64 * nb, (unsigned char*)wd0, FF0, 64 * nb, WD_PRESCALE, scr, F.lane);
            else p0_transpose_item(I.w_down, D, 64 * kb, 64 * nb, wd0, FF0, 64 * nb, scr, F.lane); continue; } r -= I_D0;
        (void)I_GE; (void)I_DE;
    }
    if (PART == 0) { const int gt = F.vcu * (NWAVES * 64) + F.tid, NGT = F.G * NWAVES * 64;
      for (int f = gt; f < 4 * 2 * 8 * 8 * 64; f += NGT) { const int ln = f & 63, nb = (f >> 6) & 7, ks = (f >> 9) & 7, half = (f >> 12) & 1, g = f >> 13, c16 = ln & 15, kq = ln >> 4;
          const float* src = I.pool_w + (size_t)g * 65536 + (size_t)(32 * ks + 8 * kq) * 256 + 128 * half + 16 * nb + c16;
          v4u w; w.x = pk2(src[0], src[256]); w.y = pk2(src[512], src[768]); w.z = pk2(src[1024], src[1280]); w.w = pk2(src[1536], src[1792]);
          ((v4u*)wpool)[f] = w; } }
    if (PART == 0) { float* wft = (float*)(F.ws + WS_WFT); float* wrt = (float*)(F.ws + WS_WRT); const int gt = F.vcu * (NWAVES * 64) + F.tid, NGT = F.G * NWAVES * 64;
      for (int i = gt; i < 16 * D; i += NGT) { const int j = i / D, c = i % D; ((bf16*)wft)[i] = (bf16)f2bf(I.w_in[(size_t)c * NWIN + 3 * D + j]); }
      for (int i = gt; i < NE * D; i += NGT) { const int e = i / D, c = i % D; wrt[i] = I.w_router[(size_t)c * NE + e]; } }
}

__device__ __forceinline__ void row_rstd2(const f32x4 (&a)[4], const f32x4 (&b)[4], float& ra, float& rb) {
    float s = 0.f, t = 0.f;
#pragma unroll
    for (int j = 0; j < 4; ++j) { s += (a[j].x * a[j].x + a[j].y * a[j].y) + (a[j].z * a[j].z + a[j].w * a[j].w); t += (b[j].x * b[j].x + b[j].y * b[j].y) + (b[j].z * b[j].z + b[j].w * b[j].w); }
#pragma unroll
    for (int o = 1; o < 64; o <<= 1) { s += __shfl_xor(s, o); t += __shfl_xor(t, o); }
    ra = 1.0f / sqrtf(s * (1.0f / D) + RMS_EPS); rb = 1.0f / sqrtf(t * (1.0f / D) + RMS_EPS);
}
template <int H, int BIT, int N>
__device__ __forceinline__ void halve_step(float (&v)[N], int lane) {
    const bool up = (lane & BIT) != 0;
#pragma unroll
    for (int i = 0; i < H; ++i) { const float send = up ? v[i] : v[i + H], keep = up ? v[i + H] : v[i]; v[i] = keep + __shfl_xor(send, BIT); }
}
__device__ __forceinline__ float halve_reduce16(float (&v)[16], int lane) {
    halve_step<8, 32>(v, lane); halve_step<4, 16>(v, lane); halve_step<2, 8>(v, lane); halve_step<1, 4>(v, lane);
    float r = v[0]; r += __shfl_xor(r, 2); r += __shfl_xor(r, 1); return r;
}
__device__ __forceinline__ float halve_reduce8(float (&v)[8], int lane) {
    halve_step<4, 32>(v, lane); halve_step<2, 16>(v, lane); halve_step<1, 8>(v, lane);
    float r = v[0]; r += __shfl_xor(r, 4); r += __shfl_xor(r, 2); r += __shfl_xor(r, 1); return r;
}
template <int MODE>
__device__ __forceinline__ void thin_phase(Frame& F, const In& I, const bf16* Y, bf16* xr, const float* gpost_p, const float* gpre_p) {
    bf16* const Hb = (bf16*)(F.ws + WS_H);
    LAS float* wl = (LAS float*)(F.lds + RING_OFF);
    LAS unsigned* rte = (LAS unsigned*)(F.lds + RING_OFF + 65536);
    LAS float* rtg = (LAS float*)(F.lds + RING_OFF + 65536 + 512);
    LAS unsigned* wtot = (LAS unsigned*)(F.lds + RING_OFF + 65536 + 2048);
    if (MODE == 1) { const f32x4* src = (const f32x4*)(F.ws + WS_WFT); for (int i = F.tid; i < 16 * D / 8; i += NWAVES * 64) ((LAS f32x4*)wl)[i] = src[i]; }
    if (MODE == 2) { const f32x4* src = (const f32x4*)(F.ws + WS_WRT); for (int i = F.tid; i < NE * D / 4; i += NWAVES * 64) ((LAS f32x4*)wl)[i] = src[i]; }
    f32x4 gpost[4], gpre[4];
    load_row_f32(gpost_p, F.lane, gpost); load_row_f32(gpre_p, F.lane, gpre);
    float bfq = 0.f; if (MODE == 1) bfq = I.b_f[(F.lane >> 2) & 15];
    __syncthreads();
    for (int tile = F.vcu; tile < T / 128; tile += F.G) {
        const int mb = tile * 128 + F.wave * 16;
        f32x4 ynA[4], xnA[4], ynB[4], xnB[4];
        load_row_bf16_nt(Y + (size_t)mb * D, F.lane, ynA); load_row_bf16(xr + (size_t)mb * D, F.lane, xnA);
        load_row_bf16_nt(Y + (size_t)(mb + 1) * D, F.lane, ynB); load_row_bf16(xr + (size_t)(mb + 1) * D, F.lane, xnB);
#pragma unroll 1
        for (int i = 0; i < 16; i += 2) {
            const int m = mb + i, tl = F.wave * 16 + i;
            f32x4 yA[4], xA[4], yB[4], xB[4];
#pragma unroll
            for (int j = 0; j < 4; ++j) { yA[j] = ynA[j]; xA[j] = xnA[j]; yB[j] = ynB[j]; xB[j] = xnB[j]; }
            if (i + 2 < 16) { load_row_bf16_nt(Y + (size_t)(m + 2) * D, F.lane, ynA); load_row_bf16(xr + (size_t)(m + 2) * D, F.lane, xnA);
                              load_row_bf16_nt(Y + (size_t)(m + 3) * D, F.lane, ynB); load_row_bf16(xr + (size_t)(m + 3) * D, F.lane, xnB); }
            float r1A, r1B; row_rstd2(yA, yB, r1A, r1B);
#pragma unroll
            for (int j = 0; j < 4; ++j) { xA[j] += yA[j] * r1A * gpost[j]; xB[j] += yB[j] * r1B * gpost[j]; }
            store_row_bf16(xr + (size_t)m * D, F.lane, xA); store_row_bf16(xr + (size_t)(m + 1) * D, F.lane, xB);
            float r2A, r2B; row_rstd2(xA, xB, r2A, r2B);
#pragma unroll
            for (int j = 0; j < 4; ++j) { xA[j] = xA[j] * r2A * gpre[j]; xB[j] = xB[j] * r2B * gpre[j]; }
            if (MODE == 2) {
#pragma unroll
                for (int j = 0; j < 4; ++j) { ((unsigned*)((unsigned char*)Hb + (size_t)m * D))[64 * j + F.lane] = pg8::pk4_fp8(xA[j].x, xA[j].y, xA[j].z, xA[j].w);
                                              ((unsigned*)((unsigned char*)Hb + (size_t)(m + 1) * D))[64 * j + F.lane] = pg8::pk4_fp8(xB[j].x, xB[j].y, xB[j].z, xB[j].w); }
            } else if (MODE != 1) { store_row_bf16(Hb + (size_t)m * D, F.lane, xA); store_row_bf16(Hb + (size_t)(m + 1) * D, F.lane, xB); }
            if (MODE == 1) {
                v2u hA[4], hB[4];
#pragma unroll
                for (int j = 0; j < 4; ++j) { hA[j].x = pk2(xA[j].x, xA[j].y); hA[j].y = pk2(xA[j].z, xA[j].w); hB[j].x = pk2(xB[j].x, xB[j].y); hB[j].y = pk2(xB[j].z, xB[j].w);
                    ((v2u*)(Hb + (size_t)m * D))[64 * j + F.lane] = hA[j]; ((v2u*)(Hb + (size_t)(m + 1) * D))[64 * j + F.lane] = hB[j]; }
                float pA[16], pB[16];
#pragma unroll
                for (int q = 0; q < 16; ++q) { float s = 0.f, t = 0.f;
#pragma unroll
                    for (int j = 0; j < 4; ++j) { const v2u wp = ((const LAS v2u*)wl)[q * 256 + 64 * j + F.lane];
                        s = dot2bf(wp.x, hA[j].x, s); s = dot2bf(wp.y, hA[j].y, s); t = dot2bf(wp.x, hB[j].x, t); t = dot2bf(wp.y, hB[j].y, t); }
                    pA[q] = s; pB[q] = t; if ((q & 3) == 3) asm volatile("" ::: "memory"); }
                float zA = halve_reduce16(pA, F.lane), zB = halve_reduce16(pB, F.lane);
                if ((F.lane & 3) == 0) { const int q = F.lane >> 2; const float bf = bfq; zA += bf; zB += bf;
                    ((float*)(F.ws + WS_LOGF))[(size_t)m * 16 + q] = fminf(zA, 0.f) - log1pf(expf(-fabsf(zA)));
                    ((float*)(F.ws + WS_LOGF))[(size_t)(m + 1) * 16 + q] = fminf(zB, 0.f) - log1pf(expf(-fabsf(zB))); }
            }
            if (MODE == 2) {
                float lgA[8], lgB[8];
#pragma unroll
                for (int q = 0; q < 8; ++q) { float s = 0.f, t = 0.f;
#pragma unroll
                    for (int j = 0; j < 4; ++j) { const f32x4 w = ((const LAS f32x4*)wl)[q * 256 + 64 * j + F.lane];
                        s += (xA[j].x * w.x + xA[j].y * w.y) + (xA[j].z * w.z + xA[j].w * w.w); t += (xB[j].x * w.x + xB[j].y * w.y) + (xB[j].z * w.z + xB[j].w * w.w); }
                    lgA[q] = s; lgB[q] = t; if ((q & 1) == 1) asm volatile("" ::: "memory"); }
                { const float rA = halve_reduce8(lgA, F.lane), rB = halve_reduce8(lgB, F.lane);
#pragma unroll
                  for (int q = 0; q < 8; ++q) { lgA[q] = __shfl(rA, 8 * q); lgB[q] = __shfl(rB, 8 * q); } }
#pragma unroll
                for (int rr = 0; rr < 2; ++rr) {
                    int e1 = 0; float v1 = rr ? lgB[0] : lgA[0];
#pragma unroll
                    for (int q = 1; q < 8; ++q) { const float v = rr ? lgB[q] : lgA[q]; if (v > v1) { v1 = v; e1 = q; } }
                    int e2 = -1; float v2 = -INFINITY;
#pragma unroll
                    for (int q = 0; q < 8; ++q) { const float v = rr ? lgB[q] : lgA[q]; if (q != e1 && v > v2) { v2 = v; e2 = q; } }
                    const float ex = expf(v2 - v1), g1 = 1.0f / (1.0f + ex), g2 = ex * g1;
                    if (F.lane == 0) { rte[tl + rr] = (unsigned)e1 | ((unsigned)e2 << 8); rtg[2 * (tl + rr)] = g1; rtg[2 * (tl + rr) + 1] = g2; }
                }
            }
        }
        if (MODE == 2) {
            __syncthreads();
            unsigned e1 = 0, e2 = 0, r1 = 0, r2 = 0; const int tl = F.tid;
            if (F.wave < 2) { const unsigned w = rte[tl]; e1 = w & 255u; e2 = w >> 8;
                const unsigned long long lt = (1ull << F.lane) - 1ull;
#pragma unroll
                for (unsigned e = 0; e < 8; ++e) { const unsigned long long m1 = __ballot(e1 == e), m2 = __ballot(e2 == e);
                    if (e1 == e) r1 = (unsigned)__popcll(m1 & lt); if (e2 == e) r2 = (unsigned)(__popcll(m1) + __popcll(m2 & lt));
                    if (F.lane == 0) wtot[F.wave * 8 + e] = (unsigned)(__popcll(m1) + __popcll(m2)); } }
            __syncthreads();
            if (F.tid < 8) { const unsigned n = wtot[F.tid] + wtot[8 + F.tid]; wtot[16 + F.tid] = __hip_atomic_fetch_add(F.ctl + CW_CNT + 64 * F.tid, n, RLX_AGENT); }
            __syncthreads();
            if (F.wave < 2) { const int m = tile * 128 + tl;
                const unsigned p1 = wtot[16 + e1] + (F.wave ? wtot[e1] : 0u) + r1, p2 = wtot[16 + e2] + (F.wave ? wtot[e2] : 0u) + r2;
                v2u pp; pp.x = (e1 << 20) | p1; pp.y = (e2 << 20) | p2; ((v2u*)(F.ws + WS_RTPOS))[m] = pp;
                ((unsigned*)(F.ws + WS_RIDX))[e1 * T + p1] = (unsigned)m; ((unsigned*)(F.ws + WS_RIDX))[e2 * T + p2] = (unsigned)m;
                ((f32x2*)(F.ws + WS_RTG))[m] = (f32x2){rtg[2 * tl], rtg[2 * tl + 1]}; }
            __syncthreads();
        }
    }
}

__device__ __forceinline__ f32x4 unpk4(v2u w) { return (f32x4){bf_lo(w.x), bf_hi(w.x), bf_lo(w.y), bf_hi(w.y)}; }
template <int W>
__device__ __forceinline__ void pool_rows(LAS unsigned char* P, LAS unsigned char* HALO, int seg, int c4, int tb0) {
    f32x4 ring[W]; f32x4 S = (f32x4){0.f, 0.f, 0.f, 0.f};
#pragma unroll
    for (int k = 0; k < W; ++k) { const int row = 32 - W + k;
        const v2u w = seg ? *(const LAS v2u*)(P + row * 2048 + ((((c4 >> 1) ^ (row & 15))) << 4) + (c4 & 1) * 8) : *(const LAS v2u*)(HALO + (W - 2) * 512 + k * 512 + 8 * (c4 & 63));
        ring[k] = unpk4(w); S += ring[k]; }
    __syncthreads();
    const int tbb = tb0 + 32 * seg;
#pragma unroll
    for (int i = 0; i < 32; ++i) { const int row = 32 * seg + i; LAS v2u* p = (LAS v2u*)(P + row * 2048 + ((((c4 >> 1) ^ (row & 15))) << 4) + (c4 & 1) * 8);
        const f32x4 hv = unpk4(*p); S += hv - ring[i % W]; ring[i % W] = hv;
        const int tb = tbb + i; const float inv = 1.0f / (float)((tb + 1 < W) ? (tb + 1) : W);
        const f32x4 pv_ = S * inv - hv; v2u o; o.x = pk2(pv_.x, pv_.y); o.y = pk2(pv_.z, pv_.w); *p = o; }
}
__device__ __forceinline__ void pro_publish(Frame& F) {
    asm volatile("s_waitcnt vmcnt(0)" ::: "memory");
    __syncthreads();
    if (threadIdx.x == 0) { __builtin_amdgcn_fence(__ATOMIC_RELEASE, "agent"); asm volatile("s_waitcnt vmcnt(0)" ::: "memory"); (void)xb_add((unsigned*)(F.ctl + CW_PRO), 1u); }
}
__device__ __forceinline__ void pro_wait(Frame& F) {
    if (threadIdx.x == 0) { unsigned* const bar = (unsigned*)(F.ctl + CW_BAR); unsigned* const c = (unsigned*)(F.ctl + CW_PRO); const unsigned G = (unsigned)F.G;
        XB_SPIN(xb_ld(c) < G, bar); __builtin_amdgcn_fence(__ATOMIC_ACQUIRE, "agent"); asm volatile("s_waitcnt vmcnt(0)" ::: "memory"); }
    __syncthreads();
}
__device__ __forceinline__ void mix0_phase(Frame& F, const In& I, bf16* xr) {
    typedef short bf16x8_t __attribute__((ext_vector_type(8)));
    LAS unsigned char* const P = F.lds + RING_OFF;
    LAS unsigned char* const HALO = F.lds + MISC_OFF + 128;
    const bf16* const WP = (const bf16*)(F.ws + WS_WPOOL);
    bf16* const Hb = (bf16*)(F.ws + WS_H);
    const int lane = F.lane, wave = F.wave, c16 = lane & 15, kq = lane >> 4;
    bool first = true;
    for (int tile = F.vcu; tile < T / 64; tile += F.G) {
        const int t0 = tile * 64, tb0 = t0 & (SEQ - 1);
        { f32x4 g0[4]; load_row_f32(I.norm_g, lane, g0);
#pragma unroll 1
          for (int bt = 0; bt < 2; ++bt) {
              f32x4 a[5][4]; float sq[5];
#pragma unroll
              for (int k = 0; k < 5; ++k) { const int rr = t0 - 16 + wave + 8 * (5 * bt + k); load_row_f32(I.x + (size_t)(rr < 0 ? 0 : rr) * D, lane, a[k]); }
#pragma unroll
              for (int k = 0; k < 5; ++k) { float q = 0.f;
#pragma unroll
                  for (int j = 0; j < 4; ++j) q += (a[k][j].x * a[k][j].x + a[k][j].y * a[k][j].y) + (a[k][j].z * a[k][j].z + a[k][j].w * a[k][j].w);
                  sq[k] = q; }
#pragma unroll
              for (int o = 1; o < 64; o <<= 1) {
#pragma unroll
                  for (int k = 0; k < 5; ++k) sq[k] += __shfl_xor(sq[k], o); }
#pragma unroll
              for (int k = 0; k < 5; ++k) { const int row = -16 + wave + 8 * (5 * bt + k);
                  const float rstd = (tb0 + row >= 0) ? 1.0f / sqrtf(sq[k] * (1.0f / D) + RMS_EPS) : 0.f;
#pragma unroll
                  for (int j = 0; j < 4; ++j) { const f32x4 hv = a[k][j] * (g0[j] * rstd); v2u o; o.x = pk2(hv.x, hv.y); o.y = pk2(hv.z, hv.w);
                      if (row >= 0) *(LAS v2u*)(P + row * 2048 + ((((32 * j + (lane >> 1)) ^ (row & 15))) << 4) + (lane & 1) * 8) = o;
                      else { const int wj = 2 << j; if (row >= -wj) *(LAS v2u*)(HALO + (wj - 2) * 512 + (row + wj) * 512 + 8 * lane) = o; } } }
          } }
        __syncthreads();
        { int tid_ = threadIdx.x; asm volatile("" : "+v"(tid_));
          const int seg = tid_ >> 8, c4 = tid_ & 255;
          switch ((c4 >> 6) & 3) { case 0: pool_rows<2>(P, HALO, seg, c4, tb0); break; case 1: pool_rows<4>(P, HALO, seg, c4, tb0); break; case 2: pool_rows<8>(P, HALO, seg, c4, tb0); break; default: pool_rows<16>(P, HALO, seg, c4, tb0); break; } }
        __syncthreads();
        f32x4 acc[4][8];
#pragma unroll
        for (int m = 0; m < 4; ++m)
#pragma unroll
            for (int nb = 0; nb < 8; ++nb) acc[m][nb] = (f32x4){0.f, 0.f, 0.f, 0.f};
        if (first) { pro_wait(F); first = false; }
        { const int gI = wave >> 1;
          const char* const wpb = (const char*)WP;
          const unsigned boff = (unsigned)((gI * 2 + (wave & 1)) * (8 * 8 * 64) + lane) * 16u;
          bf16x8_t bnx[8];
          { unsigned bo = boff; asm volatile("" : "+v"(bo));
#pragma unroll
            for (int nb = 0; nb < 8; ++nb) bnx[nb] = *(const bf16x8_t*)(wpb + (size_t)(bo + (unsigned)nb * 1024u)); }
#pragma unroll 1
          for (int ks = 0; ks < 8; ++ks) {
              bf16x8_t bfr[8], afr[4];
#pragma unroll
              for (int nb = 0; nb < 8; ++nb) bfr[nb] = bnx[nb];
              if (ks + 1 < 8) { unsigned bo = boff + (unsigned)(ks + 1) * 8192u; asm volatile("" : "+v"(bo));
#pragma unroll
                  for (int nb = 0; nb < 8; ++nb) bnx[nb] = *(const bf16x8_t*)(wpb + (size_t)(bo + (unsigned)nb * 1024u)); }
#pragma unroll
              for (int m = 0; m < 4; ++m) afr[m] = *(const LAS bf16x8_t*)(P + (16 * m + c16) * 2048 + (((32 * gI + 4 * ks + kq) ^ c16) << 4));
#pragma unroll
              for (int m = 0; m < 4; ++m)
#pragma unroll
                  for (int nb = 0; nb < 8; ++nb) acc[m][nb] = __builtin_amdgcn_mfma_f32_16x16x32_bf16(bfr[nb], afr[m], acc[m][nb], 0, 0, 0);
          } }
        __syncthreads();
#pragma unroll
        for (int nb = 0; nb < 8; ++nb) { const int col = 128 * wave + 16 * nb + 4 * kq; const f32x4 sc = *(const f32x4*)(I.pool_scale + col);
#pragma unroll
            for (int m = 0; m < 4; ++m) { const f32x4 v = acc[m][nb] * sc; v2u o; o.x = pk2(v.x, v.y); o.y = pk2(v.z, v.w);
                const int row = 16 * m + c16;
                *(LAS v2u*)(P + row * 2048 + ((((col >> 3) ^ c16)) << 4) + (kq & 1) * 8) = o; } }
        __syncthreads();
        { const int rb0 = wave * 8; int lane_ = threadIdx.x & 63; asm volatile("" : "+v"(lane_)); const int lane = lane_;
          f32x4 gpost[4], gpre[4];
          load_row_f32(I.norm_g + 1 * D, lane, gpost); load_row_f32(I.norm_g + 2 * D, lane, gpre);
#pragma unroll 1
          for (int i = 0; i < 8; i += 4) {
              f32x4 y[4][4], x[4][4]; float sq[4];
#pragma unroll
              for (int q = 0; q < 4; ++q) load_row_f32(I.x + (size_t)(t0 + rb0 + i + q) * D, lane, x[q]);
#pragma unroll
              for (int q = 0; q < 4; ++q) { const int r = rb0 + i + q;
#pragma unroll
                  for (int j = 0; j < 4; ++j) {
                      const v2u wv = *(const LAS v2u*)(P + r * 2048 + ((((32 * j + (lane >> 1)) ^ (r & 15))) << 4) + (lane & 1) * 8);
                      y[q][j] = (f32x4){bf_lo(wv.x), bf_hi(wv.x), bf_lo(wv.y), bf_hi(wv.y)}; } }
#pragma unroll
              for (int q = 0; q < 4; ++q) { float t = 0.f;
#pragma unroll
                  for (int j = 0; j < 4; ++j) t += (y[q][j].x * y[q][j].x + y[q][j].y * y[q][j].y) + (y[q][j].z * y[q][j].z + y[q][j].w * y[q][j].w);
                  sq[q] = t; }
#pragma unroll
              for (int o = 1; o < 64; o <<= 1) {
#pragma unroll
                  for (int q = 0; q < 4; ++q) sq[q] += __shfl_xor(sq[q], o); }
#pragma unroll
              for (int q = 0; q < 4; ++q) { const float r1 = 1.0f / sqrtf(sq[q] * (1.0f / D) + RMS_EPS); float t = 0.f;
#pragma unroll
                  for (int j = 0; j < 4; ++j) { x[q][j] += y[q][j] * r1 * gpost[j]; t += (x[q][j].x * x[q][j].x + x[q][j].y * x[q][j].y) + (x[q][j].z * x[q][j].z + x[q][j].w * x[q][j].w); }
                  store_row_bf16(xr + (size_t)(t0 + rb0 + i + q) * D, lane, x[q]); sq[q] = t; }
#pragma unroll
              for (int o = 1; o < 64; o <<= 1) {
#pragma unroll
                  for (int q = 0; q < 4; ++q) sq[q] += __shfl_xor(sq[q], o); }
#pragma unroll
              for (int q = 0; q < 4; ++q) { const float r2 = 1.0f / sqrtf(sq[q] * (1.0f / D) + RMS_EPS);
#pragma unroll
                  for (int j = 0; j < 4; ++j) x[q][j] = x[q][j] * r2 * gpre[j];
                  if (MK_FFN0_FP8) {
#pragma unroll
                      for (int j = 0; j < 4; ++j) ((unsigned*)((unsigned char*)Hb + (size_t)(t0 + rb0 + i + q) * D))[64 * j + lane] = pg8::pk4_fp8(x[q][j].x, x[q][j].y, x[q][j].z, x[q][j].w);
                  } else store_row_bf16(Hb + (size_t)(t0 + rb0 + i + q) * D, lane, x[q]); }
          } }
        __syncthreads();
    }
}

__device__ __forceinline__ void moe_offsets(Frame& F) {
    if (F.tid < 64) {
        const unsigned c = F.tid < NE ? __hip_atomic_load(F.ctl + CW_CNT + 64 * (F.tid & 7), RLX_AGENT) : 0u; unsigned incl = (c + 255u) >> 8;
#pragma unroll
        for (int o = 1; o < 8; o <<= 1) { const unsigned t = (unsigned)__shfl_up((int)incl, o); if (F.lane >= o) incl += t; }
        if (F.tid < NE) F.MISC[12 + F.tid] = incl - ((c + 255u) >> 8);
        if (F.tid == NE - 1) { F.MISC[12 + NE] = incl; F.MISC[10] = incl; } }
    __syncthreads();
}
__device__ __forceinline__ void permute_phase(Frame& F) {
    moe_offsets(F);
    unsigned* const ridx = (unsigned*)(F.ws + WS_RIDX);
    const int gt = F.vcu * (NWAVES * 64) + F.tid, NGT = F.G * NWAVES * 64;
    for (int m = gt; m < T; m += NGT) { v2u pp = ((const v2u*)(F.ws + WS_RTPOS))[m];
        const unsigned e1 = pp.x >> 20, e2 = pp.y >> 20, d1 = F.MISC[12 + e1] * 256u + (pp.x & 0xfffffu), d2 = F.MISC[12 + e2] * 256u + (pp.y & 0xfffffu);
        pp.x = d1; pp.y = d2; ((v2u*)(F.ws + WS_RTPOS))[m] = pp; ridx[d1] = (unsigned)m; ridx[d2] = (unsigned)m; }
    for (int e = 0; e < NE; ++e) { const unsigned c = __hip_atomic_load(F.ctl + CW_CNT + 64 * e, RLX_AGENT); const unsigned r0 = F.MISC[12 + e] * 256u + c, r1 = F.MISC[13 + e] * 256u;
        for (unsigned r = r0 + (unsigned)gt; r < r1; r += (unsigned)NGT) ridx[r] = 0u; }
}
__device__ __forceinline__ void load_row_fp8(const unsigned char* p, int lane, f32x4 (&v)[4]) {
#pragma unroll
    for (int j = 0; j < 4; ++j) { const int w = __builtin_nontemporal_load((const int*)p + 64 * j + lane); const f32x2 lo = __builtin_amdgcn_cvt_pk_f32_fp8(w, false), hi = __builtin_amdgcn_cvt_pk_f32_fp8(w, true); v[j] = (f32x4){lo.x, lo.y, hi.x, hi.y}; }
}
__device__ __forceinline__ void final_phase(Frame& F, const In& I, float* xout) {
    const unsigned char* YS = F.ws + WS_YS; const bf16* xr = (const bf16*)(F.ws + WS_XR);
    f32x4 gp[4]; load_row_f32(I.norm_g + (size_t)(1 * 4 + 3) * D, F.lane, gp);
    for (int tile = F.vcu; tile < T / 128; tile += F.G) {
        const int mb = tile * 128 + F.wave * 16;
        v2u pp = (v2u){0u, 0u}; f32x2 gg = (f32x2){0.f, 0.f};
        if (F.lane < 16) { pp = ((const v2u*)(F.ws + WS_RTPOS))[mb + F.lane]; gg = ((const f32x2*)(F.ws + WS_RTG))[mb + F.lane];
            pp.x = F.MISC[12 + (pp.x >> 20)] * 256u + (pp.x & 0xfffffu); pp.y = F.MISC[12 + (pp.y >> 20)] * 256u + (pp.y & 0xfffffu); }
        f32x4 anA[4], bnA[4], xnA[4], anB[4], bnB[4], xnB[4];
        load_row_fp8(YS + (size_t)(unsigned)__shfl((int)pp.x, 0) * D, F.lane, anA); load_row_fp8(YS + (size_t)(unsigned)__shfl((int)pp.y, 0) * D, F.lane, bnA); load_row_bf16_nt(xr + (size_t)mb * D, F.lane, xnA);
        load_row_fp8(YS + (size_t)(unsigned)__shfl((int)pp.x, 1) * D, F.lane, anB); load_row_fp8(YS + (size_t)(unsigned)__shfl((int)pp.y, 1) * D, F.lane, bnB); load_row_bf16_nt(xr + (size_t)(mb + 1) * D, F.lane, xnB);
#pragma unroll 1
        for (int i = 0; i < 16; i += 2) {
            const int m = mb + i;
            f32x4 aA[4], xA[4], aB[4], xB[4];
            const float g1A = __shfl(gg.x, i), g2A = __shfl(gg.y, i), g1B = __shfl(gg.x, i + 1), g2B = __shfl(gg.y, i + 1);
#pragma unroll
            for (int j = 0; j < 4; ++j) { aA[j] = anA[j] * g1A + bnA[j] * g2A; aB[j] = anB[j] * g1B + bnB[j] * g2B; xA[j] = xnA[j]; xB[j] = xnB[j]; }
            if (i + 2 < 16) {
                load_row_fp8(YS + (size_t)(unsigned)__shfl((int)pp.x, i + 2) * D, F.lane, anA); load_row_fp8(YS + (size_t)(unsigned)__shfl((int)pp.y, i + 2) * D, F.lane, bnA); load_row_bf16_nt(xr + (size_t)(m + 2) * D, F.lane, xnA);
                load_row_fp8(YS + (size_t)(unsigned)__shfl((int)pp.x, i + 3) * D, F.lane, anB); load_row_fp8(YS + (size_t)(unsigned)__shfl((int)pp.y, i + 3) * D, F.lane, bnB); load_row_bf16_nt(xr + (size_t)(m + 3) * D, F.lane, xnB); }
            float rA, rB; row_rstd2(aA, aB, rA, rB);
#pragma unroll
            for (int j = 0; j < 4; ++j) { xA[j] += aA[j] * rA * gp[j]; xB[j] += aB[j] * rB * gp[j]; }
            store_row_f32(xout + (size_t)m * D, F.lane, xA); store_row_f32(xout + (size_t)(m + 1) * D, F.lane, xB);
        }
    }
}
__device__ __forceinline__ void scan_phase(Frame& F, int unit) {
    const int bh = unit >> 2, qn = unit & 3, b = bh / NH, h = bh % NH; const float* lf = (const float*)(F.ws + WS_LOGF) + ((size_t)b * SEQ + 2048 * qn) * 16 + h;
    float* ncs = (float*)(F.ws + WS_NCS) + (size_t)bh * SEQ + 2048 * qn;
    LAS float* part = (LAS float*)(F.lds + RING_OFF);
    float v[4]; float s = 0.f; const int s0 = F.tid * 4;
#pragma unroll
    for (int i = 0; i < 4; ++i) { v[i] = lf[(size_t)(s0 + i) * 16]; s += v[i]; }
    float incl = s;
#pragma unroll
    for (int o = 1; o < 64; o <<= 1) { const float t = __shfl_up(incl, o); if (F.lane >= o) incl += t; }
    if (F.lane == 63) part[F.wave] = incl;
    __syncthreads();
    float base = incl - s, tot = 0.f;
    for (int w = 0; w < NWAVES; ++w) { const float p = part[w]; if (w < F.wave) base += p; tot += p; }
    float run = base; f32x4 o4; run += v[0]; o4.x = -1.4426950408889634f * run; run += v[1]; o4.y = -1.4426950408889634f * run; run += v[2]; o4.z = -1.4426950408889634f * run; run += v[3]; o4.w = -1.4426950408889634f * run;
    *(f32x4*)(ncs + s0) = o4;
    if (F.tid == 0) ((float*)(F.ws + WS_QTOT))[unit] = -1.4426950408889634f * tot;
    __syncthreads();
}

__device__ __forceinline__ bool attn_next(int vcu, int G, int i, int& bh, int& qb) {
    if (G == 256) { if (i >= 8) return false; const int s = vcu & 3; bh = vcu >> 2; const int base = 8 * (i >> 1); qb = (i & 1) ? base + 7 - s : base + s; return true; }
    const int u = vcu + i * G; if (u >= 64 * 32) return false; bh = u >> 5; qb = 31 - (u & 31); return true;
}

struct Args { const float* in[14]; float* out; unsigned char* ws; int ph_lo, ph_hi; };
__global__ void __launch_bounds__(NWAVES * 64, 2) trunk_fwd(Args args) {
    extern __shared__ __attribute__((aligned(16))) unsigned char lds[];
    Frame F;
    F.lds = (LAS unsigned char*)lds;
    F.MISC = (volatile LAS unsigned*)(F.lds + MISC_OFF);
    F.tid = threadIdx.x; F.lane = F.tid & 63; F.wave = __builtin_amdgcn_readfirstlane(F.tid >> 6);
    F.G = gridDim.x; { const int bx = blockIdx.x; F.vcu = (F.G % 8 == 0) ? (bx % 8) * (F.G / 8) + bx / 8 : bx; }
    F.ws = args.ws; F.ctl = (gu32*)(args.ws + WS_CTL);
    const __attribute__((address_space(4))) Args* const ka = (const __attribute__((address_space(4))) Args*)__builtin_amdgcn_kernarg_segment_ptr();
#define KA_IN(i) ((const float*)*(const float* const volatile __attribute__((address_space(4)))*)&ka->in[i])
#define LOAD_IN() In I; I.x = KA_IN(0); I.norm_g = KA_IN(1); I.pool_w = KA_IN(2); I.pool_scale = KA_IN(3); I.w_in = KA_IN(4); I.b_f = KA_IN(5); I.w_out = KA_IN(6); \
    I.w_gate = KA_IN(7); I.w_up = KA_IN(8); I.w_down = KA_IN(9); I.w_router = KA_IN(10); I.mw_gate = KA_IN(11); I.mw_up = KA_IN(12); I.mw_down = KA_IN(13); \
    float* const out = (float*)*(float* const volatile __attribute__((address_space(4)))*)&ka->out; (void)out; (void)I; RELAUNDER()
#define RELAUNDER() do { int t_ = threadIdx.x; asm volatile("" : "+v"(t_)); F.tid = t_; F.lane = t_ & 63; } while (0)
    unsigned char* const ws = args.ws;
    for (int u = F.tid; u < (LDS_BYTES - LDSCTL_OFF) / 4; u += NWAVES * 64) ((LAS unsigned*)(F.lds + LDSCTL_OFF))[u] = 0u;
    __syncthreads();
    XcdBarrier bar; bar.bar = (unsigned*)(F.ctl + CW_BAR); bar.x = 0; bar.st = nullptr;
#if !MK_PER_PHASE
    bar = xcd_barrier_post((unsigned*)(F.ctl + CW_BAR), F.MISC + 8);
#endif
    const int lo = args.ph_lo, hi = args.ph_hi;
#define IN(k) (lo <= (k) && (k) < hi)
#ifndef MK_REPEAT
#define MK_REPEAT (-1)
#endif
#define PHASE(k) for (int rep_ = 0; rep_ < ((MK_REPEAT == (k)) ? 2 : 1); ++rep_) if (rep_ ? (xcd_barrier(bar), true) : true) if (IN(k))
#ifndef MK_TPROBE
#define MK_TPROBE (-1)
#endif
    unsigned long long tp0_ = (MK_TPROBE >= 0) ? __builtin_amdgcn_s_memrealtime() : 0ull, tp1_ = tp0_;
#define SEAM(k) do { if (IN(k) && IN((k) + 1)) { xcd_barrier(bar); } if (MK_TPROBE >= 0) { if ((k) == MK_TPROBE - 1) tp0_ = __builtin_amdgcn_s_memrealtime(); if ((k) == MK_TPROBE) tp1_ = __builtin_amdgcn_s_memrealtime(); } } while (0)
    const int cblk = (int)blockIdx.x;


    PHASE(PH_MIX0) { LOAD_IN();
        p0_prologue<0>(F, I); pro_publish(F);
        if (cblk & 1) { p0_prologue<1>(F, I); __syncthreads(); }
        mix0_phase(F, I, (bf16*)(ws + WS_XR));
        RELAUNDER();
        if (!(cblk & 1)) p0_prologue<1>(F, I); } SEAM(PH_MIX0);

    PHASE(PH_GU0) {
      LOAD_IN();
      for (int pass = 0; pass < 2; ++pass) {
        if ((pass == 0) == ((cblk & 1) == 0)) { moe_conv_share(F, I); __syncthreads(); continue; }
#if MK_FFN0_FP8
        pg8::GemmK g{D / 2, D / 2, D / 2};
        pg8::DenseOrder S{T / 256, FF0 / 128, (T / 256) * (FF0 / 128), F.G, cblk, (const char*)(ws + WS_H), (const char*)(ws + WS_WGU0), (size_t)256 * D, 0, (size_t)256 * D};
        typedef pg8::EpiSwiGLU8<(int)WGU_PRESCALE> EpiGU8;
        EpiGU8 E{ws + WS_ACT0, FF0};
        pg8::gemm_phase<EpiGU8, pg8::DenseOrder, true, true>(F.lds + RING_OFF, g, S, E);
#else
        pg8::GemmK g{D, D, D};
        pg8::DenseOrder S{T / 256, FF0 / 128, (T / 256) * (FF0 / 128), F.G, cblk, (const char*)(ws + WS_H), (const char*)(ws + WS_WGU0), (size_t)256 * D * 2, 0, (size_t)256 * D * 2};
#if MK_FFN0_DN_FP8
        typedef pg8::EpiSwiGLU8<1> EpiGUf8;
        EpiGUf8 E{ws + WS_ACT0, FF0};
        pg8::gemm_phase<EpiGUf8, pg8::DenseOrder, true>(F.lds + RING_OFF, g, S, E);
#else
        pg8::EpiSwiGLU E{(bf16*)(ws + WS_ACT0), FF0};
        pg8::gemm_phase<pg8::EpiSwiGLU, pg8::DenseOrder, true>(F.lds + RING_OFF, g, S, E);
#endif
#endif
        __syncthreads();
      }
    } SEAM(PH_GU0);

    PHASE(PH_DN0) {
#if MK_FFN0_DNF8
        pg8::GemmK g{FF0 / 2, FF0 / 2, FF0 / 2};
        pg8::DenseOrder S{T / 256, D / 256, (T / 256) * (D / 256), F.G, cblk, (const char*)(ws + WS_ACT0), (const char*)(ws + WS_WD0), (size_t)256 * FF0, 0, (size_t)256 * FF0};
        pg8::EpiBf16 E{(bf16*)(ws + WS_YB), D, nullptr, 0, 0, 1.0f / WD_PRESCALE};
        pg8::gemm_phase<pg8::EpiBf16, pg8::DenseOrder, true, true>(F.lds + RING_OFF, g, S, E);
#else
        pg8::GemmK g{FF0, FF0, FF0};
        pg8::DenseOrder S{T / 256, D / 256, (T / 256) * (D / 256), F.G, cblk, (const char*)(ws + WS_ACT0), (const char*)(ws + WS_WD0), (size_t)256 * FF0 * 2, 0, (size_t)256 * FF0 * 2};
        pg8::EpiBf16 E{(bf16*)(ws + WS_YB), D, nullptr, 0, 0, 1.f};
        pg8::gemm_phase<pg8::EpiBf16, pg8::DenseOrder, true>(F.lds + RING_OFF, g, S, E);
#endif
    } SEAM(PH_DN0);

    PHASE(PH_THB) { LOAD_IN(); thin_phase<1>(F, I, (const bf16*)(ws + WS_YB), (bf16*)(ws + WS_XR), I.norm_g + 3 * D, I.norm_g + 4 * D); } SEAM(PH_THB);

    PHASE(PH_QKV) {
        RELAUNDER();
        for (int un = cblk; un < BATCH * NH * 4; un += F.G) scan_phase(F, un);
        pg8::GemmK g{D, D, D};
        pg8::DenseOrder S{T / 256, 12, (T / 256) * 12, F.G, cblk, (const char*)(ws + WS_H), (const char*)(ws + WS_WIN), (size_t)256 * D * 2, 0, (size_t)256 * D * 2};
        pg8::EpiQKV E{(bf16*)(ws + WS_Q), D, (size_t)(WS_K - WS_Q) / 2, attn_body::C2, (float*)(ws + WS_NRM), (float*)(ws + WS_NRM) + 256 * 32, (float*)(ws + WS_KBAR)};
        pg8::gemm_phase<pg8::EpiQKV, pg8::DenseOrder, true>(F.lds + RING_OFF, g, S, E);
    } SEAM(PH_QKV);

    PHASE(PH_ATT) {
        RELAUNDER();
        auto tstart_of = [&](const unsigned cur) __attribute__((always_inline)) -> int {
            const int qb = 31 - (int)(cur >> 6), bh = (int)(cur & 63u), q0 = qb * 256, NT = (q0 + 256) / 64;
            const float* ncs = (const float*)(ws + WS_NCS) + (size_t)bh * SEQ;
            const bool hasq = qb > 0; const int j = 2 * F.lane + 1; const bool inr = (j + 5 <= NT); const int jc = inr ? j : 1;
            const float* nqp = (const float*)(ws + WS_NRM) + (size_t)((bh >> 4) * 64 + (F.lane >> 1)) * 32 + (bh & 15) * 2 + (F.lane & 1);
            const float l_mk0 = nqp[256 * 32], l_mk1 = nqp[256 * 32 + 32 * 32];
            const float l_mq = ((const float*)(ws + WS_NRM))[(size_t)(((bh >> 4) * 32 + qb) * 2 + ((F.lane >> 1) & 1)) * 32 + (bh & 15) * 2 + (F.lane & 1)];
            const float* kbp = (const float*)(ws + WS_KBAR) + ((size_t)((bh >> 4) * 128 + (hasq ? qb * 4 - 1 : 0)) * 16 + (bh & 15)) * 2; const float l_kb0 = kbp[0], l_kb1 = kbp[1];
            const float l_ms = ncs[(hasq ? q0 - 64 : 0) + F.lane], l_nq = ncs[q0], l_nk = ncs[64 * jc + 63], l_ne = ncs[64 * jc - 1];
            const float* qt = (const float*)(ws + WS_QTOT) + bh * 4; const float qo1 = qt[0], qo2 = qo1 + qt[1], qo3 = qo2 + qt[2];
            float mq = l_mq, mk = fmaxf(l_mk0, l_mk1), ms = l_ms;
#pragma unroll
            for (int o = 1; o < 64; o <<= 1) { mq = fmaxf(mq, __shfl_xor(mq, o)); mk = fmaxf(mk, __shfl_xor(mk, o)); ms += __shfl_xor(ms, o); }
            const float theta = 4.08f * mq * mk + 40.f, theta1 = 2.04f * mq * mk + 40.f;
            float dm = -INFINITY;
            if (hasq) { const int sq = (q0 - 64) >> 11; dm = 6.f + ms * (1.f / 64.f) + (sq == 0 ? 0.f : (sq == 1 ? qo1 : (sq == 2 ? qo2 : qo3))) - 1.02f * 1.41422f * mq * (sqrtf(l_kb0 + l_kb1) + 0.01f * 1.41422f * mk); }
            bool skip = false; float wj = 0.f, nqv = 0.f;
            { const int sq = q0 >> 11, sk = (64 * jc + 63) >> 11, se = (64 * jc - 1) >> 11;
              const float nq = l_nq + (sq == 0 ? 0.f : (sq == 1 ? qo1 : (sq == 2 ? qo2 : qo3))), nk = l_nk + (sk == 0 ? 0.f : (sk == 1 ? qo1 : (sk == 2 ? qo2 : qo3)));
              const float ne = l_ne + (se == 0 ? 0.f : (se == 1 ? qo1 : (se == 2 ? qo2 : qo3)));
              if (inr) { skip = (nq - nk) >= theta || (dm - nk) >= theta1; wj = exp2f(nk - nq) + exp2f(ne - nq); nqv = nq; } }
            { float P = wj;
#pragma unroll
              for (int o = 1; o < 64; o <<= 1) { const float t = __shfl_up(P, o); if (F.lane >= o) P += t; }
              if (inr) skip = skip || (dm - nqv - log2f(P)) >= (theta1 - 7.f); }
            return 2 * (int)__popcll(__ballot(skip));
        };
        gu32* const tsw = F.ctl + CW_TS;
        for (unsigned u = (unsigned)(F.vcu * NWAVES + F.wave); u < (unsigned)(BATCH * NH * 32); u += (unsigned)(F.G * NWAVES)) {
            const int ts = tstart_of(u); if (F.lane == 0) __hip_atomic_store(tsw + u, (unsigned)ts + 1u, __ATOMIC_RELAXED, __HIP_MEMORY_SCOPE_AGENT); }
        unsigned nxt = 0u, nx2 = 0u, tsn = 0u;
        if (F.tid == 0) { const unsigned a = __hip_atomic_fetch_add(F.ctl + CW_AQ + 64 * rep_, 2u, RLX_AGENT); unsigned t0 = 1u;
            if (a < (unsigned)(BATCH * NH * 32)) { unsigned sp = 0u; do { t0 = __hip_atomic_load(tsw + a, RLX_AGENT); } while (t0 == 0u && ++sp < (1u << 22)); if (t0 == 0u) t0 = 1u; }
            F.MISC[11] = a; F.MISC[21] = t0; nxt = a + 1u; }
        __syncthreads();
        unsigned cur = (unsigned)__builtin_amdgcn_readfirstlane((int)F.MISC[11]); int tstart = __builtin_amdgcn_readfirstlane((int)F.MISC[21]) - 1;
        while (cur < (unsigned)(BATCH * NH * 32)) {
            if (F.tid == 0) { nx2 = __hip_atomic_fetch_add(F.ctl + CW_AQ + 64 * rep_, 1u, RLX_AGENT); tsn = nxt < (unsigned)(BATCH * NH * 32) ? __hip_atomic_load(tsw + nxt, RLX_AGENT) : 1u; }
            const int qb = 31 - (int)(cur >> 6), bh = (int)(cur & 63u);
            attn_body::attn_unit<24>(bh / NH, bh % NH, qb, tstart, (const attn_body::bf16*)(ws + WS_Q), (const attn_body::bf16*)(ws + WS_K), (const attn_body::bf16*)(ws + WS_V), (attn_body::bf16*)(ws + WS_H),
                                     (const float*)(ws + WS_NCS), (const float*)(ws + WS_QTOT) + bh * 4, (char*)lds + RING_OFF);
            if (F.tid == 0) { if (nxt < (unsigned)(BATCH * NH * 32)) { unsigned sp = 0u; while (tsn == 0u && ++sp < (1u << 22)) tsn = __hip_atomic_load(tsw + nxt, RLX_AGENT); if (tsn == 0u) tsn = 1u; }
                F.MISC[11] = nxt; F.MISC[21] = tsn; nxt = nx2; }
            __syncthreads();
            cur = (unsigned)__builtin_amdgcn_readfirstlane((int)F.MISC[11]); tstart = __builtin_amdgcn_readfirstlane((int)F.MISC[21]) - 1;
        }
    } SEAM(PH_ATT);

    PHASE(PH_WO) {
        pg8::GemmK g{D, D, D};
        pg8::DenseOrder S{T / 256, D / 256, (T / 256) * (D / 256), F.G, cblk, (const char*)(ws + WS_H), (const char*)(ws + WS_WOUT), (size_t)256 * D * 2, 0, (size_t)256 * D * 2};
        pg8::EpiBf16 E{(bf16*)(ws + WS_YATT), D, nullptr, 0, 0, 1.f};
        pg8::gemm_phase<pg8::EpiBf16, pg8::DenseOrder, true>(F.lds + RING_OFF, g, S, E);
    } SEAM(PH_WO);

    PHASE(PH_THC) { LOAD_IN(); thin_phase<2>(F, I, (const bf16*)(ws + WS_YATT), (bf16*)(ws + WS_XR), I.norm_g + 5 * D, I.norm_g + 6 * D); } SEAM(PH_THC);


    if (hi > PH_MOE && lo < PH_FIN) {
        RELAUNDER();
        moe_offsets(F);
        const int nRT = __builtin_amdgcn_readfirstlane((int)F.MISC[10]);
        for (int c = 0; c < MAXCHUNK; ++c) {
            const int rt0 = c * CHUNK_RT; int nM = nRT - rt0; if (c == 0 && nM > CHUNK_RT) nM = CHUNK_RT;
            PHASE(PH_MOE + 2 * c) if (nM > 0) {
                pg8::GemmK g{D / 2, D / 2, D / 2};
                typedef pg8::MoeOrder<FFE / 128, 0, 0, (size_t)2 * FFE * D, (size_t)256 * D, 0> OrdGU;
                OrdGU S{rt0, nM, F.G, cblk, (const char*)(ws + WS_H), (const char*)(ws + WS_WGU), (const LAS unsigned*)(F.lds + MISC_OFF + 48)};
                typedef pg8::EpiSwiGLU8<(int)WGU_PRESCALE> EpiGU8;
                EpiGU8 E{ws + WS_ACTC, FFE};
                pg8::gemm_phase<EpiGU8, OrdGU, true, true, true>(F.lds + RING_OFF, g, S, E, (long)WS_RIDX - (long)WS_H);
            }
            SEAM(PH_MOE + 2 * c);
            PHASE(PH_MOE + 2 * c + 1) if (nM > 0) {
                pg8::GemmK g{FFE / 2, FFE / 2, FFE / 2};
                typedef pg8::MoeOrder<D / 256, (size_t)256 * FFE, 1, (size_t)D * FFE, (size_t)256 * FFE, 1> OrdDN;
                OrdDN S{rt0, nM, F.G, cblk, (const char*)(ws + WS_ACTC), (const char*)(ws + WS_WD), (const LAS unsigned*)(F.lds + MISC_OFF + 48)};
                pg8::EpiFp8 E{ws + WS_YS, D, 1.0f / WD_PRESCALE};
                pg8::gemm_phase<pg8::EpiFp8, OrdDN, true, true>(F.lds + RING_OFF, g, S, E);
            }
            SEAM(PH_MOE + 2 * c + 1);
        }
    }

    PHASE(PH_FIN) { LOAD_IN(); final_phase(F, I, out); }
    if (MK_TPROBE >= 0) { if (MK_TPROBE == PH_FIN) { asm volatile("s_waitcnt vmcnt(0)" ::: "memory"); tp1_ = __builtin_amdgcn_s_memrealtime(); }
        if (blockIdx.x == 0) { const unsigned long long t_ = __builtin_amdgcn_s_memrealtime(), d_ = 4ull * (tp1_ - tp0_); while (__builtin_amdgcn_s_memrealtime() - t_ < d_) __builtin_amdgcn_s_sleep(8); } }
#undef IN
#undef SEAM
}

extern "C" void kernel_launch(void* const* d_in, const int* in_sizes, int n_in, void* d_out, int out_size, void* d_ws, size_t ws_size, hipStream_t stream) {
    static int grid = 0;
    if (grid == 0) {
        if (n_in != 14 || in_sizes[0] != T * D || out_size != T * D || ws_size < WS_END) { fprintf(stderr, "kernel_launch: unexpected shapes (n_in %d, in0 %d, out %d, ws %zu); nothing launched\n", n_in, n_in > 0 ? in_sizes[0] : -1, out_size, ws_size); grid = -1; return; }
        int dev = 0, cus = 0, per_cu = 0;
        if (hipGetDevice(&dev) != hipSuccess || hipDeviceGetAttribute(&cus, hipDeviceAttributeMultiprocessorCount, dev) != hipSuccess) { grid = -1; return; }
        if (hipFuncSetAttribute((const void*)trunk_fwd, hipFuncAttributeMaxDynamicSharedMemorySize, LDS_BYTES) != hipSuccess) { fprintf(stderr, "kernel_launch: hipFuncSetAttribute failed\n"); grid = -1; return; }
        if (hipOccupancyMaxActiveBlocksPerMultiprocessor(&per_cu, (const void*)trunk_fwd, NWAVES * 64, LDS_BYTES) != hipSuccess || per_cu < 1)
            fprintf(stderr, "kernel_launch: note: occupancy query reports %d workgroups per CU\n", per_cu);
        (void)hipGetLastError();
        grid = cus;
    }
    if (grid < 0) return;
    if (hipMemsetAsync((char*)d_ws + WS_CTL, 0, CTL_ZERO_BYTES, stream) != hipSuccess) return;
    Args a{};
    for (int i = 0; i < 14; ++i) a.in[i] = (const float*)d_in[i];
    a.out = (float*)d_out; a.ws = (unsigned char*)d_ws;
#if MK_PER_PHASE
    for (int p = 0; p < MK_LAST_PHASE; ++p) { a.ph_lo = p; a.ph_hi = p + 1; hipLaunchKernelGGL(trunk_fwd, dim3(grid), dim3(NWAVES * 64), LDS_BYTES, stream, a); }
#else
    a.ph_lo = 0; a.ph_hi = MK_LAST_PHASE;
    hipLaunchKernelGGL(trunk_fwd, dim3(grid), dim3(NWAVES * 64), LDS_BYTES, stream, a);
#endif
}
```

```cpp
#include <hip/hip_runtime.h>
#include <hip/hip_bf16.h>
#include <cstdio>
#include <cstdint>
#include <cmath>

#ifndef MK_PER_PHASE
#define MK_PER_PHASE 0
#endif
#ifndef MK_FFN0_DN_FP8
#define MK_FFN0_DN_FP8 1
#endif
#define MK_FFN0_DNF8 (MK_FFN0_FP8 || MK_FFN0_DN_FP8)
#ifndef MK_FFN0_FP8
#define MK_FFN0_FP8 0
#endif
#ifndef MK_LAST_PHASE
#define MK_LAST_PHASE 15
#endif

namespace pg8 {
#define PG8_LAS __attribute__((address_space(3)))
typedef unsigned short bf16_t;
typedef short bf16x8 __attribute__((ext_vector_type(8)));
typedef float f32x4 __attribute__((ext_vector_type(4)));
typedef unsigned u32x4 __attribute__((ext_vector_type(4)));
constexpr int BM = 256, BK = 64, HALF = 128, HTB = HALF * BK * 2, STAGE_BYTES = 8 * HTB, NXCD = 8, WGM = 8;

__host__ __device__ __forceinline__ int lds_byte(int r, int c) { const int st = (r >> 4) * 2 + (c >> 5), rr = r & 15, cc = c & 31, ob = rr * 64 + cc * 2; return st * 1024 + (ob ^ (((ob >> 9) & 1) << 5)); }
__host__ __device__ __forceinline__ void stage_rc(int b, int& R, int& C) { const int st = b / 1024, sb = b % 1024, swz = sb ^ (((sb >> 9) & 1) << 5); R = (st >> 1) * 16 + swz / 64; C = (st & 1) * 32 + (swz % 64) / 2; }
__host__ __device__ __forceinline__ int perm32(int rho) { const int n = rho >> 4, i = rho & 15; return 8 * (i >> 2) + 4 * n + (i & 3); }

struct Unit { int pm, pn; const char* A; const char* B; int arow; };
struct GemmK { int K, lda, ldb; };

__device__ __forceinline__ void tile_of(int wgid_in, int nM, int nN, int& pm, int& pn) {
    const int nwg = nM * nN; int wgid = wgid_in;
    { const int q = nwg / NXCD, r = nwg % NXCD, xcd = wgid % NXCD, off = wgid / NXCD; wgid = (xcd < r ? xcd * (q + 1) : r * (q + 1) + (xcd - r) * q) + off; }
    const int nig = WGM * nN, gid = wgid / nig, fm = gid * WGM, gsz = (nM - fm) < WGM ? (nM - fm) : WGM;
    pm = fm + ((wgid % nig) % gsz); pn = (wgid % nig) / gsz;
}
struct DenseOrder {
    int nM, nN, nwg, G, c; const char* A; const char* B; size_t a_tile, a_pn, b_tile;
    __device__ __forceinline__ bool next(int i, Unit& u) const {
        const int L = i * G + c; if (L >= nwg) return false;
        int pm, pn; tile_of(L, nM, nN, pm, pn);
        u.pm = pm; u.pn = pn; u.A = A + (size_t)pm * a_tile + (size_t)pn * a_pn; u.B = B + (size_t)pn * b_tile; u.arow = 0; return true;
    }
};
template <int NN, size_t A_TILE, int A_LOCAL, size_t B_EXP, size_t B_TILE, int PM_GLOBAL>
struct MoeOrder {
    int rt0, nM, G, c; const char* A; const char* B; const PG8_LAS unsigned* toff;
    __device__ __forceinline__ bool next(int i, Unit& u) const {
        const int L = i * G + c; if (L >= nM * NN) return false;
        int pm, pn; tile_of(L, nM, NN, pm, pn);
        const int rt = rt0 + pm; int e = 0;
#pragma unroll
        for (int j = 1; j < 8; ++j) e += ((unsigned)rt >= toff[j]) ? 1 : 0;
        e = __builtin_amdgcn_readfirstlane(e);
        u.pm = PM_GLOBAL ? rt : pm; u.pn = pn; u.A = A + (size_t)(A_LOCAL ? pm : rt) * A_TILE; u.B = B + (size_t)e * B_EXP + (size_t)pn * B_TILE; u.arow = __builtin_amdgcn_readfirstlane(e * 32768 + (rt - (int)toff[e]) * 256); return true;
    }
};

__device__ __forceinline__ unsigned cvt_pk_bf16(float lo, float hi) { unsigned r; asm volatile("v_cvt_pk_bf16_f32 %0, %1, %2" : "=v"(r) : "v"(lo), "v"(hi)); return r; }

struct EpiBf16 {
    static constexpr bool PERM = true;
    bf16_t* O; int ldc; const float* cscale; int split_cols; size_t split_stride; float scale0;
    __device__ __forceinline__ void operator()(const f32x4 (&acc)[2][2][4][2], const Unit& u, int wr, int wc, int fr, int fq) const {
        const int row0 = u.pm * BM + wr * 64 + fr; int colt = u.pn * BM; bf16_t* base = O;
        float sc = split_cols ? 1.f : scale0; if (split_cols) { const int t = colt / split_cols; base += (size_t)t * split_stride; colt -= t * split_cols; if (t == 0) sc = scale0; }
        const int col0 = colt + wc * 32 + 8 * fq, scol0 = u.pn * BM + wc * 32 + 8 * fq;
        f32x4 sv[2][2];
#pragma unroll
        for (int bj = 0; bj < 2; ++bj)
#pragma unroll
            for (int n = 0; n < 2; ++n) { sv[bj][n] = cscale ? *(const f32x4*)(cscale + scol0 + bj * HALF + 4 * n) : (f32x4){1.f, 1.f, 1.f, 1.f}; sv[bj][n] = sv[bj][n] * sc; }
#pragma unroll
        for (int ai = 0; ai < 2; ++ai)
#pragma unroll
            for (int m = 0; m < 4; ++m) { bf16_t* rowp = base + (size_t)(row0 + ai * HALF + m * 16) * ldc + col0;
#pragma unroll
                for (int bj = 0; bj < 2; ++bj) { const f32x4 v0 = acc[ai][bj][m][0] * sv[bj][0], v1 = acc[ai][bj][m][1] * sv[bj][1];
                    u32x4 w; w.x = cvt_pk_bf16(v0[0], v0[1]); w.y = cvt_pk_bf16(v0[2], v0[3]); w.z = cvt_pk_bf16(v1[0], v1[1]); w.w = cvt_pk_bf16(v1[2], v1[3]);
                    *(u32x4*)(rowp + bj * HALF) = w; } }
    }
};
#define PG8_DPPF(v, ctrl) __builtin_bit_cast(float, __builtin_amdgcn_update_dpp(0, __builtin_bit_cast(int, v), ctrl, 0xf, 0xf, true))
struct EpiQKV {
    static constexpr bool PERM = true;
    bf16_t* O; int ldc; size_t split_stride; float scale0; float* maxq; float* maxk; float* kbar;
    __device__ __forceinline__ void operator()(const f32x4 (&acc)[2][2][4][2], const Unit& u, int wr, int wc, int fr, int fq) const {
        const int row0 = u.pm * BM + wr * 64 + fr; int colt = u.pn * BM; const int t = colt >> 10; bf16_t* base = O + (size_t)t * split_stride; colt -= t << 10;
        const float sc = (t == 0) ? scale0 : 1.f;
        const int col0 = colt + wc * 32 + 8 * fq;
        float nm0 = 0.f, nm1 = 0.f;
#pragma unroll
        for (int ai = 0; ai < 2; ++ai)
#pragma unroll
            for (int m = 0; m < 4; ++m) { bf16_t* rowp = base + (size_t)(row0 + ai * HALF + m * 16) * ldc + col0;
#pragma unroll
                for (int bj = 0; bj < 2; ++bj) { const f32x4 v0 = acc[ai][bj][m][0] * sc, v1 = acc[ai][bj][m][1] * sc;
                    u32x4 w; w.x = cvt_pk_bf16(v0[0], v0[1]); w.y = cvt_pk_bf16(v0[2], v0[3]); w.z = cvt_pk_bf16(v1[0], v1[1]); w.w = cvt_pk_bf16(v1[2], v1[3]);
                    *(u32x4*)(rowp + bj * HALF) = w;
                    if (t < 2) { float s = (v0[0] * v0[0] + v0[1] * v0[1]) + (v0[2] * v0[2] + v0[3] * v0[3]) + (v1[0] * v1[0] + v1[1] * v1[1]) + (v1[2] * v1[2] + v1[3] * v1[3]);
                        s += __shfl_xor(s, 16); s += __shfl_xor(s, 32); if (bj == 0) nm0 = fmaxf(nm0, s); else nm1 = fmaxf(nm1, s); } } }
        if (t < 2) {
            { nm0 = fmaxf(nm0, PG8_DPPF(nm0, 0xB1)); nm1 = fmaxf(nm1, PG8_DPPF(nm1, 0xB1)); nm0 = fmaxf(nm0, PG8_DPPF(nm0, 0x4E)); nm1 = fmaxf(nm1, PG8_DPPF(nm1, 0x4E));
              nm0 = fmaxf(nm0, PG8_DPPF(nm0, 0x141)); nm1 = fmaxf(nm1, PG8_DPPF(nm1, 0x141)); nm0 = fmaxf(nm0, PG8_DPPF(nm0, 0x140)); nm1 = fmaxf(nm1, PG8_DPPF(nm1, 0x140)); }
            if ((threadIdx.x & 63) == 0) { float* dst = (t == 0 ? maxq : maxk) + (size_t)(u.pm * 2 + wr) * 32 + (4 * (u.pn & 3) + (wc >> 1)) * 2 + (wc & 1);
                dst[0] = sqrtf(nm0); dst[4] = sqrtf(nm1); }
        }
        if (t == 1) {
            const int ln = threadIdx.x & 63;
#pragma unroll
            for (int ai = 0; ai < 2; ++ai)
#pragma unroll
                for (int bj = 0; bj < 2; ++bj) {
                    float c[8];
#pragma unroll
                    for (int e = 0; e < 4; ++e) { c[e] = (acc[ai][bj][0][0][e] + acc[ai][bj][1][0][e]) + (acc[ai][bj][2][0][e] + acc[ai][bj][3][0][e]);
                                                  c[4 + e] = (acc[ai][bj][0][1][e] + acc[ai][bj][1][1][e]) + (acc[ai][bj][2][1][e] + acc[ai][bj][3][1][e]); }
                    { const bool up = (ln & 8) != 0;
#pragma unroll
                      for (int i = 0; i < 4; ++i) { const float send = up ? c[i] : c[i + 4], keep = up ? c[i + 4] : c[i]; c[i] = keep + PG8_DPPF(send, 0x128); } }
                    { const bool up = (ln & 4) != 0;
#pragma unroll
                      for (int i = 0; i < 2; ++i) { const float send = up ? c[i] : c[i + 2], keep = up ? c[i + 2] : c[i]; c[i] = keep + __shfl_xor(send, 4); } }
                    { const bool up = (ln & 2) != 0; const float send = up ? c[0] : c[1], keep = up ? c[1] : c[0]; c[0] = keep + PG8_DPPF(send, 0x4E); }
                    float cs = c[0]; cs += PG8_DPPF(cs, 0xB1);
                    float q2 = cs * cs;
                    { q2 += PG8_DPPF(q2, 0xB1); q2 += PG8_DPPF(q2, 0x4E); q2 += PG8_DPPF(q2, 0x141); q2 += PG8_DPPF(q2, 0x140); q2 += __shfl_xor(q2, 16); q2 += __shfl_xor(q2, 32); }
                    if (ln == 0) kbar[((size_t)(u.pm * 4 + wr + 2 * ai) * 16 + (4 * (u.pn & 3) + (wc >> 1) + 2 * bj)) * 2 + (wc & 1)] = q2 * (0.5f / 4096.f);
                }
        }
    }
};
__device__ __forceinline__ float silu_mul(float g, float u) { const float e = __builtin_amdgcn_exp2f(g * -1.4426950408889634f); return g * __builtin_amdgcn_rcpf(1.0f + e) * u; }
struct EpiSwiGLU {
    static constexpr bool PERM = true;
    bf16_t* O; int ldc;
    __device__ __forceinline__ void operator()(const f32x4 (&acc)[2][2][4][2], const Unit& u, int wr, int wc, int fr, int fq) const {
        const int row0 = u.pm * BM + wr * 64 + fr, col0 = u.pn * HALF + wc * 32 + 8 * fq;
#pragma unroll
        for (int ai = 0; ai < 2; ++ai)
#pragma unroll
            for (int m = 0; m < 4; ++m) { bf16_t* rowp = O + (size_t)(row0 + ai * HALF + m * 16) * ldc + col0;
                const f32x4 g0 = acc[ai][0][m][0], g1 = acc[ai][0][m][1], u0 = acc[ai][1][m][0], u1 = acc[ai][1][m][1];
                u32x4 w; w.x = cvt_pk_bf16(silu_mul(g0[0], u0[0]), silu_mul(g0[1], u0[1])); w.y = cvt_pk_bf16(silu_mul(g0[2], u0[2]), silu_mul(g0[3], u0[3]));
                w.z = cvt_pk_bf16(silu_mul(g1[0], u1[0]), silu_mul(g1[1], u1[1])); w.w = cvt_pk_bf16(silu_mul(g1[2], u1[2]), silu_mul(g1[3], u1[3]));
                *(u32x4*)rowp = w; }
    }
};

__device__ __forceinline__ unsigned pk4_fp8(float a, float b, float c, float d) { int w = 0; w = __builtin_amdgcn_cvt_pk_fp8_f32(a, b, w, false); w = __builtin_amdgcn_cvt_pk_fp8_f32(c, d, w, true); return (unsigned)w; }
template <int INV_ASCALE>
struct EpiSwiGLU8 {
    static constexpr bool PERM = true;
    static constexpr float ascale = 1.0f / (float)INV_ASCALE;
    unsigned char* O; int ldc;
    __device__ __forceinline__ void operator()(const f32x4 (&acc)[2][2][4][2], const Unit& u, int wr, int wc, int fr, int fq) const {
        const int row0 = u.pm * BM + wr * 64 + fr, col0 = u.pn * HALF + wc * 32 + 8 * fq;
        unsigned char* Ob = O; asm volatile("" : "+s"(Ob));
#pragma unroll
        for (int ai = 0; ai < 2; ++ai)
#pragma unroll
            for (int m = 0; m < 4; ++m) { unsigned char* rowp = Ob + (size_t)(row0 + ai * HALF + m * 16) * ldc + col0;
                const f32x4 g0 = acc[ai][0][m][0], g1 = acc[ai][0][m][1], u0 = acc[ai][1][m][0], u1 = acc[ai][1][m][1];
                constexpr float c1 = -1.4426950408889634f * ascale, ia2 = 1.0f / (ascale * ascale);
#define SM8(G, U) (((G) * (U)) * __builtin_amdgcn_rcpf(__builtin_fmaf(__builtin_amdgcn_exp2f((G) * c1), ia2, ia2)))
                typedef unsigned u32x2 __attribute__((ext_vector_type(2)));
                u32x2 w; w.x = pk4_fp8(SM8(g0[0], u0[0]), SM8(g0[1], u0[1]), SM8(g0[2], u0[2]), SM8(g0[3], u0[3]));
                w.y = pk4_fp8(SM8(g1[0], u1[0]), SM8(g1[1], u1[1]), SM8(g1[2], u1[2]), SM8(g1[3], u1[3]));
#undef SM8
                *(__attribute__((address_space(1))) u32x2*)rowp = w; }
    }
};

struct EpiFp8 {
    static constexpr bool PERM = true;
    unsigned char* O; int ldc; float scale;
    __device__ __forceinline__ void operator()(const f32x4 (&acc)[2][2][4][2], const Unit& u, int wr, int wc, int fr, int fq) const {
        const int row0 = u.pm * BM + wr * 64 + fr, col0 = u.pn * BM + wc * 32 + 8 * fq;
        typedef unsigned u32x2 __attribute__((ext_vector_type(2)));
#pragma unroll
        for (int ai = 0; ai < 2; ++ai)
#pragma unroll
            for (int m = 0; m < 4; ++m) { unsigned char* rowp = O + (size_t)(row0 + ai * HALF + m * 16) * ldc + col0;
#pragma unroll
                for (int bj = 0; bj < 2; ++bj) { const f32x4 v0 = acc[ai][bj][m][0] * scale, v1 = acc[ai][bj][m][1] * scale;
                    u32x2 w; w.x = pk4_fp8(v0[0], v0[1], v0[2], v0[3]); w.y = pk4_fp8(v1[0], v1[1], v1[2], v1[3]); *(u32x2*)(rowp + bj * HALF) = w; } }
    }
};

typedef int v4i_t __attribute__((ext_vector_type(4)));
typedef int v8i_t __attribute__((ext_vector_type(8)));
__device__ __forceinline__ v8i_t cat8(bf16x8 lo, bf16x8 hi) { const v4i_t a = __builtin_bit_cast(v4i_t, lo), b = __builtin_bit_cast(v4i_t, hi); return __builtin_shufflevector(a, b, 0, 1, 2, 3, 4, 5, 6, 7); }
constexpr int GATHER_IDX_OFF = 133120;
template <class Epi, class Sched, bool ALIGN_EPI, bool F8 = false, bool GATHER = false>
__device__ __forceinline__ void gemm_phase(PG8_LAS unsigned char* lds, const GemmK g, const Sched& S, const Epi& E, const long ridx_delta = 0) {
    int tid_ = threadIdx.x; asm volatile("" : "+v"(tid_));
    const int tid = tid_, wid = __builtin_amdgcn_readfirstlane(tid >> 6), lane = tid & 63, wr = wid >> 2, wc = wid & 3, fr = lane & 15, fq = lane >> 4;
    const int K = g.K, nt = K / BK;
    unsigned voffA[2], voffB[2];
#pragma unroll
    for (int i = 0; i < 2; ++i) { int R, C; stage_rc(tid * 16 + i * 8192, R, C); const int Rb = Epi::PERM ? ((R & ~31) + perm32(R & 31)) : R;
        voffA[i] = (unsigned)(R * g.lda + C) * 2u; voffB[i] = (unsigned)(Rb * g.ldb + C) * 2u; }
    const size_t kstep = (size_t)(BK * 2);
    const size_t hstepA = (size_t)HALF * g.lda * 2, hstepB = (size_t)HALF * g.ldb * 2;
    const unsigned ldsw = (unsigned)wid * 1024u;
    const unsigned ldswb = (unsigned)__builtin_amdgcn_readfirstlane((int)(unsigned)(uintptr_t)lds) + ldsw;
    const int aoff = lds_byte(wr * 64 + fr, fq * 8), boff = lds_byte(wc * 32 + fr, fq * 8);
#define PG8_SA(b, h) (((b) * 2 + (h)) * HTB)
#define PG8_SB(b, h) ((4 + (b) * 2 + (h)) * HTB)
#define PG8_STAGE1(bufoff, gbase, voff, I_) do { unsigned keep_; \
        asm volatile("s_mov_b32 %0, m0\n\ts_add_u32 m0, %3, %4\n\ts_nop 2\n\tglobal_load_lds_dwordx4 %1, %2\n\ts_mov_b32 m0, %0" \
            : "=&s"(keep_) : "v"((voff)[I_]), "s"((const char*)(gbase)), "s"(ldswb), "i"((bufoff) + (I_) * 8192) : "memory", "scc"); } while (0)
#define PG8_STAGE(bufoff, gbase, voff) do { PG8_STAGE1(bufoff, gbase, voff, 0); PG8_STAGE1(bufoff, gbase, voff, 1); } while (0)
    unsigned pkA[2] = {0u, 0u};
#define PG8_GVOFF(tv_, SH) do { _Pragma("unroll") for (int i_ = 0; i_ < 2; ++i_) tv_[i_] = ((pkA[i_] >> (SH)) & 0xffffu) * (unsigned)(g.lda * 2) + (voffB[i_] & (unsigned)(g.ldb * 2 - 1)); } while (0)
#define PG8_STA0(bufoff, gbase) do { if constexpr (GATHER) { unsigned tv_[2]; PG8_GVOFF(tv_, 0); PG8_STAGE(bufoff, gbase, tv_); } else PG8_STAGE(bufoff, gbase, voffA); } while (0)
#define PG8_STA1(bufoff, gbase) do { if constexpr (GATHER) { unsigned tv_[2]; PG8_GVOFF(tv_, 16); PG8_STAGE(bufoff, gbase, tv_); } else PG8_STAGE(bufoff, (gbase) + hstepA, voffA); } while (0)
#define PG8_GATHER_SET(SRC) do { int tg_ = threadIdx.x; asm volatile("" : "+v"(tg_)); _Pragma("unroll") for (int i = 0; i < 2; ++i) { int R, C; stage_rc(tg_ * 16 + i * 8192, R, C); \
        const unsigned r0_ = (SRC)[R], r1_ = (SRC)[128 + R]; pkA[i] = (r0_ & 0xffffu) | (r1_ << 16); } } while (0)
#define PG8_LDA(dst, b, h) do { _Pragma("unroll") for (int m = 0; m < 4; ++m) _Pragma("unroll") for (int k = 0; k < 2; ++k) dst[m][k] = *(const PG8_LAS bf16x8*)(lds + PG8_SA(b, h) + aoff + m * 2048 + k * 1024); } while (0)
#define PG8_LDB(dst, b, h) do { _Pragma("unroll") for (int n = 0; n < 2; ++n) _Pragma("unroll") for (int k = 0; k < 2; ++k) dst[n][k] = *(const PG8_LAS bf16x8*)(lds + PG8_SB(b, h) + boff + n * 2048 + k * 1024); } while (0)
#define PG8_MMA(ai, bj, At, Bt) do { __builtin_amdgcn_s_setprio(1); if constexpr (F8) { _Pragma("unroll") for (int m = 0; m < 4; ++m) _Pragma("unroll") for (int n = 0; n < 2; ++n) \
        acc[ai][bj][m][n] = __builtin_amdgcn_mfma_scale_f32_16x16x128_f8f6f4(cat8(Bt[n][0], Bt[n][1]), cat8(At[m][0], At[m][1]), acc[ai][bj][m][n], 0, 0, 0, 0, 0, 0); } \
        else { _Pragma("unroll") for (int m = 0; m < 4; ++m) _Pragma("unroll") for (int n = 0; n < 2; ++n) _Pragma("unroll") for (int k = 0; k < 2; ++k) \
        acc[ai][bj][m][n] = __builtin_amdgcn_mfma_f32_16x16x32_bf16(Bt[n][k], At[m][k], acc[ai][bj][m][n], 0, 0, 0); } __builtin_amdgcn_s_setprio(0); } while (0)
#define PG8_WAIT_V(n) asm volatile("s_waitcnt vmcnt(" #n ")" ::: "memory")
#define PG8_WAIT_L(n) asm volatile("s_waitcnt lgkmcnt(" #n ")" ::: "memory")
#define PG8_BAR __builtin_amdgcn_s_barrier()
#define PG8_SCHED __builtin_amdgcn_sched_barrier(0)
    Unit cur, nxt; int ui = 0;
    if (!S.next(0, cur)) return;
    f32x4 acc[2][2][4][2];
#define PG8_ZERO_ACC() do { _Pragma("unroll") for (int a = 0; a < 2; ++a) _Pragma("unroll") for (int b = 0; b < 2; ++b) _Pragma("unroll") for (int m = 0; m < 4; ++m) _Pragma("unroll") for (int n = 0; n < 2; ++n) { \
        f32x2z lo_, hi_; asm volatile("v_mov_b64 %0, 0" : "=v"(lo_)); asm volatile("v_mov_b64 %0, 0" : "=v"(hi_)); acc[a][b][m][n] = (f32x4){lo_[0], lo_[1], hi_[0], hi_[1]}; } } while (0)
    typedef float f32x2z __attribute__((ext_vector_type(2)));
    PG8_ZERO_ACC();
    bf16x8 At[4][2], B0[2][2], B1[2][2];
    const char* cA = cur.A; const char* cB = cur.B;
    if constexpr (GATHER) { const unsigned* src_ = (const unsigned*)(cA + ridx_delta) + cur.arow; PG8_GATHER_SET(src_); }
    PG8_STAGE(PG8_SB(0, 0), cB, voffB); PG8_STAGE(PG8_SB(0, 1), cB + hstepB, voffB); PG8_STA0(PG8_SA(0, 0), cA); PG8_STA1(PG8_SA(0, 1), cA);
    if (wr == 1) PG8_BAR;
    PG8_WAIT_V(2); PG8_BAR;
    PG8_STAGE(PG8_SB(1, 0), cB + kstep, voffB); PG8_STA0(PG8_SA(1, 0), cA + kstep); PG8_STAGE(PG8_SB(1, 1), cB + hstepB + kstep, voffB);
    PG8_WAIT_V(6); PG8_BAR;
    for (;;) {
        const bool has_next = S.next(ui + 1, nxt);
        const char* nA = has_next ? nxt.A : cA; const char* nB = has_next ? nxt.B : cB;
        if constexpr (GATHER) { if (has_next && wid < 4) { unsigned keep_; int tl_ = threadIdx.x; asm volatile("" : "+v"(tl_)); const unsigned vo_ = (unsigned)tl_ * 4u;
            asm volatile("s_mov_b32 %0, m0\n\ts_mov_b32 m0, %3\n\ts_nop 2\n\tglobal_load_lds_dword %1, %2\n\ts_mov_b32 m0, %0"
                : "=&s"(keep_) : "v"(vo_), "s"((const char*)((const unsigned*)(nA + ridx_delta) + nxt.arow)), "s"(ldswb - (unsigned)wid * 768u + (unsigned)GATHER_IDX_OFF) : "memory"); } }
#pragma unroll 1
        for (int t = 0; t < nt; t += 2) {
            const bool last = (t == nt - 2);
            const char* a1 = cA + (size_t)(t + 1) * kstep;
            const char* a2 = last ? nA : cA + (size_t)(t + 2) * kstep; const char* b2 = last ? nB : cB + (size_t)(t + 2) * kstep;
            const char* a3 = a2 + kstep; const char* b3 = b2 + kstep;
            PG8_LDB(B0, 0, 0); PG8_LDB(B1, 0, 1); PG8_SCHED; PG8_LDA(At, 0, 0); PG8_STA1(PG8_SA(1, 1), a1);
            PG8_WAIT_V(8); PG8_WAIT_L(0); PG8_BAR; PG8_MMA(0, 0, At, B0); PG8_MMA(0, 1, At, B1); PG8_BAR; PG8_SCHED;
            if constexpr (GATHER) { if (last) { const PG8_LAS unsigned* li_ = (const PG8_LAS unsigned*)(lds + GATHER_IDX_OFF); PG8_GATHER_SET(li_); } }
            PG8_LDA(At, 0, 1); PG8_STAGE(PG8_SB(0, 0), b2, voffB); PG8_STAGE(PG8_SB(0, 1), b2 + hstepB, voffB); PG8_STA0(PG8_SA(0, 0), a2);
            PG8_WAIT_V(8); PG8_WAIT_L(0); PG8_BAR; PG8_MMA(1, 0, At, B0); PG8_MMA(1, 1, At, B1); PG8_BAR; PG8_SCHED;
            PG8_LDB(B0, 1, 0); PG8_LDB(B1, 1, 1); PG8_SCHED; PG8_LDA(At, 1, 0); PG8_STA1(PG8_SA(0, 1), a2);
            PG8_WAIT_V(8); PG8_WAIT_L(0); PG8_BAR; PG8_MMA(0, 0, At, B0); PG8_MMA(0, 1, At, B1); PG8_BAR; PG8_SCHED;
            PG8_LDA(At, 1, 1); PG8_STAGE(PG8_SB(1, 0), b3, voffB); PG8_STAGE(PG8_SB(1, 1), b3 + hstepB, voffB); PG8_STA0(PG8_SA(1, 0), a3);
            PG8_WAIT_V(8); PG8_WAIT_L(0); PG8_BAR; PG8_MMA(1, 0, At, B0); PG8_MMA(1, 1, At, B1); PG8_BAR; PG8_SCHED;
        }
        if constexpr (ALIGN_EPI) { if (wr == 0) PG8_BAR; }
        { int te_ = threadIdx.x; asm volatile("" : "+v"(te_));
          E(acc, cur, wr, wc, te_ & 15, (te_ >> 4) & 3); }
        if (!has_next) break;
        PG8_ZERO_ACC();
        cur = nxt; cA = nA; cB = nB; ++ui;
        if constexpr (ALIGN_EPI) { if (wr == 1) PG8_BAR; }
    }
    PG8_WAIT_V(0);
    if constexpr (!ALIGN_EPI) { if (wr == 0) PG8_BAR; }
    PG8_BAR;
#undef PG8_SA
#undef PG8_SB
#undef PG8_STAGE
#undef PG8_STAGE1
#undef PG8_STA0
#undef PG8_STA1
#undef PG8_GATHER_SET
#undef PG8_GVOFF
#undef PG8_LDA
#undef PG8_LDB
#undef PG8_MMA
#undef PG8_ZERO_ACC
#undef PG8_WAIT_V
#undef PG8_WAIT_L
#undef PG8_BAR
#undef PG8_SCHED
}
}

namespace attn_body {
using bf16=__hip_bfloat16;
using bf16x8=__attribute__((ext_vector_type(8)))short;
using s16x4=__attribute__((ext_vector_type(4)))short;
using f32x16=__attribute__((ext_vector_type(16)))float;
using f32x4v=__attribute__((ext_vector_type(4)))float;
using u32x4=__attribute__((ext_vector_type(4)))unsigned;
constexpr int BATCH=4,NHEAD=16,SEQ=8192,D=64,DM=NHEAD*D;
constexpr int NW=8,QBLK=32,QB=QBLK*NW,KVBLK=64,NQB=SEQ/QB;
__device__ __forceinline__ int crow(int r,int hi){return (r&3)+8*(r>>2)+4*hi;}
#define SBAR() __builtin_amdgcn_sched_barrier(0)
__device__ __forceinline__ void cmask(f32x16&p0,f32x16&p1,int jb,int qrel,int hi){
  const float NEG=-INFINITY; int kb=64*jb+4*hi;
  #pragma unroll
  for(int r=0;r<16;++r){int kv=kb+(r&3)+8*(r>>2); if(kv>qrel)p0[r]=NEG; if(kv+32>qrel)p1[r]=NEG;}
}
constexpr int NSLOT=3, SLOTB=8192;
constexpr int LDS_K=0, LDS_V=NSLOT*SLOTB, LDS_WS=2*NSLOT*SLOTB, LDS_OST=LDS_WS+NW*64*4, LDS_CS=LDS_OST+NW*4096, LDS_BYTES=LDS_CS+SEQ*4;
constexpr float C2=0.125f*1.4426950408889634f;
__device__ __forceinline__ void glds16(const void*gsrc,unsigned lds_dst){unsigned keep;
  asm volatile("s_mov_b32 %0, m0\n\ts_mov_b32 m0, %2\n\ts_nop 0\n\tglobal_load_lds_dwordx4 %1, off\n\ts_mov_b32 m0, %0":"=&s"(keep):"v"(gsrc),"s"(lds_dst):"memory");}
__device__ __forceinline__ float max3f(float a,float b,float c){float r;asm("v_max3_f32 %0, %1, %2, %3":"=v"(r):"v"(a),"v"(b),"v"(c));return r;}
__device__ __forceinline__ float max2f(float a,float b){float r;asm("v_max_f32_e32 %0, %1, %2":"=v"(r):"v"(a),"v"(b));return r;}
__device__ __forceinline__ float fadd_s(float a,float b){float r;asm("v_add_f32_e32 %0, %1, %2":"=v"(r):"v"(a),"v"(b));return r;}
__device__ __forceinline__ float fsub_s(float a,float b){float r;asm("v_sub_f32_e32 %0, %1, %2":"=v"(r):"v"(a),"v"(b));return r;}
typedef float f32x2_t __attribute__((ext_vector_type(2))); typedef __bf16 bf16x2_t __attribute__((ext_vector_type(2)));
__device__ __forceinline__ unsigned cvtpk_s(float lo,float hi){f32x2_t v={lo,hi};bf16x2_t b=__builtin_convertvector(v,bf16x2_t);return __builtin_bit_cast(unsigned,b);}
#define WAIT_BAR(N) asm volatile("s_waitcnt vmcnt(" #N ") lgkmcnt(0)\n\ts_barrier":::"memory")
typedef __attribute__((address_space(3))) const char* lds_cptr;
typedef short v4i16_t __attribute__((ext_vector_type(4)));
__device__ __forceinline__ void ldbias(f32x16&c0,f32x16&c1,lds_cptr csp,float negm){
  #pragma unroll
  for(int g=0;g<4;++g){ const f32x4v a=*(const __attribute__((address_space(3))) f32x4v*)(csp+g*32); const f32x4v b=*(const __attribute__((address_space(3))) f32x4v*)(csp+128+g*32);
    c0[4*g]=a[0]+negm;c0[4*g+1]=a[1]+negm;c0[4*g+2]=a[2]+negm;c0[4*g+3]=a[3]+negm; c1[4*g]=b[0]+negm;c1[4*g+1]=b[1]+negm;c1[4*g+2]=b[2]+negm;c1[4*g+3]=b[3]+negm; }
}
__device__ __forceinline__ void ldbias0(f32x16&c0,f32x16&c1,lds_cptr csp){
  #pragma unroll
  for(int g=0;g<4;++g){ const f32x4v a=*(const __attribute__((address_space(3))) f32x4v*)(csp+g*32); const f32x4v b=*(const __attribute__((address_space(3))) f32x4v*)(csp+128+g*32);
    c0[4*g]=a[0];c0[4*g+1]=a[1];c0[4*g+2]=a[2];c0[4*g+3]=a[3]; c1[4*g]=b[0];c1[4*g+1]=b[1];c1[4*g+2]=b[2];c1[4*g+3]=b[3]; }
}
__device__ __forceinline__ void qkt(f32x16&p0,f32x16&p1,const char*Kslot,const bf16x8*qr,int r32,int hi){
  const char*kb=Kslot+hi*1024+r32*16;
  #pragma unroll
  for(int d0=0;d0<4;++d0){
    const bf16x8 b0=*reinterpret_cast<const bf16x8*>(kb+d0*2048);
    const bf16x8 b1=*reinterpret_cast<const bf16x8*>(kb+d0*2048+512);
    p0=__builtin_amdgcn_mfma_f32_32x32x16_bf16(b0,qr[d0],p0,0,0,0);p1=__builtin_amdgcn_mfma_f32_32x32x16_bf16(b1,qr[d0],p1,0,0,0);}
}
__device__ __forceinline__ void kload8(bf16x8*kf,lds_cptr kp){
  kf[0]=*(const __attribute__((address_space(3))) bf16x8*)(kp);      kf[1]=*(const __attribute__((address_space(3))) bf16x8*)(kp+512);
  kf[2]=*(const __attribute__((address_space(3))) bf16x8*)(kp+2048); kf[3]=*(const __attribute__((address_space(3))) bf16x8*)(kp+2560);
  kf[4]=*(const __attribute__((address_space(3))) bf16x8*)(kp+4096); kf[5]=*(const __attribute__((address_space(3))) bf16x8*)(kp+4608);
  kf[6]=*(const __attribute__((address_space(3))) bf16x8*)(kp+6144); kf[7]=*(const __attribute__((address_space(3))) bf16x8*)(kp+6656);
}
__device__ __forceinline__ void kload2(bf16x8*kf,lds_cptr kp,int j){ kf[2*j]=*(const __attribute__((address_space(3))) bf16x8*)(kp+j*2048); kf[2*j+1]=*(const __attribute__((address_space(3))) bf16x8*)(kp+j*2048+512); }
__device__ __forceinline__ s16x4 vtr(lds_cptr p){ return __builtin_bit_cast(s16x4,__builtin_amdgcn_ds_read_tr16_b64_v4i16((__attribute__((address_space(3))) v4i16_t*)p)); }
__device__ __forceinline__ float rowmax(const f32x16&p0,const f32x16&p1){
  float a=max3f(p0[0],p0[1],p1[0]),b=max3f(p0[2],p0[3],p1[1]);a=max3f(a,p1[2],p1[3]);
  #pragma unroll
  for(int r=4;r<16;r+=4){a=max3f(a,p0[r],p0[r+1]);b=max3f(b,p0[r+2],p0[r+3]);a=max3f(a,p1[r],p1[r+1]);b=max3f(b,p1[r+2],p1[r+3]);}
  const float m=max2f(a,b);
  auto rr=__builtin_amdgcn_permlane32_swap(__float_as_uint(m),__float_as_uint(m),false,false);
  return max2f(__uint_as_float(rr[0]),__uint_as_float(rr[1]));
}
__device__ __forceinline__ void pv(f32x16*o,int vb,bf16x8 pa0,bf16x8 pa1,bf16x8 pa2,bf16x8 pa3){
  #pragma unroll
  for(int d0=0;d0<2;++d0){s16x4 lo[4],hi[4];
    #pragma unroll
    for(int ks=0;ks<4;++ks){
      asm volatile("ds_read_b64_tr_b16 %0,%1 offset:%c2":"=&v"(lo[ks]):"v"(vb),"i"(d0*4096+ks*1024):"memory");
      asm volatile("ds_read_b64_tr_b16 %0,%1 offset:%c2":"=&v"(hi[ks]):"v"(vb),"i"(d0*4096+ks*1024+512):"memory");}
    asm volatile("s_waitcnt lgkmcnt(0)":::"memory");SBAR();
    #define PK(k) (bf16x8){lo[k][0],lo[k][1],lo[k][2],lo[k][3],hi[k][0],hi[k][1],hi[k][2],hi[k][3]}
    o[d0]=__builtin_amdgcn_mfma_f32_32x32x16_bf16(pa0,PK(0),o[d0],0,0,0);
    o[d0]=__builtin_amdgcn_mfma_f32_32x32x16_bf16(pa1,PK(1),o[d0],0,0,0);
    o[d0]=__builtin_amdgcn_mfma_f32_32x32x16_bf16(pa2,PK(2),o[d0],0,0,0);
    o[d0]=__builtin_amdgcn_mfma_f32_32x32x16_bf16(pa3,PK(3),o[d0],0,0,0);
    #undef PK
  }
}
#define ATTN_STORE16(p,v) (*(u32x4*)(p)=(v))
template<int THRL,bool FIXM> __device__ __forceinline__ void attn_unit(int b,int h,int qb,int tstart,const bf16*Q,const bf16*__restrict__ K,const bf16*__restrict__ V,bf16*O,const float*NCS,const float*QOFF,char*shm,float ref){
  int tid_=threadIdx.x; asm volatile("":"+v"(tid_));
  const int tid=tid_,lane=tid&63,r32=lane&31,hi=lane>>5; const int wid=__builtin_amdgcn_readfirstlane(tid>>6);
  const long rowbase=(long)b*SEQ; const int q0=qb*QB;
  const bf16*Qw=Q+(rowbase+q0+wid*QBLK)*DM+h*D;
  const bf16*Kh=K+(rowbase+(long)tstart*KVBLK)*DM+h*D,*Vh=V+(rowbase+(long)tstart*KVBLK)*DM+h*D;
  const unsigned lds0=(unsigned)(uintptr_t)shm;
  float*wsf=(float*)(shm+LDS_WS)+wid*64;
  const lds_cptr shm3=(lds_cptr)shm;
  { const float*ncs=NCS+(size_t)(b*NHEAD+h)*SEQ+tstart*KVBLK; const int n4=(q0+QB-tstart*KVBLK)>>2;
    const float o1=QOFF[0],o2=o1+QOFF[1],o3=o2+QOFF[2];
    for(int i=tid;i<n4;i+=NW*64){ f32x4v v=*(const f32x4v*)(ncs+4*i); const int qn=(tstart*KVBLK+4*i)>>11; const float of=qn==0?0.f:(qn==1?o1:(qn==2?o2:o3)); v=v+of; if constexpr(FIXM) v=v-ref;
      *(__attribute__((address_space(3))) f32x4v*)((__attribute__((address_space(3))) char*)shm3+LDS_CS+16*i)=v; } }
  const bf16*ksrc=Kh+(long)lane*DM+wid*8;
  const bf16*vsrc=Vh+(long)(16*(wid&3)+(lane>>2))*DM+(wid>>2)*32+(lane&3)*8;
  const unsigned kdst=lds0+LDS_K+wid*1024, vdst=lds0+LDS_V+wid*1024;
  #define DMA_K(t,slot) glds16(ksrc+(long)(t)*KVBLK*DM,(unsigned)__builtin_amdgcn_readfirstlane(kdst+(slot)))
  #define DMA_V(t,slot) glds16(vsrc+(long)(t)*KVBLK*DM,(unsigned)__builtin_amdgcn_readfirstlane(vdst+(slot)))
  const int vb0=(int)(lds0+LDS_V)+((lane>>4)&1)*32+(lane&3)*8+(4*hi+((lane&15)>>2))*64;
  const char*Kbase=shm+LDS_K; bf16x8 kf[8];
  const lds_cptr kp0=shm3+LDS_K+hi*1024+r32*16; const lds_cptr vp0=shm3+LDS_V+((lane>>4)&1)*32+(lane&3)*8+(4*hi+((lane&15)>>2))*64;
  const lds_cptr csp0=shm3+LDS_CS+hi*16;
  const int NT=(q0+QB)/KVBLK-tstart;
  DMA_K(0,0);DMA_V(0,0);DMA_K(1,SLOTB);
  bf16x8 qr[4];
  #pragma unroll
  for(int d0=0;d0<4;++d0)qr[d0]=*reinterpret_cast<const bf16x8*>(&Qw[(long)r32*DM+d0*16+hi*8]);
  float mhat=0.f,l_reg=0.f,negm1=0.f;f32x16 o[2];o[0]=f32x16{};o[1]=f32x16{};
  const int qrel=wid*QBLK+r32;
  #define CMASK(P0,P1,t) do{int jb_=(t)-(NT-4); if(jb_>=0)cmask(P0,P1,jb_,qrel,hi);}while(0)
  bool resc=false;
  #define START(P0,P1) do{ resc=false; if constexpr(!FIXM){ const float rm=rowmax(P0,P1); \
    { const float dl=rm; mhat=fadd_s(mhat,dl); \
      _Pragma("unroll") for(int r=0;r<16;++r){P0[r]=fsub_s(P0[r],dl);P1[r]=fsub_s(P1[r],dl);} \
      negm1=-mhat; } } \
    _Pragma("unroll") for(int r=0;r<16;++r)P0[r]=__builtin_amdgcn_exp2f(P0[r]); }while(0)
  #define RESC() do{ if constexpr(!FIXM) if(resc){ asm volatile("s_waitcnt lgkmcnt(0)":::"memory"); \
      _Pragma("unroll") for(int d_=0;d_<2;++d_) _Pragma("unroll") for(int r=0;r<16;++r)o[d_][r]*=wsf[crow(r,hi)]; } }while(0)
  f32x16 pA0,pA1,pB0,pB1;
  int sl_prev=0,sl_cur=0,sl_next=SLOTB;
  #define ROT() do{sl_prev=sl_cur;sl_cur=sl_next;sl_next=(sl_next==(NSLOT-1)*SLOTB)?0:sl_next+SLOTB;}while(0)
  DMA_K(2,2*SLOTB);
  WAIT_BAR(3);
  if constexpr(FIXM) ldbias0(pA0,pA1,csp0); else ldbias(pA0,pA1,csp0,0.f);
  qkt(pA0,pA1,Kbase,qr,r32,hi);asm volatile("s_nop 15\n\ts_nop 7":"+v"(pA0),"+v"(pA1));CMASK(pA0,pA1,0);
  START(pA0,pA1);
  _Pragma("unroll") for(int r=0;r<16;++r)pA1[r]=__builtin_amdgcn_exp2f(pA1[r]);
  WAIT_BAR(0);
  DMA_K(3,0);DMA_V(1,SLOTB);
  ROT();
  kload8(kf,kp0+sl_cur);
  WAIT_BAR(2);
  s16x4 vlo[8],vhi[8]; u32x4 pw0,pw1,pw2,pw3;
  #define PKW(P,B) cvtpk_s(P[B],P[B+1])
  #define PAF(k) __builtin_bit_cast(bf16x8,pw##k)
  #define VFR(i) (bf16x8){vlo[i][0],vlo[i][1],vlo[i][2],vlo[i][3],vhi[i][0],vhi[i][1],vhi[i][2],vhi[i][3]}
  #define PIN(x) asm volatile("":"+v"(x))
  #define MX3(a,b,c) __builtin_fmaxf(__builtin_fmaxf((a),(b)),(c))
  #define GAPA(MF,A0,A1,A2,A3,W0,W1,PW) do{ MF; sacc+=A0; sacc+=A1; sacc+=A2; sacc+=A3; PIN(sacc); W0; W1; PIN(PW); SBAR(); }while(0)
  #define EX(v) __builtin_amdgcn_exp2f(v)
  #define GAPB(MF,X,B) do{ MF; X[B]=EX(X[B]); X[B+1]=EX(X[B+1]); X[B+2]=EX(X[B+2]); X[B+3]=EX(X[B+3]); PIN(X); SBAR(); }while(0)
  #define VRD(i) do{ vlo[i]=vtr(vp_+(((i)>>2)*4096+((i)&3)*1024)); vhi[i]=vtr(vp_+(((i)>>2)*4096+((i)&3)*1024+512)); }while(0)
  #define KRD(G,j) do{ if(G){ kload2(kf,kp0+sl_next,j); SBAR(); } }while(0)
  #define STEP(C0,C1,P0,P1,t,GK,GV,GL) do{ SBAR(); \
    const lds_cptr vp_=vp0+sl_prev; \
    if constexpr(FIXM) ldbias0(C0,C1,csp0+(t)*256); else ldbias(C0,C1,csp0+(t)*256,negm1); PIN(C0); PIN(C1); SBAR(); \
    VRD(0); SBAR(); float sacc=(P0[0]+P0[1]); \
    GAPA(C0=__builtin_amdgcn_mfma_f32_32x32x16_bf16(kf[0],qr[0],C0,0,0,0), P0[2],P0[3],P0[4],P0[5],     pw0[0]=PKW(P0,0), pw0[1]=PKW(P0,2), pw0); \
    VRD(4); SBAR(); GAPA(C1=__builtin_amdgcn_mfma_f32_32x32x16_bf16(kf[1],qr[0],C1,0,0,0), P0[6],P0[7],P0[8],P0[9],     pw0[2]=PKW(P0,4), pw0[3]=PKW(P0,6), pw0); \
    VRD(1); SBAR(); GAPA(C0=__builtin_amdgcn_mfma_f32_32x32x16_bf16(kf[2],qr[1],C0,0,0,0),   P0[10],P0[11],P0[12],P0[13], pw1[0]=PKW(P0,8), pw1[1]=PKW(P0,10), pw1); \
    VRD(5); SBAR(); GAPA(C1=__builtin_amdgcn_mfma_f32_32x32x16_bf16(kf[3],qr[1],C1,0,0,0),   P0[14],P0[15],P1[0],P1[1],   pw1[2]=PKW(P0,12),pw1[3]=PKW(P0,14), pw1); \
    VRD(2); SBAR(); GAPA(C0=__builtin_amdgcn_mfma_f32_32x32x16_bf16(kf[4],qr[2],C0,0,0,0),   P1[2],P1[3],P1[4],P1[5],     pw2[0]=PKW(P1,0), pw2[1]=PKW(P1,2), pw2); \
    VRD(6); SBAR(); GAPA(C1=__builtin_amdgcn_mfma_f32_32x32x16_bf16(kf[5],qr[2],C1,0,0,0),   P1[6],P1[7],P1[8],P1[9],     pw2[2]=PKW(P1,4), pw2[3]=PKW(P1,6), pw2); \
    VRD(3); SBAR(); GAPA(C0=__builtin_amdgcn_mfma_f32_32x32x16_bf16(kf[6],qr[3],C0,0,0,0),   P1[10],P1[11],P1[12],P1[13], pw3[0]=PKW(P1,8), pw3[1]=PKW(P1,10), pw3); \
    VRD(7); SBAR(); GAPA(C1=__builtin_amdgcn_mfma_f32_32x32x16_bf16(kf[7],qr[3],C1,0,0,0),   P1[14],P1[15],0.f,0.f,       pw3[2]=PKW(P1,12),pw3[3]=PKW(P1,14), pw3); \
    l_reg+=sacc; \
    if(GK){DMA_K((t)+3,sl_cur);} if(GV){DMA_V((t)+1,sl_next);} \
    CMASK(C0,C1,t); \
    resc=false; if constexpr(!FIXM) { float a=MX3(C0[0],C0[1],C1[0]),b=MX3(C0[2],C0[3],C1[1]); a=MX3(a,C1[2],C1[3]); \
      _Pragma("unroll") for(int r=4;r<16;r+=4){a=MX3(a,C0[r],C0[r+1]);b=MX3(b,C0[r+2],C0[r+3]);a=MX3(a,C1[r],C1[r+1]);b=MX3(b,C1[r+2],C1[r+3]);} \
      float rm=__builtin_fmaxf(a,b); { auto rr=__builtin_amdgcn_permlane32_swap(__float_as_uint(rm),__float_as_uint(rm),false,false); rm=__builtin_fmaxf(__uint_as_float(rr[0]),__uint_as_float(rr[1])); } \
      resc=false; \
      if(__builtin_expect(__any(rm>(float)THRL),0)){ const float dl=__builtin_fmaxf(rm,0.f); mhat+=dl; \
        _Pragma("unroll") for(int r=0;r<16;++r){C0[r]-=dl;C1[r]-=dl;} \
        negm1=-mhat; \
        const float f=__builtin_amdgcn_exp2f(-dl); l_reg*=f; if(hi==0)wsf[r32]=f; resc=true; } } \
    SBAR(); \
    GAPB(o[0]=__builtin_amdgcn_mfma_f32_32x32x16_bf16(PAF(0),VFR(0),o[0],0,0,0), C0,0); \
    GAPB(o[1]=__builtin_amdgcn_mfma_f32_32x32x16_bf16(PAF(0),VFR(4),o[1],0,0,0), C0,4); \
    KRD(GL,0); GAPB(o[0]=__builtin_amdgcn_mfma_f32_32x32x16_bf16(PAF(1),VFR(1),o[0],0,0,0), C0,8); \
    KRD(GL,1); GAPB(o[1]=__builtin_amdgcn_mfma_f32_32x32x16_bf16(PAF(1),VFR(5),o[1],0,0,0), C0,12); \
    KRD(GL,2); GAPB(o[0]=__builtin_amdgcn_mfma_f32_32x32x16_bf16(PAF(2),VFR(2),o[0],0,0,0), C1,0); \
    KRD(GL,3); GAPB(o[1]=__builtin_amdgcn_mfma_f32_32x32x16_bf16(PAF(2),VFR(6),o[1],0,0,0), C1,4); \
    GAPB(o[0]=__builtin_amdgcn_mfma_f32_32x32x16_bf16(PAF(3),VFR(3),o[0],0,0,0), C1,8); \
    GAPB(o[1]=__builtin_amdgcn_mfma_f32_32x32x16_bf16(PAF(3),VFR(7),o[1],0,0,0), C1,12); \
    }while(0)
  int t=1;
  #undef CMASK
  #define CMASK(P0,P1,t) do{}while(0)
  for(;t+5<NT;t+=2){
    STEP(pB0,pB1,pA0,pA1,t,true,true,true);     WAIT_BAR(2); RESC(); ROT();
    STEP(pA0,pA1,pB0,pB1,t+1,true,true,true);   WAIT_BAR(2); RESC(); ROT();
  }
  #undef CMASK
  #define CMASK(P0,P1,t) do{int jb_=(t)-(NT-4); if(jb_>=0)cmask(P0,P1,jb_,qrel,hi);}while(0)
  #define ENDW(tt) do{ if((tt)+3<NT){WAIT_BAR(2);} else if((tt)+2<NT){WAIT_BAR(1);} else {WAIT_BAR(0);} }while(0)
  const int wq_=wid>>1;
  #define AQ(tt) (((tt)-(NT-4))<=wq_)
  #define DRAINP(P0,P1,VB) do{ float sacc=P0[0]+P0[1]; _Pragma("unroll") for(int r=2;r<16;++r)sacc+=P0[r]; _Pragma("unroll") for(int r=0;r<16;++r)sacc+=P1[r]; l_reg+=sacc; \
    pw0=(u32x4){PKW(P0,0),PKW(P0,2),PKW(P0,4),PKW(P0,6)};pw1=(u32x4){PKW(P0,8),PKW(P0,10),PKW(P0,12),PKW(P0,14)};pw2=(u32x4){PKW(P1,0),PKW(P1,2),PKW(P1,4),PKW(P1,6)};pw3=(u32x4){PKW(P1,8),PKW(P1,10),PKW(P1,12),PKW(P1,14)}; \
    SBAR(); pv(o,(VB),PAF(0),PAF(1),PAF(2),PAF(3)); }while(0)
  #define TAILSTEP(P0,P1,t,GK,GV) do{ SBAR(); if(GK){DMA_K((t)+3,sl_cur);} if(GV){DMA_V((t)+1,sl_next);} resc=false; if(AQ((t)-1)){ DRAINP(P0,P1,vb0+sl_prev); } SBAR(); }while(0)
  for(;t+1<NT;t+=2){
    STEP(pB0,pB1,pA0,pA1,t,(t+3<NT),(t+1<NT),(t+1<NT));       ENDW(t);   RESC(); ROT();
    STEP(pA0,pA1,pB0,pB1,t+1,(t+4<NT),(t+2<NT),(t+2<NT));     ENDW(t+1); RESC(); ROT();
  }
  if(AQ(NT-1)){ STEP(pB0,pB1,pA0,pA1,NT-1,false,false,false); RESC(); DRAINP(pB0,pB1,vb0+sl_cur); }
  else { TAILSTEP(pA0,pA1,NT-1,false,false); }
  #undef AQ
  #undef DRAINP
  #undef TAILSTEP
  #undef PKW
  #undef PAF
  #undef VFR
  #undef PIN
  #undef MX3
  #undef GAPA
  #undef GAPB
  #undef EX
  #undef VRD
  #undef KRD
  #undef STEP
  #undef ENDW
  {auto rr=__builtin_amdgcn_permlane32_swap(__float_as_uint(l_reg),__float_as_uint(l_reg),false,false);l_reg=__uint_as_float(rr[0])+__uint_as_float(rr[1]);}
  if(hi==0)wsf[32+r32]=l_reg;asm volatile("s_waitcnt lgkmcnt(0)":::"memory");
  float rli[16];
  #pragma unroll
  for(int r=0;r<16;++r)rli[r]=__builtin_amdgcn_rcpf(wsf[32+crow(r,hi)]);
  bf16*Ow=O+(rowbase+q0+wid*QBLK)*DM+h*D;
  { bf16*stg=(bf16*)(shm+LDS_OST)+wid*2048;
    #pragma unroll
    for(int r=0;r<16;++r){const int orow=crow(r,hi);
      #pragma unroll
      for(int d0=0;d0<2;++d0)stg[orow*64+d0*32+r32]=__float2bfloat16(o[d0][r]*rli[r]);}
    asm volatile("s_waitcnt lgkmcnt(0)":::"memory");
    #pragma unroll
    for(int i=0;i<4;++i){const int row=i*8+(lane>>3),ch=lane&7; const u32x4 v=*(const u32x4*)(stg+row*64+ch*8); ATTN_STORE16(Ow+(long)row*DM+ch*8,v);} }
  asm volatile("s_waitcnt lgkmcnt(0)\n\ts_barrier":::"memory");
  #undef DMA_K
  #undef DMA_V
  #undef CMASK
  #undef START
  #undef RESC
  #undef ROT
}
constexpr int ATTN_LDS_BYTES=LDS_BYTES;
#undef SBAR
#undef WAIT_BAR
}

constexpr int NWAVES = 8;
constexpr int BATCH = 4, SEQ = 8192, D = 1024, NH = 16, HD = 64, FF0 = 2816, FFE = 3584, NE = 8;
constexpr int T = BATCH * SEQ;
constexpr int NWIN = 3 * D + NH;
constexpr float RMS_EPS = 1e-6f;
constexpr int MAXRT = 264, MAXROWS = MAXRT * 256;
constexpr int CHUNK_RT = 128;
constexpr int MAXCHUNK = 2;
constexpr float WGU_PRESCALE = 32.f, WD_PRESCALE = 64.f;
constexpr int PH_PRO = 0, PH_MIX0 = 1, PH_GU0 = 2, PH_DN0 = 3, PH_THB = 4, PH_QKV = 5, PH_ATT = 6, PH_WO = 7, PH_THC = 8, PH_PERM = 9, PH_MOE = 10, PH_FIN = PH_MOE + 2 * MAXCHUNK, N_PH = PH_FIN + 1;
static_assert(N_PH == 15, "phase count");

constexpr size_t MiB = 1u << 20;
constexpr size_t WS_CTL = 0, CTL_ZERO_BYTES = 1 * MiB;
constexpr size_t WS_WPOOL = 1 * MiB;
constexpr size_t WS_WFT = WS_WPOOL + 512 * 1024;
constexpr size_t WS_WRT = WS_WFT + 64 * 1024;
constexpr size_t WS_RTPOS = 2 * MiB;
constexpr size_t WS_RTG = WS_RTPOS + 256 * 1024;
constexpr size_t WS_LOGF = 3 * MiB;
constexpr size_t WS_NCS = 5 * MiB;
constexpr size_t WS_QTOT = 7 * MiB;
constexpr size_t WS_NRM = 7 * MiB + 4096;
constexpr size_t WS_KBAR = 7 * MiB + 128 * 1024;
constexpr size_t WS_WIN = 8 * MiB;
constexpr size_t WS_WOUT = 14 * MiB;
constexpr size_t WS_WGU0 = 16 * MiB;
constexpr size_t WS_WD0 = 27 * MiB;
constexpr size_t WS_WGU = 34 * MiB;
constexpr size_t WS_WD = 90 * MiB;
constexpr size_t WS_H = 118 * MiB;
constexpr size_t WS_R = 182 * MiB;
constexpr size_t WS_YB = WS_R, WS_ACT0 = WS_R + 64 * MiB;
constexpr size_t WS_Q = WS_R, WS_K = WS_R + 64 * MiB, WS_V = WS_R + 128 * MiB, WS_YATT = WS_K;
constexpr size_t WS_RIDX = WS_R;
constexpr size_t WS_HS = WS_R;
constexpr size_t WS_YS = WS_R + 66 * MiB;
constexpr size_t WS_ACTC = WS_YS + 66 * MiB;
constexpr size_t WS_XR = WS_R + 254 * MiB;
constexpr size_t WS_END = WS_XR + 64 * MiB;
static_assert(WS_WD0 + (size_t)D * FF0 * 2 <= WS_WGU && WS_WGU + (size_t)NE * 2 * FFE * D <= WS_WD && WS_WD + (size_t)NE * D * FFE <= WS_H && WS_ACT0 + (size_t)T * FF0 * 2 <= WS_XR &&
              WS_HS + (size_t)MAXROWS * D <= WS_YS && WS_YS + (size_t)MAXROWS * D <= WS_ACTC && WS_ACTC + (size_t)(MAXRT - CHUNK_RT) * 256 * FFE <= WS_XR && WS_END <= 512 * MiB, "ws map");
constexpr int CW_TMO = 0, CW_CODE = 1, CW_BAR = 4096, CW_CNT = 16384, CW_AQ = 20480, CW_MAXQ = 24576, CW_MAXK = 24576 + 64, CW_PRO = 28672, CW_TS = 32768;

constexpr int RING_OFF = 0, RING_BYTES = 131072;
constexpr int LDSCTL_OFF = RING_BYTES, MISC_OFF = LDSCTL_OFF + 320;
constexpr int LDS_BYTES = 147456;
static_assert(MISC_OFF + 128 <= LDS_BYTES && attn_body::ATTN_LDS_BYTES <= RING_BYTES, "LDS map");

#define GAS __attribute__((address_space(1)))
#define LAS __attribute__((address_space(3)))
typedef unsigned short bf16;
typedef unsigned v4u __attribute__((ext_vector_type(4)));
typedef unsigned v2u __attribute__((ext_vector_type(2)));
typedef float f32x4 __attribute__((ext_vector_type(4)));
typedef float f32x2 __attribute__((ext_vector_type(2)));
typedef GAS unsigned gu32;
#define RLX_AGENT __ATOMIC_RELAXED, __HIP_MEMORY_SCOPE_AGENT
#define LDS_WAIT() asm volatile("s_waitcnt lgkmcnt(0)" ::: "memory")
#define VM_WAIT() asm volatile("s_waitcnt vmcnt(0)" ::: "memory")
__device__ __forceinline__ unsigned f2bf(float f) { unsigned u = __builtin_bit_cast(unsigned, f); return (u + 0x7fffu + ((u >> 16) & 1u)) >> 16; }
typedef float f32x2c_t __attribute__((ext_vector_type(2))); typedef __bf16 bf16x2c_t __attribute__((ext_vector_type(2)));
__device__ __forceinline__ unsigned pk2(float lo, float hi) { const f32x2c_t v = {lo, hi}; const bf16x2c_t b = __builtin_convertvector(v, bf16x2c_t); return __builtin_bit_cast(unsigned, b); }
typedef __bf16 bf16x2d_t __attribute__((ext_vector_type(2)));
__device__ __forceinline__ float dot2bf(unsigned a, unsigned b, float c) { return __builtin_amdgcn_fdot2_f32_bf16(__builtin_bit_cast(bf16x2d_t, a), __builtin_bit_cast(bf16x2d_t, b), c, false); }
__device__ __forceinline__ float bf_lo(unsigned w) { return __builtin_bit_cast(float, w << 16); }
__device__ __forceinline__ float bf_hi(unsigned w) { return __builtin_bit_cast(float, w & 0xffff0000u); }

#define XB_TMO      128
#define XB_XCNT(j)  (256  + 64 * (j))
#define XB_XSUB(j)  (1280 + 64 * (j))
#define XB_XGEN(j)  (2304 + 64 * (j))
#define XB_TOP      3328
#define XB_TOPGEN   3392
#define XCD_BAR_WORDS 3456
#define XB_SPIN_CAP (1u << 18)
__device__ __forceinline__ unsigned xb_ld(unsigned* p)              { return __hip_atomic_load(p, __ATOMIC_RELAXED, __HIP_MEMORY_SCOPE_AGENT); }
__device__ __forceinline__ unsigned xb_add(unsigned* p, unsigned v) { return __hip_atomic_fetch_add(p, v, __ATOMIC_RELAXED, __HIP_MEMORY_SCOPE_AGENT); }
__device__ __forceinline__ unsigned xb_xcc_id() { return (unsigned)__builtin_amdgcn_s_getreg((3 << 11) | 20) & 0xFu; }
#define XB_SPIN(cond, bar) do { unsigned _sp = 0; while (cond) { __builtin_amdgcn_s_sleep(1); \
    if ((++_sp & 255u) == 0u) { if (xb_ld(&(bar)[XB_TMO])) break; if (_sp > XB_SPIN_CAP) { atomicAdd(&(bar)[XB_TMO], 1u); break; } } } } while (0)
struct XcdBarrier { unsigned* bar; unsigned x; volatile LAS unsigned* st; };
__device__ __forceinline__ XcdBarrier xcd_barrier_post(unsigned* bar, volatile LAS unsigned* st) {
    XcdBarrier b; b.bar = bar; b.x = xb_xcc_id(); b.st = st;
    if (threadIdx.x == 0) (void)xb_add(&bar[XB_XCNT(b.x)], 1u);
    return b;
}
__device__ __forceinline__ void xcd_barrier_complete(unsigned* bar, unsigned x, unsigned& nloc, unsigned& nx) {
    const unsigned G = gridDim.x * gridDim.y * gridDim.z;
    unsigned sum, cnt, mine, sp = 0u;
    for (;;) {
        sum = 0u; cnt = 0u; mine = 0u;
#pragma unroll
        for (unsigned j = 0; j < 16; ++j) { const unsigned c = xb_ld(&bar[XB_XCNT(j)]); sum += c; cnt += (c > 0u) ? 1u : 0u; mine = (j == x) ? c : mine; }
        if (sum == G) break;
        __builtin_amdgcn_s_sleep(1);
        if ((++sp & 255u) == 0u) { if (xb_ld(&bar[XB_TMO])) break; if (sp > XB_SPIN_CAP) { atomicAdd(&bar[XB_TMO], 1u); break; } }
    }
    nloc = mine > 0u ? mine : 1u; nx = cnt > 0u ? cnt : 1u;
}
__device__ __forceinline__ void xcd_barrier(const XcdBarrier& b) {
    asm volatile("s_waitcnt vmcnt(0)" ::: "memory");
    __syncthreads();
    if (threadIdx.x == 0) {
        unsigned* bar = b.bar;
        __builtin_amdgcn_s_waitcnt(0);
        unsigned nloc = b.st[0], nx = b.st[1];
        if (nloc == 0u) { xcd_barrier_complete(bar, b.x, nloc, nx); b.st[0] = nloc; b.st[1] = nx; }
        const unsigned old = xb_add(&bar[XB_XSUB(b.x)], 1u);
        const unsigned gen = old / nloc;
        if (old + 1u == (gen + 1u) * nloc) {
            __builtin_amdgcn_fence(__ATOMIC_RELEASE, "agent");
            asm volatile("s_waitcnt vmcnt(0)" ::: "memory");
            const unsigned og = xb_add(&bar[XB_TOP], 1u);
            const unsigned tg = og / nx;
            if (og + 1u == (tg + 1u) * nx) xb_add(&bar[XB_TOPGEN], 1u);
            else XB_SPIN(xb_ld(&bar[XB_TOPGEN]) == tg, bar);
            __builtin_amdgcn_fence(__ATOMIC_ACQUIRE, "agent");
            xb_add(&bar[XB_XGEN(b.x)], 1u);
            asm volatile("s_waitcnt vmcnt(0)" ::: "memory");
        } else {
            XB_SPIN(xb_ld(&bar[XB_XGEN(b.x)]) == gen, bar);
            __builtin_amdgcn_fence(__ATOMIC_ACQUIRE, "agent");
            asm volatile("s_waitcnt vmcnt(0)" ::: "memory");
        }
    }
    __syncthreads();
}

struct Frame {
    LAS unsigned char* lds;
    volatile LAS unsigned* MISC;
    gu32* ctl;
    int tid, lane, wave;
    int vcu, G;
    unsigned char* ws;
};
#define DPP_ADDF(v, ctrl) v += __builtin_bit_cast(float, __builtin_amdgcn_update_dpp(0, __builtin_bit_cast(int, v), ctrl, 0xf, 0xf, true))
__device__ __forceinline__ float allsum64(float v) {
    DPP_ADDF(v, 0xB1); DPP_ADDF(v, 0x4E); DPP_ADDF(v, 0x141); DPP_ADDF(v, 0x140);
    v += __shfl_xor(v, 16); v += __shfl_xor(v, 32);
    return v;
}
__device__ __forceinline__ float wave_sum(float v) { return allsum64(v); }
__device__ __forceinline__ void load_row_f32(const float* p, int lane, f32x4 (&v)[4]) {
#pragma unroll
    for (int j = 0; j < 4; ++j) v[j] = ((const f32x4*)p)[64 * j + lane];
}
__device__ __forceinline__ void store_row_f32(float* p, int lane, const f32x4 (&v)[4]) {
#pragma unroll
    for (int j = 0; j < 4; ++j) __builtin_nontemporal_store(v[j], (f32x4*)p + 64 * j + lane);
}
__device__ __forceinline__ void store_row_bf16_nt(bf16* p, int lane, const f32x4 (&v)[4]) {
#pragma unroll
    for (int j = 0; j < 4; ++j) { v2u w; w.x = pk2(v[j].x, v[j].y); w.y = pk2(v[j].z, v[j].w); __builtin_nontemporal_store(w, (v2u*)p + 64 * j + lane); }
}
__device__ __forceinline__ void load_row_bf16(const bf16* p, int lane, f32x4 (&v)[4]) {
#pragma unroll
    for (int j = 0; j < 4; ++j) { const v2u w = ((const v2u*)p)[64 * j + lane]; v[j] = (f32x4){bf_lo(w.x), bf_hi(w.x), bf_lo(w.y), bf_hi(w.y)}; }
}
__device__ __forceinline__ void load_row_bf16_nt(const bf16* p, int lane, f32x4 (&v)[4]) {
#pragma unroll
    for (int j = 0; j < 4; ++j) { const v2u w = __builtin_nontemporal_load((const v2u*)p + 64 * j + lane); v[j] = (f32x4){bf_lo(w.x), bf_hi(w.x), bf_lo(w.y), bf_hi(w.y)}; }
}
__device__ __forceinline__ void store_row_bf16(bf16* p, int lane, const f32x4 (&v)[4]) {
#pragma unroll
    for (int j = 0; j < 4; ++j) { v2u w; w.x = pk2(v[j].x, v[j].y); w.y = pk2(v[j].z, v[j].w); ((v2u*)p)[64 * j + lane] = w; }
}
__device__ __forceinline__ float row_rstd(const f32x4 (&v)[4]) {
    float s = 0.f;
#pragma unroll
    for (int j = 0; j < 4; ++j) s += (v[j].x * v[j].x + v[j].y * v[j].y) + (v[j].z * v[j].z + v[j].w * v[j].w);
    s = wave_sum(s);
    return 1.0f / sqrtf(s * (1.0f / D) + RMS_EPS);
}

__device__ __forceinline__ void p0_transpose_item(const float* W, int ldw, int k0, int n0, bf16* dst, int dK, int drow0, LAS unsigned* scr, int lane) {
    const int nq = lane & 15, kr = lane >> 4;
#pragma unroll 4
    for (int it = 0; it < 8; ++it) { const int kp = it * 4 + kr;
        const f32x4 a = __builtin_nontemporal_load((const f32x4*)(W + (size_t)(k0 + 2 * kp) * ldw + n0 + 4 * nq)), b = __builtin_nontemporal_load((const f32x4*)(W + (size_t)(k0 + 2 * kp + 1) * ldw + n0 + 4 * nq));
        scr[(4 * nq + 0) * 33 + kp] = pk2(a.x, b.x); scr[(4 * nq + 1) * 33 + kp] = pk2(a.y, b.y); scr[(4 * nq + 2) * 33 + kp] = pk2(a.z, b.z); scr[(4 * nq + 3) * 33 + kp] = pk2(a.w, b.w); }
    LDS_WAIT(); asm volatile("" ::: "memory");
    const int c = lane & 7;
#pragma unroll
    for (int ps = 0; ps < 8; ++ps) { const int n = (lane >> 3) + 8 * ps; const LAS unsigned* s = scr + n * 33 + 4 * c;
        v4u o; o.x = s[0]; o.y = s[1]; o.z = s[2]; o.w = s[3];
        *(v4u*)(dst + (size_t)(drow0 + n) * dK + k0 + 8 * c) = o; }
    LDS_WAIT(); asm volatile("" ::: "memory");
}
template <bool NTS = true>
__device__ __forceinline__ void p0_transpose_item8(const float* W, int ldw, int k0, int n0, unsigned char* dst, int dK, int drow0, float scale, LAS unsigned* scr, int lane) {
    const int nq = lane & 15, kr = lane >> 4;
#pragma unroll 4
    for (int it = 0; it < 8; ++it) { const int k4 = it * 4 + kr; const float* p = W + (size_t)(k0 + 4 * k4) * ldw + n0 + 4 * nq;
        const f32x4 a = __builtin_nontemporal_load((const f32x4*)p) * scale, b = __builtin_nontemporal_load((const f32x4*)(p + ldw)) * scale, c = __builtin_nontemporal_load((const f32x4*)(p + 2 * (size_t)ldw)) * scale, d = __builtin_nontemporal_load((const f32x4*)(p + 3 * (size_t)ldw)) * scale;
        scr[(4 * nq + 0) * 33 + k4] = pg8::pk4_fp8(a.x, b.x, c.x, d.x); scr[(4 * nq + 1) * 33 + k4] = pg8::pk4_fp8(a.y, b.y, c.y, d.y);
        scr[(4 * nq + 2) * 33 + k4] = pg8::pk4_fp8(a.z, b.z, c.z, d.z); scr[(4 * nq + 3) * 33 + k4] = pg8::pk4_fp8(a.w, b.w, c.w, d.w); }
    LDS_WAIT(); asm volatile("" ::: "memory");
    const int c = lane & 7;
#pragma unroll
    for (int ps = 0; ps < 8; ++ps) { const int n = (lane >> 3) + 8 * ps; const LAS unsigned* s = scr + n * 33 + 4 * c;
        v4u o; o.x = s[0]; o.y = s[1]; o.z = s[2]; o.w = s[3];
        if (NTS) __builtin_nontemporal_store(o, (v4u*)(dst + (size_t)(drow0 + n) * dK + k0 + 16 * c)); else *(v4u*)(dst + (size_t)(drow0 + n) * dK + k0 + 16 * c) = o; }
    LDS_WAIT(); asm volatile("" ::: "memory");
}
struct In { const float *x, *norm_g, *pool_w, *pool_scale, *w_in, *b_f, *w_out, *w_gate, *w_up, *w_down, *w_router, *mw_gate, *mw_up, *mw_down; };

__device__ __forceinline__ void moe_conv_share(Frame& F, const In& I) {
    LAS unsigned* scr = (LAS unsigned*)(F.lds + RING_OFF + F.wave * 16384);
    unsigned char* const wgu = F.ws + WS_WGU; unsigned char* const wd = F.ws + WS_WD;
    const int gw = F.vcu * NWAVES + F.wave, NGW = F.G * NWAVES;
#pragma unroll 1
    for (int it = gw; it < NE * 1344; it += NGW) {
        int r = it; const int e = r / 1344; r -= e * 1344;
        if (r < 896) { const int up = r >= 448; if (up) r -= 448; const int kb = r / 56, nb = r % 56, n0 = 64 * nb;
            p0_transpose_item8((up ? I.mw_up : I.mw_gate) + (size_t)e * D * FFE, FFE, 128 * kb, n0, wgu + (size_t)e * 2 * FFE * D, D, ((n0 >> 7) << 8) + (n0 & 127) + (up ? 128 : 0), WGU_PRESCALE, scr, F.lane); }
        else { r -= 896; const int kb = r / 16, nb = r % 16; p0_transpose_item8(I.mw_down + (size_t)e * FFE * D, D, 128 * kb, 64 * nb, wd + (size_t)e * D * FFE, FFE, 64 * nb, WD_PRESCALE, scr, F.lane); }
    }
}
template <int PART>
__device__ __forceinline__ void p0_prologue(Frame& F, const In& I) {
    LAS unsigned* scr = (LAS unsigned*)(F.lds + RING_OFF + F.wave * 16384);
    const int gw = F.vcu * NWAVES + F.wave, NGW = F.G * NWAVES;
    constexpr int I_POOL = 4 * 4 * 4, I_WIN = 16 * 48, I_WOUT = 16 * 16, I_G0 = MK_FFN0_FP8 ? 8 * 44 : 16 * 44, I_D0 = MK_FFN0_DNF8 ? 22 * 16 : 44 * 16, I_GE = 8 * 56, I_DE = 28 * 16;
    constexpr int NITEMS = I_POOL + I_WIN + I_WOUT + 2 * I_G0 + I_D0;
    bf16* const wpool = (bf16*)(F.ws + WS_WPOOL); bf16* const win = (bf16*)(F.ws + WS_WIN); bf16* const wout = (bf16*)(F.ws + WS_WOUT);
    bf16* const wgu0 = (bf16*)(F.ws + WS_WGU0); bf16* const wd0 = (bf16*)(F.ws + WS_WD0);
    for (int it = (PART == 0 ? NITEMS : I_POOL) + gw; it < NITEMS; it += NGW) {
        int r = it;
        if (r < I_POOL) { const int g = r >> 4, q = r & 15, kb = q >> 2, nb = q & 3; p0_transpose_item(I.pool_w + (size_t)g * 65536, 256, 64 * kb, 64 * nb, wpool + (size_t)g * 65536, 256, 64 * nb, scr, F.lane); continue; } r -= I_POOL;
        if (r < I_WIN) { const int kb = r / 48, nb = r % 48; p0_transpose_item(I.w_in, NWIN, 64 * kb, 64 * nb, win, D, 64 * nb, scr, F.lane); continue; } r -= I_WIN;
        if (r < I_WOUT) { const int kb = r / 16, nb = r % 16; p0_transpose_item(I.w_out, D, 64 * kb, 64 * nb, wout, D, 64 * nb, scr, F.lane); continue; } r -= I_WOUT;
        if (r < 2 * I_G0) { const int up = r >= I_G0; if (up) r -= I_G0; const int kb = r / 44, nb = r % 44, n0 = 64 * nb;
            if (MK_FFN0_FP8) p0_transpose_item8(up ? I.w_up : I.w_gate, FF0, 128 * kb, n0, (unsigned char*)wgu0, D, ((n0 >> 7) << 8) + (n0 & 127) + (up ? 128 : 0), WGU_PRESCALE, scr, F.lane);
            else p0_transpose_item(up ? I.w_up : I.w_gate, FF0, 64 * kb, n0, wgu0, D, ((n0 >> 7) << 8) + (n0 & 127) + (up ? 128 : 0), scr, F.lane); continue; } r -= 2 * I_G0;
        if (r < I_D0) { const int kb = r / 16, nb = r % 16;
            if (MK_FFN0_DNF8) p0_transpose_item8<false>(I.w_down, D, 128 * kb, 64 * nb, (unsigned char*)wd0, FF0, 64 * nb, WD_PRESCALE, scr, F.lane);
            else p0_transpose_item(I.w_down, D, 64 * kb, 64 * nb, wd0, FF0, 64 * nb, scr, F.lane); continue; } r -= I_D0;
        (void)I_GE; (void)I_DE;
    }
    if (PART == 0) { const int gt = F.vcu * (NWAVES * 64) + F.tid, NGT = F.G * NWAVES * 64;
      for (int f = gt; f < 4 * 2 * 8 * 8 * 64; f += NGT) { const int ln = f & 63, nb = (f >> 6) & 7, ks = (f >> 9) & 7, half = (f >> 12) & 1, g = f >> 13, c16 = ln & 15, kq = ln >> 4;
          const float* src = I.pool_w + (size_t)g * 65536 + (size_t)(32 * ks + 8 * kq) * 256 + 128 * half + 16 * nb + c16;
          v4u w; w.x = pk2(src[0], src[256]); w.y = pk2(src[512], src[768]); w.z = pk2(src[1024], src[1280]); w.w = pk2(src[1536], src[1792]);
          ((v4u*)wpool)[f] = w; } }
    if (PART == 0) { float* wft = (float*)(F.ws + WS_WFT); float* wrt = (float*)(F.ws + WS_WRT); const int gt = F.vcu * (NWAVES * 64) + F.tid, NGT = F.G * NWAVES * 64;
      for (int i = gt; i < 16 * D; i += NGT) { const int j = i / D, c = i % D; ((bf16*)wft)[i] = (bf16)f2bf(I.w_in[(size_t)c * NWIN + 3 * D + j]); }
      for (int i = gt; i < NE * D; i += NGT) { const int e = i / D, c = i % D; wrt[i] = I.w_router[(size_t)c * NE + e]; } }
}

__device__ __forceinline__ void row_rstd2(const f32x4 (&a)[4], const f32x4 (&b)[4], float& ra, float& rb) {
    float s = 0.f, t = 0.f;
#pragma unroll
    for (int j = 0; j < 4; ++j) { s += (a[j].x * a[j].x + a[j].y * a[j].y) + (a[j].z * a[j].z + a[j].w * a[j].w); t += (b[j].x * b[j].x + b[j].y * b[j].y) + (b[j].z * b[j].z + b[j].w * b[j].w); }
    s = allsum64(s); t = allsum64(t);
    ra = 1.0f / sqrtf(s * (1.0f / D) + RMS_EPS); rb = 1.0f / sqrtf(t * (1.0f / D) + RMS_EPS);
}
template <int H, int BIT, int N>
__device__ __forceinline__ void halve_step(float (&v)[N], int lane) {
    const bool up = (lane & BIT) != 0;
#pragma unroll
    for (int i = 0; i < H; ++i) { const float send = up ? v[i] : v[i + H], keep = up ? v[i + H] : v[i];
        if constexpr (BIT == 8) v[i] = keep + __builtin_bit_cast(float, __builtin_amdgcn_update_dpp(0, __builtin_bit_cast(int, send), 0x128, 0xf, 0xf, true));
        else v[i] = keep + __shfl_xor(send, BIT); }
}
__device__ __forceinline__ float halve_reduce16(float (&v)[16], int lane) {
    halve_step<8, 32>(v, lane); halve_step<4, 16>(v, lane); halve_step<2, 8>(v, lane); halve_step<1, 4>(v, lane);
    float r = v[0]; DPP_ADDF(r, 0x4E); DPP_ADDF(r, 0xB1); return r;
}
__device__ __forceinline__ float halve_reduce8(float (&v)[8], int lane) {
    halve_step<4, 32>(v, lane); halve_step<2, 16>(v, lane); halve_step<1, 8>(v, lane);
    float r = v[0]; r += __shfl_xor(r, 4); DPP_ADDF(r, 0x4E); DPP_ADDF(r, 0xB1); return r;
}
template <int MODE>
__device__ __forceinline__ void thin_phase(Frame& F, const In& I, const bf16* Y, bf16* xr, const float* gpost_p, const float* gpre_p) {
    bf16* const Hb = (bf16*)(F.ws + WS_H);
    LAS float* wl = (LAS float*)(F.lds + RING_OFF);
    LAS unsigned* rte = (LAS unsigned*)(F.lds + RING_OFF + 65536);
    LAS float* rtg = (LAS float*)(F.lds + RING_OFF + 65536 + 512);
    LAS unsigned* wtot = (LAS unsigned*)(F.lds + RING_OFF + 65536 + 2048);
    if (MODE == 1) { const f32x4* src = (const f32x4*)(F.ws + WS_WFT); for (int i = F.tid; i < 16 * D / 8; i += NWAVES * 64) ((LAS f32x4*)wl)[i] = src[i]; }
    if (MODE == 2) { const f32x4* src = (const f32x4*)(F.ws + WS_WRT); for (int i = F.tid; i < NE * D / 4; i += NWAVES * 64) ((LAS f32x4*)wl)[i] = src[i]; }
    f32x4 gpost[4], gpre[4];
    load_row_f32(gpost_p, F.lane, gpost); load_row_f32(gpre_p, F.lane, gpre);
    float bfq = 0.f; if (MODE == 1) bfq = I.b_f[(F.lane >> 2) & 15];
    __syncthreads();
    for (int tile = F.vcu; tile < T / 128; tile += F.G) {
        const int mb = tile * 128 + F.wave * 16;
        f32x4 ynA[4], xnA[4], ynB[4], xnB[4];
        load_row_bf16_nt(Y + (size_t)mb * D, F.lane, ynA); load_row_bf16_nt(xr + (size_t)mb * D, F.lane, xnA);
        load_row_bf16_nt(Y + (size_t)(mb + 1) * D, F.lane, ynB); load_row_bf16_nt(xr + (size_t)(mb + 1) * D, F.lane, xnB);
#pragma unroll 1
        for (int i = 0; i < 16; i += 2) {
            const int m = mb + i, tl = F.wave * 16 + i;
            f32x4 yA[4], xA[4], yB[4], xB[4];
#pragma unroll
            for (int j = 0; j < 4; ++j) { yA[j] = ynA[j]; xA[j] = xnA[j]; yB[j] = ynB[j]; xB[j] = xnB[j]; }
            if (i + 2 < 16) { load_row_bf16_nt(Y + (size_t)(m + 2) * D, F.lane, ynA); load_row_bf16_nt(xr + (size_t)(m + 2) * D, F.lane, xnA);
                              load_row_bf16_nt(Y + (size_t)(m + 3) * D, F.lane, ynB); load_row_bf16_nt(xr + (size_t)(m + 3) * D, F.lane, xnB); }
            float r1A, r1B; row_rstd2(yA, yB, r1A, r1B);
#pragma unroll
            for (int j = 0; j < 4; ++j) { xA[j] += yA[j] * r1A * gpost[j]; xB[j] += yB[j] * r1B * gpost[j]; }
            store_row_bf16_nt(xr + (size_t)m * D, F.lane, xA); store_row_bf16_nt(xr + (size_t)(m + 1) * D, F.lane, xB);
            float r2A, r2B; row_rstd2(xA, xB, r2A, r2B);
#pragma unroll
            for (int j = 0; j < 4; ++j) { xA[j] = xA[j] * r2A * gpre[j]; xB[j] = xB[j] * r2B * gpre[j]; }
            if (MODE == 2) {
#pragma unroll
                for (int j = 0; j < 4; ++j) { ((unsigned*)((unsigned char*)Hb + (size_t)m * D))[64 * j + F.lane] = pg8::pk4_fp8(xA[j].x, xA[j].y, xA[j].z, xA[j].w);
                                              ((unsigned*)((unsigned char*)Hb + (size_t)(m + 1) * D))[64 * j + F.lane] = pg8::pk4_fp8(xB[j].x, xB[j].y, xB[j].z, xB[j].w); }
            } else if (MODE != 1) { store_row_bf16(Hb + (size_t)m * D, F.lane, xA); store_row_bf16(Hb + (size_t)(m + 1) * D, F.lane, xB); }
            if (MODE == 1) {
                v2u hA[4], hB[4];
#pragma unroll
                for (int j = 0; j < 4; ++j) { hA[j].x = pk2(xA[j].x, xA[j].y); hA[j].y = pk2(xA[j].z, xA[j].w); hB[j].x = pk2(xB[j].x, xB[j].y); hB[j].y = pk2(xB[j].z, xB[j].w);
                    ((v2u*)(Hb + (size_t)m * D))[64 * j + F.lane] = hA[j]; ((v2u*)(Hb + (size_t)(m + 1) * D))[64 * j + F.lane] = hB[j]; }
                float pA[16], pB[16];
                v2u wq0[16], wq1[16];
#define TP_LDW(buf, q0) do { _Pragma("unroll") for (int qq = 0; qq < 4; ++qq) _Pragma("unroll") for (int j = 0; j < 4; ++j) buf[qq * 4 + j] = ((const LAS v2u*)wl)[((q0) + qq) * 256 + 64 * j + F.lane]; } while (0)
#define TP_DOT(buf, q0) do { _Pragma("unroll") for (int qq = 0; qq < 4; ++qq) { float s = 0.f, t = 0.f; _Pragma("unroll") for (int j = 0; j < 4; ++j) { const v2u wp = buf[qq * 4 + j]; \
                        s = dot2bf(wp.x, hA[j].x, s); s = dot2bf(wp.y, hA[j].y, s); t = dot2bf(wp.x, hB[j].x, t); t = dot2bf(wp.y, hB[j].y, t); } pA[(q0) + qq] = s; pB[(q0) + qq] = t; } } while (0)
                TP_LDW(wq0, 0);
                TP_LDW(wq1, 4); asm volatile("" ::: "memory"); TP_DOT(wq0, 0);
                TP_LDW(wq0, 8); asm volatile("" ::: "memory"); TP_DOT(wq1, 4);
                TP_LDW(wq1, 12); asm volatile("" ::: "memory"); TP_DOT(wq0, 8);
                asm volatile("" ::: "memory"); TP_DOT(wq1, 12);
#undef TP_LDW
#undef TP_DOT
                float zA = halve_reduce16(pA, F.lane), zB = halve_reduce16(pB, F.lane);
                if ((F.lane & 3) == 0) { const int q = F.lane >> 2; const float bf = bfq; zA += bf; zB += bf;
                    ((float*)(F.ws + WS_LOGF))[(size_t)m * 16 + q] = fminf(zA, 0.f) - 0.6931471805599453f * __builtin_amdgcn_logf(1.0f + __builtin_amdgcn_exp2f(-1.4426950408889634f * fabsf(zA)));
                    ((float*)(F.ws + WS_LOGF))[(size_t)(m + 1) * 16 + q] = fminf(zB, 0.f) - 0.6931471805599453f * __builtin_amdgcn_logf(1.0f + __builtin_amdgcn_exp2f(-1.4426950408889634f * fabsf(zB))); }
            }
            if (MODE == 2) {
                float lgA[8], lgB[8];
#pragma unroll
                for (int q = 0; q < 8; ++q) { float s = 0.f, t = 0.f;
#pragma unroll
                    for (int j = 0; j < 4; ++j) { const f32x4 w = ((const LAS f32x4*)wl)[q * 256 + 64 * j + F.lane];
                        s += (xA[j].x * w.x + xA[j].y * w.y) + (xA[j].z * w.z + xA[j].w * w.w); t += (xB[j].x * w.x + xB[j].y * w.y) + (xB[j].z * w.z + xB[j].w * w.w); }
                    lgA[q] = s; lgB[q] = t; if ((q & 1) == 1) asm volatile("" ::: "memory"); }
                { const float rA = halve_reduce8(lgA, F.lane), rB = halve_reduce8(lgB, F.lane);
#pragma unroll
                  for (int q = 0; q < 8; ++q) { lgA[q] = __shfl(rA, 8 * q); lgB[q] = __shfl(rB, 8 * q); } }
#pragma unroll
                for (int rr = 0; rr < 2; ++rr) {
                    int e1 = 0; float v1 = rr ? lgB[0] : lgA[0];
#pragma unroll
                    for (int q = 1; q < 8; ++q) { const float v = rr ? lgB[q] : lgA[q]; if (v > v1) { v1 = v; e1 = q; } }
                    int e2 = -1; float v2 = -INFINITY;
#pragma unroll
                    for (int q = 0; q < 8; ++q) { const float v = rr ? lgB[q] : lgA[q]; if (q != e1 && v > v2) { v2 = v; e2 = q; } }
                    const float ex = expf(v2 - v1), g1 = 1.0f / (1.0f + ex), g2 = ex * g1;
                    if (F.lane == 0) { rte[tl + rr] = (unsigned)e1 | ((unsigned)e2 << 8); rtg[2 * (tl + rr)] = g1; rtg[2 * (tl + rr) + 1] = g2; }
                }
            }
        }
        if (MODE == 2) {
            __syncthreads();
            unsigned e1 = 0, e2 = 0, r1 = 0, r2 = 0; const int tl = F.tid;
            if (F.wave < 2) { const unsigned w = rte[tl]; e1 = w & 255u; e2 = w >> 8;
                const unsigned long long lt = (1ull << F.lane) - 1ull;
#pragma unroll
                for (unsigned e = 0; e < 8; ++e) { const unsigned long long m1 = __ballot(e1 == e), m2 = __ballot(e2 == e);
                    if (e1 == e) r1 = (unsigned)__popcll(m1 & lt); if (e2 == e) r2 = (unsigned)(__popcll(m1) + __popcll(m2 & lt));
                    if (F.lane == 0) wtot[F.wave * 8 + e] = (unsigned)(__popcll(m1) + __popcll(m2)); } }
            __syncthreads();
            if (F.tid < 8) { const unsigned n = wtot[F.tid] + wtot[8 + F.tid]; wtot[16 + F.tid] = __hip_atomic_fetch_add(F.ctl + CW_CNT + 64 * F.tid, n, RLX_AGENT); }
            __syncthreads();
            if (F.wave < 2) { const int m = tile * 128 + tl;
                const unsigned p1 = wtot[16 + e1] + (F.wave ? wtot[e1] : 0u) + r1, p2 = wtot[16 + e2] + (F.wave ? wtot[e2] : 0u) + r2;
                v2u pp; pp.x = (e1 << 20) | p1; pp.y = (e2 << 20) | p2; ((v2u*)(F.ws + WS_RTPOS))[m] = pp;
                ((unsigned*)(F.ws + WS_RIDX))[e1 * T + p1] = (unsigned)m; ((unsigned*)(F.ws + WS_RIDX))[e2 * T + p2] = (unsigned)m;
                ((f32x2*)(F.ws + WS_RTG))[m] = (f32x2){rtg[2 * tl], rtg[2 * tl + 1]}; }
            __syncthreads();
        }
    }
}

__device__ __forceinline__ f32x4 unpk4(v2u w) { return (f32x4){bf_lo(w.x), bf_hi(w.x), bf_lo(w.y), bf_hi(w.y)}; }
template <int W>
__device__ __forceinline__ void pool_rows(LAS unsigned char* P, LAS unsigned char* HALO, int seg, int c4, int tb0) {
    f32x4 ring[W]; f32x4 S = (f32x4){0.f, 0.f, 0.f, 0.f};
#pragma unroll
    for (int k = 0; k < W; ++k) { const int row = 32 - W + k;
        const v2u w = seg ? *(const LAS v2u*)(P + row * 2048 + ((((c4 >> 1) ^ (row & 15))) << 4) + (c4 & 1) * 8) : *(const LAS v2u*)(HALO + (W - 2) * 512 + k * 512 + 8 * (c4 & 63));
        ring[k] = unpk4(w); S += ring[k]; }
    __syncthreads();
    const int tbb = tb0 + 32 * seg;
#pragma unroll
    for (int i = 0; i < 32; ++i) { const int row = 32 * seg + i; LAS v2u* p = (LAS v2u*)(P + row * 2048 + ((((c4 >> 1) ^ (row & 15))) << 4) + (c4 & 1) * 8);
        const f32x4 hv = unpk4(*p); S += hv - ring[i % W]; ring[i % W] = hv;
        const int tb = tbb + i; const float inv = 1.0f / (float)((tb + 1 < W) ? (tb + 1) : W);
        const f32x4 pv_ = S * inv - hv; v2u o; o.x = pk2(pv_.x, pv_.y); o.y = pk2(pv_.z, pv_.w); *p = o; }
}
__device__ __forceinline__ void pro_publish(Frame& F) {
    asm volatile("s_waitcnt vmcnt(0)" ::: "memory");
    __syncthreads();
    if (threadIdx.x == 0) { __builtin_amdgcn_fence(__ATOMIC_RELEASE, "agent"); asm volatile("s_waitcnt vmcnt(0)" ::: "memory"); (void)xb_add((unsigned*)(F.ctl + CW_PRO), 1u); }
}
__device__ __forceinline__ void pro_wait(Frame& F) {
    if (threadIdx.x == 0) { unsigned* const bar = (unsigned*)(F.ctl + CW_BAR); unsigned* const c = (unsigned*)(F.ctl + CW_PRO); const unsigned G = (unsigned)F.G;
        XB_SPIN(xb_ld(c) < G, bar); __builtin_amdgcn_fence(__ATOMIC_ACQUIRE, "agent"); asm volatile("s_waitcnt vmcnt(0)" ::: "memory"); }
    __syncthreads();
}
__device__ __forceinline__ void mix0_phase(Frame& F, const In& I, bf16* xr) {
    typedef short bf16x8_t __attribute__((ext_vector_type(8)));
    LAS unsigned char* const P = F.lds + RING_OFF;
    LAS unsigned char* const HALO = F.lds + MISC_OFF + 128;
    const bf16* const WP = (const bf16*)(F.ws + WS_WPOOL);
    bf16* const Hb = (bf16*)(F.ws + WS_H);
    const int lane = F.lane, wave = F.wave, c16 = lane & 15, kq = lane >> 4;
    bool first = true;
    for (int tile = F.vcu; tile < T / 64; tile += F.G) {
        const int t0 = tile * 64, tb0 = t0 & (SEQ - 1);
        { f32x4 g0[4]; load_row_f32(I.norm_g, lane, g0);
#pragma unroll 1
          for (int bt = 0; bt < 2; ++bt) {
              f32x4 a[5][4]; float sq[5];
#pragma unroll
              for (int k = 0; k < 5; ++k) { const int rr = t0 - 16 + wave + 8 * (5 * bt + k); load_row_f32(I.x + (size_t)(rr < 0 ? 0 : rr) * D, lane, a[k]); }
#pragma unroll
              for (int k = 0; k < 5; ++k) { float q = 0.f;
#pragma unroll
                  for (int j = 0; j < 4; ++j) q += (a[k][j].x * a[k][j].x + a[k][j].y * a[k][j].y) + (a[k][j].z * a[k][j].z + a[k][j].w * a[k][j].w);
                  sq[k] = q; }
#pragma unroll
              for (int k = 0; k < 5; ++k) sq[k] = allsum64(sq[k]);
#pragma unroll
              for (int k = 0; k < 5; ++k) { const int row = -16 + wave + 8 * (5 * bt + k);
                  const float rstd = (tb0 + row >= 0) ? 1.0f / sqrtf(sq[k] * (1.0f / D) + RMS_EPS) : 0.f;
#pragma unroll
                  for (int j = 0; j < 4; ++j) { const f32x4 hv = a[k][j] * (g0[j] * rstd); v2u o; o.x = pk2(hv.x, hv.y); o.y = pk2(hv.z, hv.w);
                      if (row >= 0) *(LAS v2u*)(P + row * 2048 + ((((32 * j + (lane >> 1)) ^ (row & 15))) << 4) + (lane & 1) * 8) = o;
                      else { const int wj = 2 << j; if (row >= -wj) *(LAS v2u*)(HALO + (wj - 2) * 512 + (row + wj) * 512 + 8 * lane) = o; } } }
          } }
        __syncthreads();
        { int tid_ = threadIdx.x; asm volatile("" : "+v"(tid_));
          const int seg = tid_ >> 8, c4 = tid_ & 255;
          switch ((c4 >> 6) & 3) { case 0: pool_rows<2>(P, HALO, seg, c4, tb0); break; case 1: pool_rows<4>(P, HALO, seg, c4, tb0); break; case 2: pool_rows<8>(P, HALO, seg, c4, tb0); break; default: pool_rows<16>(P, HALO, seg, c4, tb0); break; } }
        __syncthreads();
        f32x4 acc[4][8];
#pragma unroll
        for (int m = 0; m < 4; ++m)
#pragma unroll
            for (int nb = 0; nb < 8; ++nb) acc[m][nb] = (f32x4){0.f, 0.f, 0.f, 0.f};
        if (first) { pro_wait(F); first = false; }
        { const int gI = wave >> 1;
          const char* const wpb = (const char*)WP;
          const unsigned boff = (unsigned)((gI * 2 + (wave & 1)) * (8 * 8 * 64) + lane) * 16u;
          bf16x8_t bnx[8];
          { unsigned bo = boff; asm volatile("" : "+v"(bo));
#pragma unroll
            for (int nb = 0; nb < 8; ++nb) bnx[nb] = *(const bf16x8_t*)(wpb + (size_t)(bo + (unsigned)nb * 1024u)); }
#pragma unroll 1
          for (int ks = 0; ks < 8; ++ks) {
              bf16x8_t bfr[8], afr[4];
#pragma unroll
              for (int nb = 0; nb < 8; ++nb) bfr[nb] = bnx[nb];
              if (ks + 1 < 8) { unsigned bo = boff + (unsigned)(ks + 1) * 8192u; asm volatile("" : "+v"(bo));
#pragma unroll
                  for (int nb = 0; nb < 8; ++nb) bnx[nb] = *(const bf16x8_t*)(wpb + (size_t)(bo + (unsigned)nb * 1024u)); }
#pragma unroll
              for (int m = 0; m < 4; ++m) afr[m] = *(const LAS bf16x8_t*)(P + (16 * m + c16) * 2048 + (((32 * gI + 4 * ks + kq) ^ c16) << 4));
#pragma unroll
              for (int m = 0; m < 4; ++m)
#pragma unroll
                  for (int nb = 0; nb < 8; ++nb) acc[m][nb] = __builtin_amdgcn_mfma_f32_16x16x32_bf16(bfr[nb], afr[m], acc[m][nb], 0, 0, 0);
          } }
        __syncthreads();
#pragma unroll
        for (int nb = 0; nb < 8; ++nb) { const int col = 128 * wave + 16 * nb + 4 * kq; const f32x4 sc = *(const f32x4*)(I.pool_scale + col);
#pragma unroll
            for (int m = 0; m < 4; ++m) { const f32x4 v = acc[m][nb] * sc; v2u o; o.x = pk2(v.x, v.y); o.y = pk2(v.z, v.w);
                const int row = 16 * m + c16;
                *(LAS v2u*)(P + row * 2048 + ((((col >> 3) ^ c16)) << 4) + (kq & 1) * 8) = o; } }
        __syncthreads();
        { const int rb0 = wave * 8; int lane_ = threadIdx.x & 63; asm volatile("" : "+v"(lane_)); const int lane = lane_;
          f32x4 gpost[4], gpre[4];
          load_row_f32(I.norm_g + 1 * D, lane, gpost); load_row_f32(I.norm_g + 2 * D, lane, gpre);
#pragma unroll 1
          for (int i = 0; i < 8; i += 4) {
              f32x4 y[4][4], x[4][4]; float sq[4];
#pragma unroll
              for (int q = 0; q < 4; ++q) {
#pragma unroll
                  for (int j = 0; j < 4; ++j) x[q][j] = __builtin_nontemporal_load((const f32x4*)(I.x + (size_t)(t0 + rb0 + i + q) * D) + 64 * j + lane); }
#pragma unroll
              for (int q = 0; q < 4; ++q) { const int r = rb0 + i + q;
#pragma unroll
                  for (int j = 0; j < 4; ++j) {
                      const v2u wv = *(const LAS v2u*)(P + r * 2048 + ((((32 * j + (lane >> 1)) ^ (r & 15))) << 4) + (lane & 1) * 8);
                      y[q][j] = (f32x4){bf_lo(wv.x), bf_hi(wv.x), bf_lo(wv.y), bf_hi(wv.y)}; } }
#pragma unroll
              for (int q = 0; q < 4; ++q) { float t = 0.f;
#pragma unroll
                  for (int j = 0; j < 4; ++j) t += (y[q][j].x * y[q][j].x + y[q][j].y * y[q][j].y) + (y[q][j].z * y[q][j].z + y[q][j].w * y[q][j].w);
                  sq[q] = t; }
#pragma unroll
              for (int q = 0; q < 4; ++q) sq[q] = allsum64(sq[q]);
#pragma unroll
              for (int q = 0; q < 4; ++q) { const float r1 = 1.0f / sqrtf(sq[q] * (1.0f / D) + RMS_EPS); float t = 0.f;
#pragma unroll
                  for (int j = 0; j < 4; ++j) { x[q][j] += y[q][j] * r1 * gpost[j]; t += (x[q][j].x * x[q][j].x + x[q][j].y * x[q][j].y) + (x[q][j].z * x[q][j].z + x[q][j].w * x[q][j].w); }
                  store_row_bf16_nt(xr + (size_t)(t0 + rb0 + i + q) * D, lane, x[q]); sq[q] = t; }
#pragma unroll
              for (int q = 0; q < 4; ++q) sq[q] = allsum64(sq[q]);
#pragma unroll
              for (int q = 0; q < 4; ++q) { const float r2 = 1.0f / sqrtf(sq[q] * (1.0f / D) + RMS_EPS);
#pragma unroll
                  for (int j = 0; j < 4; ++j) x[q][j] = x[q][j] * r2 * gpre[j];
                  if (MK_FFN0_FP8) {
#pragma unroll
                      for (int j = 0; j < 4; ++j) ((unsigned*)((unsigned char*)Hb + (size_t)(t0 + rb0 + i + q) * D))[64 * j + lane] = pg8::pk4_fp8(x[q][j].x, x[q][j].y, x[q][j].z, x[q][j].w);
                  } else store_row_bf16(Hb + (size_t)(t0 + rb0 + i + q) * D, lane, x[q]); }
          } }
        __syncthreads();
    }
}

__device__ __forceinline__ void moe_offsets(Frame& F) {
    if (F.tid < 64) {
        const unsigned c = F.tid < NE ? __hip_atomic_load(F.ctl + CW_CNT + 64 * (F.tid & 7), RLX_AGENT) : 0u; unsigned incl = (c + 255u) >> 8;
#pragma unroll
        for (int o = 1; o < 8; o <<= 1) { const unsigned t = (unsigned)__shfl_up((int)incl, o); if (F.lane >= o) incl += t; }
        if (F.tid < NE) F.MISC[12 + F.tid] = incl - ((c + 255u) >> 8);
        if (F.tid == NE - 1) { F.MISC[12 + NE] = incl; F.MISC[10] = incl; } }
    __syncthreads();
}
__device__ __forceinline__ void permute_phase(Frame& F) {
    moe_offsets(F);
    unsigned* const ridx = (unsigned*)(F.ws + WS_RIDX);
    const int gt = F.vcu * (NWAVES * 64) + F.tid, NGT = F.G * NWAVES * 64;
    for (int m = gt; m < T; m += NGT) { v2u pp = ((const v2u*)(F.ws + WS_RTPOS))[m];
        const unsigned e1 = pp.x >> 20, e2 = pp.y >> 20, d1 = F.MISC[12 + e1] * 256u + (pp.x & 0xfffffu), d2 = F.MISC[12 + e2] * 256u + (pp.y & 0xfffffu);
        pp.x = d1; pp.y = d2; ((v2u*)(F.ws + WS_RTPOS))[m] = pp; ridx[d1] = (unsigned)m; ridx[d2] = (unsigned)m; }
    for (int e = 0; e < NE; ++e) { const unsigned c = __hip_atomic_load(F.ctl + CW_CNT + 64 * e, RLX_AGENT); const unsigned r0 = F.MISC[12 + e] * 256u + c, r1 = F.MISC[13 + e] * 256u;
        for (unsigned r = r0 + (unsigned)gt; r < r1; r += (unsigned)NGT) ridx[r] = 0u; }
}
__device__ __forceinline__ void load_row_fp8(const unsigned char* p, int lane, f32x4 (&v)[4]) {
#pragma unroll
    for (int j = 0; j < 4; ++j) { const int w = __builtin_nontemporal_load((const int*)p + 64 * j + lane); const f32x2 lo = __builtin_amdgcn_cvt_pk_f32_fp8(w, false), hi = __builtin_amdgcn_cvt_pk_f32_fp8(w, true); v[j] = (f32x4){lo.x, lo.y, hi.x, hi.y}; }
}
__device__ __forceinline__ void final_phase(Frame& F, const In& I, float* xout) {
    const unsigned char* YS = F.ws + WS_YS; const bf16* xr = (const bf16*)(F.ws + WS_XR);
    f32x4 gp[4]; load_row_f32(I.norm_g + (size_t)(1 * 4 + 3) * D, F.lane, gp);
    for (int tile = F.vcu; tile < T / 128; tile += F.G) {
        const int mb = tile * 128 + F.wave * 16;
        v2u pp = (v2u){0u, 0u}; f32x2 gg = (f32x2){0.f, 0.f};
        if (F.lane < 16) { pp = ((const v2u*)(F.ws + WS_RTPOS))[mb + F.lane]; gg = ((const f32x2*)(F.ws + WS_RTG))[mb + F.lane];
            pp.x = F.MISC[12 + (pp.x >> 20)] * 256u + (pp.x & 0xfffffu); pp.y = F.MISC[12 + (pp.y >> 20)] * 256u + (pp.y & 0xfffffu); }
        f32x4 anA[4], bnA[4], xnA[4], anB[4], bnB[4], xnB[4];
        load_row_fp8(YS + (size_t)(unsigned)__shfl((int)pp.x, 0) * D, F.lane, anA); load_row_fp8(YS + (size_t)(unsigned)__shfl((int)pp.y, 0) * D, F.lane, bnA); load_row_bf16_nt(xr + (size_t)mb * D, F.lane, xnA);
        load_row_fp8(YS + (size_t)(unsigned)__shfl((int)pp.x, 1) * D, F.lane, anB); load_row_fp8(YS + (size_t)(unsigned)__shfl((int)pp.y, 1) * D, F.lane, bnB); load_row_bf16_nt(xr + (size_t)(mb + 1) * D, F.lane, xnB);
#pragma unroll 1
        for (int i = 0; i < 16; i += 2) {
            const int m = mb + i;
            f32x4 aA[4], xA[4], aB[4], xB[4];
            const float g1A = __shfl(gg.x, i), g2A = __shfl(gg.y, i), g1B = __shfl(gg.x, i + 1), g2B = __shfl(gg.y, i + 1);
#pragma unroll
            for (int j = 0; j < 4; ++j) { aA[j] = anA[j] * g1A + bnA[j] * g2A; aB[j] = anB[j] * g1B + bnB[j] * g2B; xA[j] = xnA[j]; xB[j] = xnB[j]; }
            if (i + 2 < 16) {
                load_row_fp8(YS + (size_t)(unsigned)__shfl((int)pp.x, i + 2) * D, F.lane, anA); load_row_fp8(YS + (size_t)(unsigned)__shfl((int)pp.y, i + 2) * D, F.lane, bnA); load_row_bf16_nt(xr + (size_t)(m + 2) * D, F.lane, xnA);
                load_row_fp8(YS + (size_t)(unsigned)__shfl((int)pp.x, i + 3) * D, F.lane, anB); load_row_fp8(YS + (size_t)(unsigned)__shfl((int)pp.y, i + 3) * D, F.lane, bnB); load_row_bf16_nt(xr + (size_t)(m + 3) * D, F.lane, xnB); }
            float rA, rB; row_rstd2(aA, aB, rA, rB);
#pragma unroll
            for (int j = 0; j < 4; ++j) { xA[j] += aA[j] * rA * gp[j]; xB[j] += aB[j] * rB * gp[j]; }
            store_row_f32(xout + (size_t)m * D, F.lane, xA); store_row_f32(xout + (size_t)(m + 1) * D, F.lane, xB);
        }
    }
}
__device__ __forceinline__ void scan_phase(Frame& F, int unit) {
    const int bh = unit >> 2, qn = unit & 3, b = bh / NH, h = bh % NH; const float* lf = (const float*)(F.ws + WS_LOGF) + ((size_t)b * SEQ + 2048 * qn) * 16 + h;
    float* ncs = (float*)(F.ws + WS_NCS) + (size_t)bh * SEQ + 2048 * qn;
    LAS float* part = (LAS float*)(F.lds + RING_OFF);
    float v[4]; float s = 0.f; const int s0 = F.tid * 4;
#pragma unroll
    for (int i = 0; i < 4; ++i) { v[i] = lf[(size_t)(s0 + i) * 16]; s += v[i]; }
    float incl = s;
#pragma unroll
    for (int o = 1; o < 64; o <<= 1) { const float t = __shfl_up(incl, o); if (F.lane >= o) incl += t; }
    if (F.lane == 63) part[F.wave] = incl;
    __syncthreads();
    float base = incl - s, tot = 0.f;
    for (int w = 0; w < NWAVES; ++w) { const float p = part[w]; if (w < F.wave) base += p; tot += p; }
    float run = base; f32x4 o4; run += v[0]; o4.x = -1.4426950408889634f * run; run += v[1]; o4.y = -1.4426950408889634f * run; run += v[2]; o4.z = -1.4426950408889634f * run; run += v[3]; o4.w = -1.4426950408889634f * run;
    *(f32x4*)(ncs + s0) = o4;
    if (F.tid == 0) ((float*)(F.ws + WS_QTOT))[unit] = -1.4426950408889634f * tot;
    __syncthreads();
}

__device__ __forceinline__ bool attn_next(int vcu, int G, int i, int& bh, int& qb) {
    if (G == 256) { if (i >= 8) return false; const int s = vcu & 3; bh = vcu >> 2; const int base = 8 * (i >> 1); qb = (i & 1) ? base + 7 - s : base + s; return true; }
    const int u = vcu + i * G; if (u >= 64 * 32) return false; bh = u >> 5; qb = 31 - (u & 31); return true;
}

struct Args { const float* in[14]; float* out; unsigned char* ws; int ph_lo, ph_hi; };
__global__ void __launch_bounds__(NWAVES * 64, 2) __attribute__((target("no-packed-fp32-ops"))) trunk_fwd(Args args) {
    extern __shared__ __attribute__((aligned(16))) unsigned char lds[];
    Frame F;
    F.lds = (LAS unsigned char*)lds;
    F.MISC = (volatile LAS unsigned*)(F.lds + MISC_OFF);
    F.tid = threadIdx.x; F.lane = F.tid & 63; F.wave = __builtin_amdgcn_readfirstlane(F.tid >> 6);
    F.G = gridDim.x; { const int bx = blockIdx.x; F.vcu = (F.G % 8 == 0) ? (bx % 8) * (F.G / 8) + bx / 8 : bx; }
    F.ws = args.ws; F.ctl = (gu32*)(args.ws + WS_CTL);
    const __attribute__((address_space(4))) Args* const ka = (const __attribute__((address_space(4))) Args*)__builtin_amdgcn_kernarg_segment_ptr();
#define KA_IN(i) ((const float*)*(const float* const volatile __attribute__((address_space(4)))*)&ka->in[i])
#define LOAD_IN() In I; I.x = KA_IN(0); I.norm_g = KA_IN(1); I.pool_w = KA_IN(2); I.pool_scale = KA_IN(3); I.w_in = KA_IN(4); I.b_f = KA_IN(5); I.w_out = KA_IN(6); \
    I.w_gate = KA_IN(7); I.w_up = KA_IN(8); I.w_down = KA_IN(9); I.w_router = KA_IN(10); I.mw_gate = KA_IN(11); I.mw_up = KA_IN(12); I.mw_down = KA_IN(13); \
    float* const out = (float*)*(float* const volatile __attribute__((address_space(4)))*)&ka->out; (void)out; (void)I; RELAUNDER()
#define RELAUNDER() do { int t_ = threadIdx.x; asm volatile("" : "+v"(t_)); F.tid = t_; F.lane = t_ & 63; } while (0)
    unsigned char* const ws = args.ws;
    for (int u = F.tid; u < (LDS_BYTES - LDSCTL_OFF) / 4; u += NWAVES * 64) ((LAS unsigned*)(F.lds + LDSCTL_OFF))[u] = 0u;
    __syncthreads();
    XcdBarrier bar; bar.bar = (unsigned*)(F.ctl + CW_BAR); bar.x = 0; bar.st = nullptr;
#if !MK_PER_PHASE
    bar = xcd_barrier_post((unsigned*)(F.ctl + CW_BAR), F.MISC + 8);
#endif
    const int lo = args.ph_lo, hi = args.ph_hi;
#define IN(k) (lo <= (k) && (k) < hi)
#ifndef MK_REPEAT
#define MK_REPEAT (-1)
#endif
#define PHASE(k) for (int rep_ = 0; rep_ < ((MK_REPEAT == (k)) ? 2 : 1); ++rep_) if (rep_ ? (xcd_barrier(bar), true) : true) if (IN(k))
#ifndef MK_TPROBE
#define MK_TPROBE (-1)
#endif
    unsigned long long tp0_ = (MK_TPROBE >= 0) ? __builtin_amdgcn_s_memrealtime() : 0ull, tp1_ = tp0_;
#define SEAM(k) do { if (IN(k) && IN((k) + 1)) { xcd_barrier(bar); } if (MK_TPROBE >= 0) { if ((k) == MK_TPROBE - 1) tp0_ = __builtin_amdgcn_s_memrealtime(); if ((k) == MK_TPROBE) tp1_ = __builtin_amdgcn_s_memrealtime(); } } while (0)
    const int cblk = (int)blockIdx.x;


    PHASE(PH_MIX0) { LOAD_IN();
        p0_prologue<0>(F, I); pro_publish(F);
        if (cblk & 1) { p0_prologue<1>(F, I); __syncthreads(); }
        mix0_phase(F, I, (bf16*)(ws + WS_XR));
        RELAUNDER();
        if (!(cblk & 1)) p0_prologue<1>(F, I); } SEAM(PH_MIX0);

    PHASE(PH_GU0) {
      LOAD_IN();
      for (int pass = 0; pass < 2; ++pass) {
        if ((pass == 0) == ((cblk & 1) == 0)) { moe_conv_share(F, I); __syncthreads(); continue; }
#if MK_FFN0_FP8
        pg8::GemmK g{D / 2, D / 2, D / 2};
        pg8::DenseOrder S{T / 256, FF0 / 128, (T / 256) * (FF0 / 128), F.G, cblk, (const char*)(ws + WS_H), (const char*)(ws + WS_WGU0), (size_t)256 * D, 0, (size_t)256 * D};
        typedef pg8::EpiSwiGLU8<(int)WGU_PRESCALE> EpiGU8;
        EpiGU8 E{ws + WS_ACT0, FF0};
        pg8::gemm_phase<EpiGU8, pg8::DenseOrder, true, true>(F.lds + RING_OFF, g, S, E);
#else
        pg8::GemmK g{D, D, D};
        pg8::DenseOrder S{T / 256, FF0 / 128, (T / 256) * (FF0 / 128), F.G, cblk, (const char*)(ws + WS_H), (const char*)(ws + WS_WGU0), (size_t)256 * D * 2, 0, (size_t)256 * D * 2};
#if MK_FFN0_DN_FP8
        typedef pg8::EpiSwiGLU8<1> EpiGUf8;
        EpiGUf8 E{ws + WS_ACT0, FF0};
        pg8::gemm_phase<EpiGUf8, pg8::DenseOrder, true>(F.lds + RING_OFF, g, S, E);
#else
        pg8::EpiSwiGLU E{(bf16*)(ws + WS_ACT0), FF0};
        pg8::gemm_phase<pg8::EpiSwiGLU, pg8::DenseOrder, true>(F.lds + RING_OFF, g, S, E);
#endif
#endif
        __syncthreads();
      }
    } SEAM(PH_GU0);

    PHASE(PH_DN0) {
#if MK_FFN0_DNF8
        pg8::GemmK g{FF0 / 2, FF0 / 2, FF0 / 2};
        pg8::DenseOrder S{T / 256, D / 256, (T / 256) * (D / 256), F.G, cblk, (const char*)(ws + WS_ACT0), (const char*)(ws + WS_WD0), (size_t)256 * FF0, 0, (size_t)256 * FF0};
        pg8::EpiBf16 E{(bf16*)(ws + WS_YB), D, nullptr, 0, 0, 1.0f / WD_PRESCALE};
        pg8::gemm_phase<pg8::EpiBf16, pg8::DenseOrder, true, true>(F.lds + RING_OFF, g, S, E);
#else
        pg8::GemmK g{FF0, FF0, FF0};
        pg8::DenseOrder S{T / 256, D / 256, (T / 256) * (D / 256), F.G, cblk, (const char*)(ws + WS_ACT0), (const char*)(ws + WS_WD0), (size_t)256 * FF0 * 2, 0, (size_t)256 * FF0 * 2};
        pg8::EpiBf16 E{(bf16*)(ws + WS_YB), D, nullptr, 0, 0, 1.f};
        pg8::gemm_phase<pg8::EpiBf16, pg8::DenseOrder, true>(F.lds + RING_OFF, g, S, E);
#endif
    } SEAM(PH_DN0);

    PHASE(PH_THB) { LOAD_IN(); thin_phase<1>(F, I, (const bf16*)(ws + WS_YB), (bf16*)(ws + WS_XR), I.norm_g + 3 * D, I.norm_g + 4 * D); } SEAM(PH_THB);

    PHASE(PH_QKV) {
        RELAUNDER();
        for (int un = cblk; un < BATCH * NH * 4; un += F.G) scan_phase(F, un);
        pg8::GemmK g{D, D, D};
        pg8::DenseOrder S{T / 256, 12, (T / 256) * 12, F.G, cblk, (const char*)(ws + WS_H), (const char*)(ws + WS_WIN), (size_t)256 * D * 2, 0, (size_t)256 * D * 2};
        pg8::EpiQKV E{(bf16*)(ws + WS_Q), D, (size_t)(WS_K - WS_Q) / 2, attn_body::C2, (float*)(ws + WS_NRM), (float*)(ws + WS_NRM) + 256 * 32, (float*)(ws + WS_KBAR)};
        pg8::gemm_phase<pg8::EpiQKV, pg8::DenseOrder, true>(F.lds + RING_OFF, g, S, E);
    } SEAM(PH_QKV);

    PHASE(PH_ATT) {
        RELAUNDER();
        auto tstart_of = [&](const unsigned cur) __attribute__((always_inline)) -> int {
            const int qb = 31 - (int)(cur >> 6), bh = (int)(cur & 63u), q0 = qb * 256, NT = (q0 + 256) / 64;
            const float* ncs = (const float*)(ws + WS_NCS) + (size_t)bh * SEQ;
            const bool hasq = qb > 0; const int j = 2 * F.lane + 1; const bool inr = (j + 5 <= NT); const int jc = inr ? j : 1;
            const float* nqp = (const float*)(ws + WS_NRM) + (size_t)((bh >> 4) * 64 + (F.lane >> 1)) * 32 + (bh & 15) * 2 + (F.lane & 1);
            const float l_mk0 = nqp[256 * 32], l_mk1 = nqp[256 * 32 + 32 * 32];
            const float l_mq = ((const float*)(ws + WS_NRM))[(size_t)(((bh >> 4) * 32 + qb) * 2 + ((F.lane >> 1) & 1)) * 32 + (bh & 15) * 2 + (F.lane & 1)];
            const float* kbp = (const float*)(ws + WS_KBAR) + ((size_t)((bh >> 4) * 128 + (hasq ? qb * 4 - 1 : 0)) * 16 + (bh & 15)) * 2; const float l_kb0 = kbp[0], l_kb1 = kbp[1];
            const float l_ms = ncs[(hasq ? q0 - 64 : 0) + F.lane], l_nq = ncs[q0], l_nk = ncs[64 * jc + 63], l_ne = ncs[64 * jc - 1], l_nl = ncs[q0 + 255];
            const float* qt = (const float*)(ws + WS_QTOT) + bh * 4; const float qo1 = qt[0], qo2 = qo1 + qt[1], qo3 = qo2 + qt[2];
            float mq = l_mq, mk = fmaxf(l_mk0, l_mk1), ms = l_ms;
#pragma unroll
            for (int o = 1; o < 64; o <<= 1) { mq = fmaxf(mq, __shfl_xor(mq, o)); mk = fmaxf(mk, __shfl_xor(mk, o)); ms += __shfl_xor(ms, o); }
            const float theta = 4.08f * mq * mk + 40.f, theta1 = 2.04f * mq * mk + 40.f;
            float dm = -INFINITY;
            if (hasq) { const int sq = (q0 - 64) >> 11; dm = 6.f + ms * (1.f / 64.f) + (sq == 0 ? 0.f : (sq == 1 ? qo1 : (sq == 2 ? qo2 : qo3))) - 1.02f * 1.41422f * mq * (sqrtf(l_kb0 + l_kb1) + 0.01f * 1.41422f * mk); }
            bool skip = false; float wj = 0.f, nqv = 0.f;
            { const int sq = q0 >> 11, sk = (64 * jc + 63) >> 11, se = (64 * jc - 1) >> 11;
              const float nq = l_nq + (sq == 0 ? 0.f : (sq == 1 ? qo1 : (sq == 2 ? qo2 : qo3))), nk = l_nk + (sk == 0 ? 0.f : (sk == 1 ? qo1 : (sk == 2 ? qo2 : qo3)));
              const float ne = l_ne + (se == 0 ? 0.f : (se == 1 ? qo1 : (se == 2 ? qo2 : qo3)));
              if (inr) { skip = (nq - nk) >= theta || (dm - nk) >= theta1; wj = exp2f(nk - nq) + exp2f(ne - nq); nqv = nq; } }
            { float P = wj;
#pragma unroll
              for (int o = 1; o < 64; o <<= 1) { const float t = __shfl_up(P, o); if (F.lane >= o) P += t; }
              if (inr) skip = skip || (dm - nqv - log2f(P)) >= (theta1 - 7.f); }
            const float Bq = 2.04f * mq * mk, span = l_nl - l_nq;
            const int fix = (Bq <= 60.f && span + Bq <= 90.f) ? 1 : 0;
            return 2 * (int)__popcll(__ballot(skip)) + (fix << 16);
        };
        gu32* const tsw = F.ctl + CW_TS;
        for (unsigned u = (unsigned)(F.vcu * NWAVES + F.wave); u < (unsigned)(BATCH * NH * 32); u += (unsigned)(F.G * NWAVES)) {
            const int ts = tstart_of(u); if (F.lane == 0) __hip_atomic_store(tsw + u, (unsigned)ts + 1u, __ATOMIC_RELAXED, __HIP_MEMORY_SCOPE_AGENT); }
        unsigned nxt = 0u, nx2 = 0u, tsn = 0u;
        if (F.tid == 0) { const unsigned a = __hip_atomic_fetch_add(F.ctl + CW_AQ + 64 * rep_, 2u, RLX_AGENT); unsigned t0 = 1u;
            if (a < (unsigned)(BATCH * NH * 32)) { unsigned sp = 0u; do { t0 = __hip_atomic_load(tsw + a, RLX_AGENT); } while (t0 == 0u && ++sp < (1u << 22)); if (t0 == 0u) t0 = 1u; }
            F.MISC[11] = a; F.MISC[21] = t0; nxt = a + 1u; }
        __syncthreads();
        unsigned cur = (unsigned)__builtin_amdgcn_readfirstlane((int)F.MISC[11]); int tstart = __builtin_amdgcn_readfirstlane((int)F.MISC[21]) - 1;
        while (cur < (unsigned)(BATCH * NH * 32)) {
            if (F.tid == 0) { nx2 = __hip_atomic_fetch_add(F.ctl + CW_AQ + 64 * rep_, 1u, RLX_AGENT); tsn = nxt < (unsigned)(BATCH * NH * 32) ? __hip_atomic_load(tsw + nxt, RLX_AGENT) : 1u; }
            const int qb = 31 - (int)(cur >> 6), bh = (int)(cur & 63u);
            const int fixm = tstart >> 16, ts0 = tstart & 0xffff;
            if (fixm) { const int q0 = qb * 256, sq = q0 >> 11; const float* qt = (const float*)(ws + WS_QTOT) + bh * 4; const float a1 = qt[0], a2 = a1 + qt[1], a3 = a2 + qt[2];
                const float ref = ((const float*)(ws + WS_NCS))[(size_t)bh * SEQ + q0 + 255] + (sq == 0 ? 0.f : (sq == 1 ? a1 : (sq == 2 ? a2 : a3)));
                attn_body::attn_unit<24, true>(bh / NH, bh % NH, qb, ts0, (const attn_body::bf16*)(ws + WS_Q), (const attn_body::bf16*)(ws + WS_K), (const attn_body::bf16*)(ws + WS_V), (attn_body::bf16*)(ws + WS_H),
                                     (const float*)(ws + WS_NCS), (const float*)(ws + WS_QTOT) + bh * 4, (char*)lds + RING_OFF, ref); }
            else attn_body::attn_unit<24, false>(bh / NH, bh % NH, qb, ts0, (const attn_body::bf16*)(ws + WS_Q), (const attn_body::bf16*)(ws + WS_K), (const attn_body::bf16*)(ws + WS_V), (attn_body::bf16*)(ws + WS_H),
                                     (const float*)(ws + WS_NCS), (const float*)(ws + WS_QTOT) + bh * 4, (char*)lds + RING_OFF, 0.f);
            if (F.tid == 0) { if (nxt < (unsigned)(BATCH * NH * 32)) { unsigned sp = 0u; while (tsn == 0u && ++sp < (1u << 22)) tsn = __hip_atomic_load(tsw + nxt, RLX_AGENT); if (tsn == 0u) tsn = 1u; }
                F.MISC[11] = nxt; F.MISC[21] = tsn; nxt = nx2; }
            __syncthreads();
            cur = (unsigned)__builtin_amdgcn_readfirstlane((int)F.MISC[11]); tstart = __builtin_amdgcn_readfirstlane((int)F.MISC[21]) - 1;
        }
    } SEAM(PH_ATT);

    PHASE(PH_WO) {
        pg8::GemmK g{D, D, D};
        pg8::DenseOrder S{T / 256, D / 256, (T / 256) * (D / 256), F.G, cblk, (const char*)(ws + WS_H), (const char*)(ws + WS_WOUT), (size_t)256 * D * 2, 0, (size_t)256 * D * 2};
        pg8::EpiBf16 E{(bf16*)(ws + WS_YATT), D, nullptr, 0, 0, 1.f};
        pg8::gemm_phase<pg8::EpiBf16, pg8::DenseOrder, true>(F.lds + RING_OFF, g, S, E);
    } SEAM(PH_WO);

    PHASE(PH_THC) { LOAD_IN(); thin_phase<2>(F, I, (const bf16*)(ws + WS_YATT), (bf16*)(ws + WS_XR), I.norm_g + 5 * D, I.norm_g + 6 * D); } SEAM(PH_THC);


    if (hi > PH_MOE && lo < PH_FIN) {
        RELAUNDER();
        moe_offsets(F);
        const int nRT = __builtin_amdgcn_readfirstlane((int)F.MISC[10]);
        for (int c = 0; c < MAXCHUNK; ++c) {
            const int rt0 = c * CHUNK_RT; int nM = nRT - rt0; if (c == 0 && nM > CHUNK_RT) nM = CHUNK_RT;
            PHASE(PH_MOE + 2 * c) if (nM > 0) {
                pg8::GemmK g{D / 2, D / 2, D / 2};
                typedef pg8::MoeOrder<FFE / 128, 0, 0, (size_t)2 * FFE * D, (size_t)256 * D, 0> OrdGU;
                OrdGU S{rt0, nM, F.G, cblk, (const char*)(ws + WS_H), (const char*)(ws + WS_WGU), (const LAS unsigned*)(F.lds + MISC_OFF + 48)};
                typedef pg8::EpiSwiGLU8<(int)WGU_PRESCALE> EpiGU8;
                EpiGU8 E{ws + WS_ACTC, FFE};
                pg8::gemm_phase<EpiGU8, OrdGU, true, true, true>(F.lds + RING_OFF, g, S, E, (long)WS_RIDX - (long)WS_H);
            }
            SEAM(PH_MOE + 2 * c);
            PHASE(PH_MOE + 2 * c + 1) if (nM > 0) {
                pg8::GemmK g{FFE / 2, FFE / 2, FFE / 2};
                typedef pg8::MoeOrder<D / 256, (size_t)256 * FFE, 1, (size_t)D * FFE, (size_t)256 * FFE, 1> OrdDN;
                OrdDN S{rt0, nM, F.G, cblk, (const char*)(ws + WS_ACTC), (const char*)(ws + WS_WD), (const LAS unsigned*)(F.lds + MISC_OFF + 48)};
                pg8::EpiFp8 E{ws + WS_YS, D, 1.0f / WD_PRESCALE};
                pg8::gemm_phase<pg8::EpiFp8, OrdDN, true, true>(F.lds + RING_OFF, g, S, E);
            }
            SEAM(PH_MOE + 2 * c + 1);
        }
    }

    PHASE(PH_FIN) { LOAD_IN(); final_phase(F, I, out); }
    if (MK_TPROBE >= 0) { if (MK_TPROBE == PH_FIN) { asm volatile("s_waitcnt vmcnt(0)" ::: "memory"); tp1_ = __builtin_amdgcn_s_memrealtime(); }
        if (blockIdx.x == 0) { const unsigned long long t_ = __builtin_amdgcn_s_memrealtime(), d_ = 4ull * (tp1_ - tp0_); while (__builtin_amdgcn_s_memrealtime() - t_ < d_) __builtin_amdgcn_s_sleep(8); } }
#undef IN
#undef SEAM
}

extern "C" void kernel_launch(void* const* d_in, const int* in_sizes, int n_in, void* d_out, int out_size, void* d_ws, size_t ws_size, hipStream_t stream) {
    static int grid = 0;
    if (grid == 0) {
        if (n_in != 14 || in_sizes[0] != T * D || out_size != T * D || ws_size < WS_END) { fprintf(stderr, "kernel_launch: unexpected shapes (n_in %d, in0 %d, out %d, ws %zu); nothing launched\n", n_in, n_in > 0 ? in_sizes[0] : -1, out_size, ws_size); grid = -1; return; }
        int dev = 0, cus = 0, per_cu = 0;
        if (hipGetDevice(&dev) != hipSuccess || hipDeviceGetAttribute(&cus, hipDeviceAttributeMultiprocessorCount, dev) != hipSuccess) { grid = -1; return; }
        if (hipFuncSetAttribute((const void*)trunk_fwd, hipFuncAttributeMaxDynamicSharedMemorySize, LDS_BYTES) != hipSuccess) { fprintf(stderr, "kernel_launch: hipFuncSetAttribute failed\n"); grid = -1; return; }
        if (hipOccupancyMaxActiveBlocksPerMultiprocessor(&per_cu, (const void*)trunk_fwd, NWAVES * 64, LDS_BYTES) != hipSuccess || per_cu < 1)
            fprintf(stderr, "kernel_launch: note: occupancy query reports %d workgroups per CU\n", per_cu);
        (void)hipGetLastError();
        grid = cus;
    }
    if (grid < 0) return;
    if (hipMemsetAsync((char*)d_ws + WS_CTL, 0, CTL_ZERO_BYTES, stream) != hipSuccess) return;
    Args a{};
    for (int i = 0; i < 14; ++i) a.in[i] = (const float*)d_in[i];
    a.out = (float*)d_out; a.ws = (unsigned char*)d_ws;
#if MK_PER_PHASE
    for (int p = 0; p < MK_LAST_PHASE; ++p) { a.ph_lo = p; a.ph_hi = p + 1; hipLaunchKernelGGL(trunk_fwd, dim3(grid), dim3(NWAVES * 64), LDS_BYTES, stream, a); }
#else
    a.ph_lo = 0; a.ph_hi = MK_LAST_PHASE;
    hipLaunchKernelGGL(trunk_fwd, dim3(grid), dim3(NWAVES * 64), LDS_BYTES, stream, a);
#endif
}
```
